# Optimizing an MI355X kernel written in HIP

```python
import jax, jax.numpy as jnp
from jax import lax
import numpy as np

D_MODEL = 1024
BATCH = 8
SEQ = 4096
DEPTH = 2

RMS_EPS = 1e-5
N_BRANCHES = 3
GMLP_WIDTH = D_MODEL
GMLP_HEADS = 8
GMLP_HEAD_DIM = GMLP_WIDTH // GMLP_HEADS
CHUNK = 128
POOL_WIDTH = D_MODEL
POOL_WINDOWS = (2, 4, 8, 16)
POOL_GROUPS = len(POOL_WINDOWS)
POOL_GROUP_DIM = POOL_WIDTH // POOL_GROUPS
CONV_WIDTH = D_MODEL
CONV_K = 3
SPLIT_POINTS = (
    GMLP_WIDTH,
    2 * GMLP_WIDTH,
    2 * GMLP_WIDTH + POOL_WIDTH,
    2 * GMLP_WIDTH + POOL_WIDTH + CONV_WIDTH,
    2 * GMLP_WIDTH + POOL_WIDTH + 2 * CONV_WIDTH,
    2 * GMLP_WIDTH + POOL_WIDTH + 3 * CONV_WIDTH,
)
IN_COLS = 2 * GMLP_WIDTH + POOL_WIDTH + 3 * CONV_WIDTH + N_BRANCHES * D_MODEL
N_EXPERTS = 32
TOP_K = 4
D_FF = D_MODEL
SWIGLU_LIMIT = 7.0
SWIGLU_ALPHA = 1.702
MOE_BLOCK = 128

kernel_name = "hybrid_gmlp_pool_conv_moe_adaln"


def rms_norm(x, g):
    xf = x.astype(jnp.float32)
    y = xf * lax.rsqrt(jnp.mean(xf * xf, axis=-1, keepdims=True) + RMS_EPS)
    return (y * g.astype(jnp.float32)).astype(x.dtype)


def gmlp_branch(u, v, norm_g, ws, bs, w_proj):
    bsz, seq, _ = v.shape
    u = jax.nn.gelu(u)
    v = rms_norm(jax.nn.gelu(v), norm_g)
    vb = v.reshape(bsz, seq // CHUNK, CHUNK, GMLP_HEADS, GMLP_HEAD_DIM)
    causal = jnp.tril(jnp.ones((CHUNK, CHUNK), dtype=bool))
    ws_m = jnp.where(causal[None], ws, jnp.zeros_like(ws))
    s = jnp.einsum('hts,bcshd->bcthd', ws_m, vb) + jnp.transpose(bs)[:, :, None]
    return (u * s.reshape(bsz, seq, GMLP_WIDTH)) @ w_proj


def pool_branch(p, pool_w, pool_scale):
    bsz, seq, _ = p.shape
    pf = p.astype(jnp.float32)
    cs = jnp.cumsum(pf, axis=1)
    pos = jnp.arange(seq)
    diffs = []
    for gi, w in enumerate(POOL_WINDOWS):
        sl = slice(gi * POOL_GROUP_DIM, (gi + 1) * POOL_GROUP_DIM)
        cs_g = cs[:, :, sl]
        lag = jnp.pad(cs_g, ((0, 0), (w, 0), (0, 0)))[:, :seq]
        cnt = jnp.minimum(pos + 1, w).astype(jnp.float32)[None, :, None]
        diffs.append((cs_g - lag) / cnt - pf[:, :, sl])
    d = jnp.stack(diffs, axis=2).astype(p.dtype)
    y = jnp.einsum('bsgc,gce->bsge', d, pool_w).reshape(bsz, seq, POOL_WIDTH)
    return y * pool_scale


def conv_branch(xc, b_gate, c_gate, conv_w, w_proj):
    z = c_gate * xc
    zp = jnp.pad(z, ((0, 0), (CONV_K - 1, 0), (0, 0)))
    seq = z.shape[1]
    conv = sum(conv_w[k] * zp[:, k:k + seq] for k in range(CONV_K))
    return (b_gate * conv) @ w_proj


def hybrid_mixer(h, w_in, gmlp_norm_g, gmlp_ws, gmlp_bs, w_proj_a, pool_w, pool_scale,
                 conv_w, w_proj_c, w_out):
    z = jnp.einsum('bsd,dn->bsn', h, w_in)
    u, v, p, xc, b_gate, c_gate, gates = jnp.split(z, SPLIT_POINTS, axis=-1)
    ya = gmlp_branch(u, v, gmlp_norm_g, gmlp_ws, gmlp_bs, w_proj_a)
    yb = pool_branch(p, pool_w, pool_scale)
    yc = conv_branch(xc, b_gate, c_gate, conv_w, w_proj_c)
    ga, gb, gc = jnp.split(jax.nn.sigmoid(gates), N_BRANCHES, axis=-1)
    return (ga * ya + gb * yb + gc * yc) @ w_out


def moe_ffn(h, router_w, router_b, w_gu, b_gu, w_down, b_down):
    bsz, seq, d = h.shape
    n_tok = bsz * seq
    n_assign = n_tok * TOP_K
    n_rows = n_assign + N_EXPERTS * MOE_BLOCK
    n_blocks = n_rows // MOE_BLOCK
    t = h.reshape(n_tok, d)
    logits = (t @ router_w + router_b).astype(jnp.float32)
    top_vals, top_idx = lax.top_k(logits, TOP_K)
    gate_w = jax.nn.softmax(top_vals, axis=-1)
    flat_e = top_idx.reshape(-1).astype(jnp.int32)
    flat_tok = jnp.repeat(jnp.arange(n_tok, dtype=jnp.int32), TOP_K)
    order = jnp.argsort(flat_e)
    sorted_e = flat_e[order]
    sorted_tok = flat_tok[order]
    w_sorted = gate_w.reshape(-1)[order].astype(h.dtype)
    counts = jnp.bincount(flat_e, length=N_EXPERTS).astype(jnp.int32)
    padded = ((counts + MOE_BLOCK - 1) // MOE_BLOCK) * MOE_BLOCK
    pad_end = jnp.cumsum(padded)
    pad_start = pad_end - padded
    grp_start = jnp.cumsum(counts) - counts
    rank = jnp.arange(n_assign, dtype=jnp.int32) - grp_start[sorted_e]
    dest = pad_start[sorted_e] + rank
    row_tok = jnp.zeros((n_rows,), jnp.int32).at[dest].set(sorted_tok)
    xs = t[row_tok].reshape(n_blocks, MOE_BLOCK, d)
    block_start = jnp.arange(n_blocks, dtype=jnp.int32) * MOE_BLOCK
    block_e = jnp.minimum(jnp.searchsorted(pad_end, block_start, side='right'), N_EXPERTS - 1)

    def expert_block(args):
        xb, e = args
        gu = xb @ w_gu[e] + b_gu[e]
        gate, up = jnp.split(gu, 2, axis=-1)
        gate = jnp.minimum(gate, SWIGLU_LIMIT)
        up = jnp.clip(up, -SWIGLU_LIMIT, SWIGLU_LIMIT)
        glu = gate * jax.nn.sigmoid(SWIGLU_ALPHA * gate)
        return ((up + 1.0) * glu) @ w_down[e] + b_down[e]

    ys = lax.map(expert_block, (xs, block_e)).reshape(n_rows, d)
    y_assign = ys[dest] * w_sorted[:, None]
    out = jax.ops.segment_sum(y_assign, sorted_tok, num_segments=n_tok)
    return out.reshape(bsz, seq, d)


def setup_inputs(seed: int = 0) -> dict:
    key = jax.random.key(seed)
    ks = jax.random.split(key, 24)
    f32 = jnp.float32
    L, D = DEPTH, D_MODEL

    def nrm(k, shape, s):
        return jax.random.normal(k, shape, f32) * s

    return {
        "x": nrm(ks[0], (BATCH, SEQ, D), 1.0),
        "c": nrm(ks[1], (BATCH, D), 1.0),
        "norm1_g": 1.0 + nrm(ks[2], (L, D), 0.05),
        "ada_w": nrm(ks[3], (L, D, 6 * D), 0.2 * D ** -0.5),
        "ada_b": nrm(ks[4], (L, 6 * D), 0.02),
        "w_in": nrm(ks[5], (L, D, IN_COLS), D ** -0.5),
        "gmlp_norm_g": 1.0 + nrm(ks[6], (L, GMLP_WIDTH), 0.05),
        "gmlp_ws": nrm(ks[7], (L, GMLP_HEADS, CHUNK, CHUNK), CHUNK ** -0.5),
        "gmlp_bs": 1.0 + nrm(ks[8], (L, GMLP_HEADS, CHUNK), 0.05),
        "w_proj_a": nrm(ks[9], (L, GMLP_WIDTH, D), GMLP_WIDTH ** -0.5),
        "pool_w": nrm(ks[10], (L, POOL_GROUPS, POOL_GROUP_DIM, POOL_GROUP_DIM), POOL_GROUP_DIM ** -0.5),
        "pool_scale": 1.0 + nrm(ks[11], (L, POOL_WIDTH), 0.05),
        "conv_w": nrm(ks[12], (L, CONV_K, CONV_WIDTH), CONV_K ** -0.5),
        "w_proj_c": nrm(ks[13], (L, CONV_WIDTH, D), CONV_WIDTH ** -0.5),
        "w_out": nrm(ks[14], (L, D, D), D ** -0.5),
        "norm2_g": 1.0 + nrm(ks[15], (L, D), 0.05),
        "router_w": nrm(ks[16], (L, D, N_EXPERTS), D ** -0.5),
        "router_b": nrm(ks[17], (L, N_EXPERTS), 0.01),
        "exp_w_gu": nrm(ks[18], (L, N_EXPERTS, D, 2 * D_FF), D ** -0.5),
        "exp_b_gu": nrm(ks[19], (L, N_EXPERTS, 2 * D_FF), 0.02),
        "exp_w_down": nrm(ks[20], (L, N_EXPERTS, D_FF, D), D_FF ** -0.5),
        "exp_b_down": nrm(ks[21], (L, N_EXPERTS, D), 0.02),
        "final_g": 1.0 + nrm(ks[22], (D,), 0.05),
    }


def reference(x, c, norm1_g, ada_w, ada_b, w_in, gmlp_norm_g, gmlp_ws, gmlp_bs, w_proj_a,
              pool_w, pool_scale, conv_w, w_proj_c, w_out, norm2_g, router_w, router_b,
              exp_w_gu, exp_b_gu, exp_w_down, exp_b_down, final_g):
    cond = jax.nn.silu(c)
    for l in range(DEPTH):
        mods = cond @ ada_w[l] + ada_b[l]
        sh1, sc1, g1, sh2, sc2, g2 = [m[:, None, :] for m in jnp.split(mods, 6, axis=-1)]
        h = rms_norm(x, norm1_g[l]) * (1.0 + sc1) + sh1
        x = x + g1 * hybrid_mixer(h, w_in[l], gmlp_norm_g[l], gmlp_ws[l], gmlp_bs[l], w_proj_a[l],
                                  pool_w[l], pool_scale[l], conv_w[l], w_proj_c[l], w_out[l])
        h = rms_norm(x, norm2_g[l]) * (1.0 + sc2) + sh2
        x = x + g2 * moe_ffn(h, router_w[l], router_b[l], exp_w_gu[l], exp_b_gu[l],
                             exp_w_down[l], exp_b_down[l])
    return rms_norm(x, final_g)
```

```cpp
#include <hip/hip_runtime.h>
#include <cstdio>
#include <cstdint>

#ifndef MK_N_LAUNCHES
#define MK_N_LAUNCHES 18
#endif

#define GAS __attribute__((address_space(1)))
#define LAS __attribute__((address_space(3)))
typedef unsigned short bf16;
typedef short bf16x8 __attribute__((ext_vector_type(8)));
typedef float f32x4 __attribute__((ext_vector_type(4)));
typedef float f32x2 __attribute__((ext_vector_type(2)));
typedef unsigned u32x4 __attribute__((ext_vector_type(4)));
typedef unsigned u32x2 __attribute__((ext_vector_type(2)));

constexpr int D = 1024, NB = 8, SEQ = 4096, NTOK = NB * SEQ, DEPTH = 2, INC = 9216, NE = 32, TOPK = 4, FF = 1024, CHUNK = 128;
constexpr int Z_U = 0, Z_V = 1024, Z_P = 2048, Z_X = 3072, Z_B = 4096, Z_C = 5120, Z_GA = 6144, Z_GB = 7168, Z_GC = 8192;
constexpr float RMS_EPS = 1e-5f;
constexpr int NWAVES = 8, NTHREADS = NWAVES * 64;
constexpr int NPHASES = 2 + 8 * DEPTH;
constexpr int N_LAUNCHES = MK_N_LAUNCHES;
static_assert(N_LAUNCHES == 1 || N_LAUNCHES == NPHASES, "MK_N_LAUNCHES must be 1 or NPHASES");

constexpr size_t MiB = 1u << 20;
constexpr size_t WS_CTL = 0, CTL_ZERO_BYTES = 1 * MiB;
constexpr int CW_BAR = 4096;
constexpr int CW_CNT = 8192;
constexpr size_t WS_VSS = 256 * 1024;
constexpr size_t WS_MODS = 512 * 1024;
constexpr size_t WS_RWT = 1 * MiB;
constexpr size_t WS_RBIAS = 3 * MiB;
constexpr size_t WS_LIST = 4 * MiB;
constexpr size_t WS_WLIST = 8 * MiB;
constexpr size_t WS_WTPOOL = 12 * MiB;
constexpr size_t WS_WTA = 16 * MiB, WS_WTC = 20 * MiB, WS_WTO = 24 * MiB;
constexpr size_t WS_WTIN = 28 * MiB;
constexpr size_t WS_WTGU = 64 * MiB;
constexpr size_t WS_WTDN = 320 * MiB;
constexpr size_t WS_H = 448 * MiB;
constexpr size_t WS_VT = 512 * MiB;
constexpr size_t WS_AIN = 576 * MiB, WS_CIN = 640 * MiB, WS_PIN = 704 * MiB;
constexpr size_t WS_MIX = 768 * MiB;
constexpr size_t WS_XRES = 832 * MiB;
constexpr size_t WS_MIXF = 960 * MiB;
constexpr size_t WS_Z = 1088 * MiB;
constexpr size_t WS_ACT = WS_Z;
constexpr size_t WS_YB = WS_Z + 288 * MiB;
constexpr size_t WS_END = 1664 * MiB;

constexpr int RING_BYTES = 131072;
constexpr int LDS_BYTES = 147456;
constexpr int LDSCTL_OFF = LDS_BYTES - 1024;

#define RLX_AGENT __ATOMIC_RELAXED, __HIP_MEMORY_SCOPE_AGENT
__device__ __forceinline__ unsigned cvt_pk_bf16(float lo, float hi) { unsigned r; asm volatile("v_cvt_pk_bf16_f32 %0, %1, %2" : "=v"(r) : "v"(lo), "v"(hi)); return r; }
__device__ __forceinline__ float bflo(unsigned u) { return __uint_as_float(u << 16); }
__device__ __forceinline__ float bfhi(unsigned u) { return __uint_as_float(u & 0xffff0000u); }
__device__ __forceinline__ float wave_sum(float v) {
#pragma unroll
    for (int o = 1; o < 64; o <<= 1) v += __shfl_xor(v, o);
    return v;
}
__device__ __forceinline__ float sigmoidf_fast(float x) { return __builtin_amdgcn_rcpf(1.0f + __builtin_amdgcn_exp2f(-1.44269504089f * x)); }
__device__ __forceinline__ float gelu_tanh(float x) {
    const float t = x * (1.0f + 0.044715f * x * x);
    return x * __builtin_amdgcn_rcpf(1.0f + __builtin_amdgcn_exp2f(-2.30220818f * t));
}
__device__ __forceinline__ f32x4 unpack_lo4(u32x2 w) { return (f32x4){bflo(w.x), bfhi(w.x), bflo(w.y), bfhi(w.y)}; }

#define XB_TMO      128
#define XB_XCNT(j)  (256  + 64 * (j))
#define XB_XSUB(j)  (1280 + 64 * (j))
#define XB_XGEN(j)  (2304 + 64 * (j))
#define XB_TOP      3328
#define XB_TOPGEN   3392
#define XCD_BAR_WORDS 3456
#define XB_SPIN_CAP (1u << 18)
__device__ __forceinline__ unsigned xb_ld(unsigned* p)              { return __hip_atomic_load(p, __ATOMIC_RELAXED, __HIP_MEMORY_SCOPE_AGENT); }
__device__ __forceinline__ unsigned xb_add(unsigned* p, unsigned v) { return __hip_atomic_fetch_add(p, v, __ATOMIC_RELAXED, __HIP_MEMORY_SCOPE_AGENT); }
__device__ __forceinline__ unsigned xb_xcc_id() { return (unsigned)__builtin_amdgcn_s_getreg((3 << 11) | 20) & 0xFu; }
#define XB_SPIN(cond, bar) do { unsigned _sp = 0; while (cond) { __builtin_amdgcn_s_sleep(1); \
    if ((++_sp & 255u) == 0u) { if (xb_ld(&(bar)[XB_TMO])) break; if (_sp > XB_SPIN_CAP) { atomicAdd(&(bar)[XB_TMO], 1u); break; } } } } while (0)
struct XcdBarrier { unsigned* bar; unsigned x; volatile LAS unsigned* st; };
__device__ __forceinline__ XcdBarrier xcd_barrier_post(unsigned* bar, volatile LAS unsigned* st) {
    XcdBarrier b; b.bar = bar; b.x = xb_xcc_id(); b.st = st;
    if (threadIdx.x == 0) (void)xb_add(&bar[XB_XCNT(b.x)], 1u);
    return b;
}
__device__ __forceinline__ void xcd_barrier_complete(unsigned* bar, unsigned x, unsigned& nloc, unsigned& nx) {
    const unsigned G = gridDim.x * gridDim.y * gridDim.z;
    unsigned sum, cnt, mine, sp = 0u;
    for (;;) {
        sum = 0u; cnt = 0u; mine = 0u;
#pragma unroll
        for (unsigned j = 0; j < 16; ++j) { const unsigned c = xb_ld(&bar[XB_XCNT(j)]); sum += c; cnt += (c > 0u) ? 1u : 0u; mine = (j == x) ? c : mine; }
        if (sum == G) break;
        __builtin_amdgcn_s_sleep(1);
        if ((++sp & 255u) == 0u) { if (xb_ld(&bar[XB_TMO])) break; if (sp > XB_SPIN_CAP) { atomicAdd(&bar[XB_TMO], 1u); break; } }
    }
    nloc = mine > 0u ? mine : 1u; nx = cnt > 0u ? cnt : 1u;
}
__device__ __forceinline__ void xcd_barrier(const XcdBarrier& b) {
    asm volatile("s_waitcnt vmcnt(0)" ::: "memory");
    __syncthreads();
    if (threadIdx.x == 0) {
        unsigned* bar = b.bar;
        __builtin_amdgcn_s_waitcnt(0);
        unsigned nloc = b.st[0], nx = b.st[1];
        if (nloc == 0u) { xcd_barrier_complete(bar, b.x, nloc, nx); b.st[0] = nloc; b.st[1] = nx; }
        const unsigned old = xb_add(&bar[XB_XSUB(b.x)], 1u);
        const unsigned gen = old / nloc;
        if (old + 1u == (gen + 1u) * nloc) {
            __builtin_amdgcn_fence(__ATOMIC_RELEASE, "agent");
            asm volatile("s_waitcnt vmcnt(0)" ::: "memory");
            const unsigned og = xb_add(&bar[XB_TOP], 1u);
            const unsigned tg = og / nx;
            if (og + 1u == (tg + 1u) * nx) xb_add(&bar[XB_TOPGEN], 1u);
            else XB_SPIN(xb_ld(&bar[XB_TOPGEN]) == tg, bar);
            __builtin_amdgcn_fence(__ATOMIC_ACQUIRE, "agent");
            xb_add(&bar[XB_XGEN(b.x)], 1u);
            asm volatile("s_waitcnt vmcnt(0)" ::: "memory");
        } else {
            XB_SPIN(xb_ld(&bar[XB_XGEN(b.x)]) == gen, bar);
            __builtin_amdgcn_fence(__ATOMIC_ACQUIRE, "agent");
            asm volatile("s_waitcnt vmcnt(0)" ::: "memory");
        }
    }
    __syncthreads();
}

namespace gm {
constexpr int BM = 256, BK = 64, HALF = 128, HTB = HALF * BK * 2;
constexpr unsigned PITCH = 2048u, HSTEP = 128u * PITCH, TSTEP = 256u * PITCH, KSTEP = 128u;
__device__ __forceinline__ int lds_byte(int r, int c) { const int st = (r >> 4) * 2 + (c >> 5), rr = r & 15, cc = c & 31, ob = rr * 64 + cc * 2; return st * 1024 + (ob ^ (((ob >> 9) & 1) << 5)); }
__device__ __forceinline__ void stage_rc(int b, int& R, int& C) { const int st = b / 1024, sb = b % 1024, swz = sb ^ (((sb >> 9) & 1) << 5); R = (st >> 1) * 16 + swz / 64; C = (st & 1) * 32 + (swz % 64) / 2; }
__device__ __forceinline__ int perm32(int rho) { const int n = rho >> 4, i = rho & 15; return 8 * (i >> 2) + 4 * n + (i & 3); }

struct Unit { const char* A; const char* B; int nt, kind, pm, pn, aux; };

__device__ __forceinline__ void tile_map(int L, int nM, int nN, int& pm, int& pn) {
    const int nwg = nM * nN; int wgid = L;
    { const int q = nwg / 8, r = nwg % 8, xcd = wgid % 8, off = wgid / 8; wgid = (xcd < r ? xcd * (q + 1) : r * (q + 1) + (xcd - r) * q) + off; }
    const int nig = 8 * nN, gid = wgid / nig, fm = gid * 8, gsz = (nM - fm) < 8 ? (nM - fm) : 8;
    pm = fm + ((wgid % nig) % gsz); pn = (wgid % nig) / gsz;
}

template <class Epi, class Sched, bool GATHER>
__device__ __forceinline__ void gemm_phase(LAS unsigned char* lds, const Sched& S, const Epi& E) {
    int tid_ = threadIdx.x; asm volatile("" : "+v"(tid_));
    const int tid = tid_, wid = __builtin_amdgcn_readfirstlane(tid >> 6), lane = tid & 63, wr = wid >> 2, wc = wid & 3, fr = lane & 15, fq = lane >> 4;
    unsigned voffB[2], cvA[2][2], nvA[2][2]; int rA[2]; unsigned cC[2];
#pragma unroll
    for (int i = 0; i < 2; ++i) { int R, C; stage_rc(tid * 16 + i * 8192, R, C); const int Rb = (R & ~31) + perm32(R & 31);
        voffB[i] = (unsigned)Rb * PITCH + (unsigned)C * 2u; rA[i] = R; cC[i] = (unsigned)C * 2u;
        cvA[0][i] = (unsigned)R * PITCH + cC[i]; cvA[1][i] = cvA[0][i] + HSTEP; nvA[0][i] = cvA[0][i]; nvA[1][i] = cvA[1][i]; }
    const unsigned ldsw = (unsigned)wid * 1024u;
    const int aoff = lds_byte(wr * 64 + fr, fq * 8), boff = lds_byte(wc * 32 + fr, fq * 8);
#define GM_SA(b, h) (((b) * 2 + (h)) * HTB)
#define GM_SB(b, h) ((4 + (b) * 2 + (h)) * HTB)
#define GM_STAGE(bufoff, gbase, voff) do { _Pragma("unroll") for (int _i = 0; _i < 2; ++_i) \
        __builtin_amdgcn_global_load_lds((const unsigned*)((const char*)(gbase) + (voff)[_i]), (LAS unsigned*)(lds + (bufoff) + ldsw + _i * 8192), 16, 0, 0); } while (0)
#define GM_LDA(dst, b, h) do { _Pragma("unroll") for (int m = 0; m < 4; ++m) _Pragma("unroll") for (int k = 0; k < 2; ++k) dst[m][k] = *(const LAS bf16x8*)(lds + GM_SA(b, h) + aoff + m * 2048 + k * 1024); } while (0)
#define GM_LDB(dst, b, h) do { _Pragma("unroll") for (int n = 0; n < 2; ++n) _Pragma("unroll") for (int k = 0; k < 2; ++k) dst[n][k] = *(const LAS bf16x8*)(lds + GM_SB(b, h) + boff + n * 2048 + k * 1024); } while (0)
#define GM_MMA(ai, bj, At, Bt) do { __builtin_amdgcn_s_setprio(1); _Pragma("unroll") for (int m = 0; m < 4; ++m) _Pragma("unroll") for (int n = 0; n < 2; ++n) _Pragma("unroll") for (int k = 0; k < 2; ++k) \
        acc[ai][bj][m][n] = __builtin_amdgcn_mfma_f32_16x16x32_bf16(Bt[n][k], At[m][k], acc[ai][bj][m][n], 0, 0, 0); __builtin_amdgcn_s_setprio(0); } while (0)
#define GM_WAIT_V(n) asm volatile("s_waitcnt vmcnt(" #n ")" ::: "memory")
#define GM_WAIT_L(n) asm volatile("s_waitcnt lgkmcnt(" #n ")" ::: "memory")
#define GM_BAR __builtin_amdgcn_s_barrier()
#define GM_SCHED __builtin_amdgcn_sched_barrier(0)
    Unit cur, nxt; int ui = 0;
    if (!S.next(0, cur)) return;
    f32x4 acc[2][2][4][2];
#pragma unroll
    for (int a = 0; a < 2; ++a)
#pragma unroll
        for (int b = 0; b < 2; ++b)
#pragma unroll
            for (int m = 0; m < 4; ++m)
#pragma unroll
                for (int n = 0; n < 2; ++n) acc[a][b][m][n] = (f32x4){0.f, 0.f, 0.f, 0.f};
    bf16x8 At[4][2], B0[2][2], B1[2][2];
    const char* cA = cur.A; const char* cB = cur.B;
    if constexpr (GATHER) {
#pragma unroll
        for (int h = 0; h < 2; ++h)
#pragma unroll
            for (int i = 0; i < 2; ++i) cvA[h][i] = S.row_off(cur, h * HALF + rA[i]) + cC[i];
    }
    GM_STAGE(GM_SB(0, 0), cB, voffB); GM_STAGE(GM_SB(0, 1), cB + HSTEP, voffB); GM_STAGE(GM_SA(0, 0), cA, cvA[0]); GM_STAGE(GM_SA(0, 1), cA, cvA[1]);
    if (wr == 1) GM_BAR;
    GM_WAIT_V(2); GM_BAR;
    GM_STAGE(GM_SB(1, 0), cB + KSTEP, voffB); GM_STAGE(GM_SA(1, 0), cA + KSTEP, cvA[0]); GM_STAGE(GM_SB(1, 1), cB + HSTEP + KSTEP, voffB);
    GM_WAIT_V(6); GM_BAR;
    for (;;) {
        const bool has_next = S.next(ui + 1, nxt);
        const char* nA = has_next ? nxt.A : cA; const char* nB = has_next ? nxt.B : cB;
        if constexpr (GATHER) {
            if (has_next) {
#pragma unroll
                for (int h = 0; h < 2; ++h)
#pragma unroll
                    for (int i = 0; i < 2; ++i) nvA[h][i] = S.row_off(nxt, h * HALF + rA[i]) + cC[i];
            } else {
#pragma unroll
                for (int h = 0; h < 2; ++h)
#pragma unroll
                    for (int i = 0; i < 2; ++i) nvA[h][i] = cvA[h][i];
            }
        }
        const int nt = cur.nt;
        for (int t = 0; t < nt; t += 2) {
            const bool last = (t == nt - 2);
            const char* a1 = cA + (size_t)(t + 1) * KSTEP;
            const char* a2 = last ? nA : cA + (size_t)(t + 2) * KSTEP; const char* b2 = last ? nB : cB + (size_t)(t + 2) * KSTEP;
            const char* a3 = a2 + KSTEP; const char* b3 = b2 + KSTEP;
            unsigned o0[2], o1[2];
            if constexpr (GATHER) { o0[0] = last ? nvA[0][0] : cvA[0][0]; o0[1] = last ? nvA[0][1] : cvA[0][1]; o1[0] = last ? nvA[1][0] : cvA[1][0]; o1[1] = last ? nvA[1][1] : cvA[1][1]; }
            else { o0[0] = cvA[0][0]; o0[1] = cvA[0][1]; o1[0] = cvA[1][0]; o1[1] = cvA[1][1]; }
            GM_LDB(B0, 0, 0); GM_LDB(B1, 0, 1); GM_SCHED; GM_LDA(At, 0, 0); GM_STAGE(GM_SA(1, 1), a1, cvA[1]);
            GM_WAIT_V(8); GM_WAIT_L(0); GM_BAR; GM_MMA(0, 0, At, B0); GM_MMA(0, 1, At, B1); GM_BAR; GM_SCHED;
            GM_LDA(At, 0, 1); GM_STAGE(GM_SB(0, 0), b2, voffB); GM_STAGE(GM_SB(0, 1), b2 + HSTEP, voffB); GM_STAGE(GM_SA(0, 0), a2, o0);
            GM_WAIT_V(8); GM_WAIT_L(0); GM_BAR; GM_MMA(1, 0, At, B0); GM_MMA(1, 1, At, B1); GM_BAR; GM_SCHED;
            GM_LDB(B0, 1, 0); GM_LDB(B1, 1, 1); GM_SCHED; GM_LDA(At, 1, 0); GM_STAGE(GM_SA(0, 1), a2, o1);
            GM_WAIT_V(8); GM_WAIT_L(0); GM_BAR; GM_MMA(0, 0, At, B0); GM_MMA(0, 1, At, B1); GM_BAR; GM_SCHED;
            GM_LDA(At, 1, 1); GM_STAGE(GM_SB(1, 0), b3, voffB); GM_STAGE(GM_SB(1, 1), b3 + HSTEP, voffB); GM_STAGE(GM_SA(1, 0), a3, o0);
            GM_WAIT_V(8); GM_WAIT_L(0); GM_BAR; GM_MMA(1, 0, At, B0); GM_MMA(1, 1, At, B1); GM_BAR; GM_SCHED;
        }
        if (wr == 0) GM_BAR;
        E(acc, cur, wr, wc, fr, fq);
        if (!has_next) break;
#pragma unroll
        for (int a = 0; a < 2; ++a)
#pragma unroll
            for (int b = 0; b < 2; ++b)
#pragma unroll
                for (int m = 0; m < 4; ++m)
#pragma unroll
                    for (int n = 0; n < 2; ++n) acc[a][b][m][n] = (f32x4){0.f, 0.f, 0.f, 0.f};
        cur = nxt; cA = nA; cB = nB; ++ui;
        if constexpr (GATHER) {
#pragma unroll
            for (int h = 0; h < 2; ++h)
#pragma unroll
                for (int i = 0; i < 2; ++i) cvA[h][i] = nvA[h][i];
        }
        if (wr == 1) GM_BAR;
    }
    GM_WAIT_V(0);
    GM_BAR;
#undef GM_SA
#undef GM_SB
#undef GM_STAGE
#undef GM_LDA
#undef GM_LDB
#undef GM_MMA
#undef GM_WAIT_V
#undef GM_WAIT_L
#undef GM_BAR
#undef GM_SCHED
}
}

struct Args { const float* in[23]; float* out; unsigned char* ws; int ph_lo, ph_hi; };
struct Frame {
    LAS unsigned char* lds;
    unsigned* ctl;
    unsigned char* ws;
    int tid, lane, wave, G, bid;
    const Args* a;
};
#define FIN(i) (F.a->in[i])
#define FRESH_IDS(F) do { int t_ = threadIdx.x; asm volatile("" : "+v"(t_)); (F).tid = t_; (F).lane = t_ & 63; (F).wave = __builtin_amdgcn_readfirstlane(t_ >> 6); } while (0)
#define WSP(T, off) ((T*)(F.ws + (off)))

typedef f32x4 Acc[2][2][4][2];

struct EpiZ {
    bf16* Z; bf16* VT; float* vss;
    __device__ __forceinline__ void operator()(const Acc& acc, const gm::Unit& u, int wr, int wc, int fr, int fq) const {
        if (u.kind == 1) {
            const int vrow0 = (u.pn - 4) * 256 + wr * 64 + fr, tok0 = u.pm * 256 + wc * 32 + 8 * fq;
            float ss[2][8];
#pragma unroll
            for (int bj = 0; bj < 2; ++bj)
#pragma unroll
                for (int j = 0; j < 8; ++j) ss[bj][j] = 0.f;
#pragma unroll
            for (int ai = 0; ai < 2; ++ai)
#pragma unroll
                for (int m = 0; m < 4; ++m) { bf16* rp = VT + (size_t)(vrow0 + ai * 128 + m * 16) * NTOK + tok0;
#pragma unroll
                    for (int bj = 0; bj < 2; ++bj) { float v[8];
#pragma unroll
                        for (int j = 0; j < 8; ++j) { v[j] = gelu_tanh(acc[ai][bj][m][j >> 2][j & 3]); ss[bj][j] += v[j] * v[j]; }
                        u32x4 w; w.x = cvt_pk_bf16(v[0], v[1]); w.y = cvt_pk_bf16(v[2], v[3]); w.z = cvt_pk_bf16(v[4], v[5]); w.w = cvt_pk_bf16(v[6], v[7]);
                        *(u32x4*)(rp + bj * 128) = w; } }
#pragma unroll
            for (int bj = 0; bj < 2; ++bj)
#pragma unroll
                for (int j = 0; j < 8; ++j) { float s = ss[bj][j]; s += __shfl_xor(s, 1); s += __shfl_xor(s, 2); s += __shfl_xor(s, 4); s += __shfl_xor(s, 8);
                    if (fr == 0) atomicAdd(vss + tok0 + bj * 128 + j, s); }
        } else {
            const int row0 = u.pm * 256 + wr * 64 + fr, col0 = u.pn * 256 + wc * 32 + 8 * fq; const int kind = u.kind;
#pragma unroll
            for (int ai = 0; ai < 2; ++ai)
#pragma unroll
                for (int m = 0; m < 4; ++m) { bf16* rp = Z + (size_t)(row0 + ai * 128 + m * 16) * INC + col0;
#pragma unroll
                    for (int bj = 0; bj < 2; ++bj) { float v[8];
#pragma unroll
                        for (int j = 0; j < 8; ++j) { const float a = acc[ai][bj][m][j >> 2][j & 3]; v[j] = kind == 0 ? gelu_tanh(a) : (kind == 3 ? sigmoidf_fast(a) : a); }
                        u32x4 w; w.x = cvt_pk_bf16(v[0], v[1]); w.y = cvt_pk_bf16(v[2], v[3]); w.z = cvt_pk_bf16(v[4], v[5]); w.w = cvt_pk_bf16(v[6], v[7]);
                        *(u32x4*)(rp + bj * 128) = w; } }
        }
    }
};
struct SchedZ {
    int G, c; const char* H; const char* W;
    __device__ __forceinline__ bool next(int i, gm::Unit& u) const {
        const int L = i * G + c; if (L >= 128 * 36) return false;
        int pm, pn; gm::tile_map(L, 128, 36, pm, pn);
        u.pm = pm; u.pn = pn; u.nt = 16; u.aux = 0;
        if (pn >= 4 && pn < 8) { u.A = W + (size_t)pn * gm::TSTEP; u.B = H + (size_t)pm * gm::TSTEP; u.kind = 1; }
        else { u.A = H + (size_t)pm * gm::TSTEP; u.B = W + (size_t)pn * gm::TSTEP; u.kind = pn < 4 ? 0 : (pn < 24 ? 2 : 3); }
        return true;
    }
    __device__ __forceinline__ unsigned row_off(const gm::Unit&, int) const { return 0u; }
};

struct EpiMix {
    const bf16* Z; float* MIXF; bf16* MIX; const float* pscale;
    __device__ __forceinline__ void operator()(const Acc& acc, const gm::Unit& u, int wr, int wc, int fr, int fq) const {
        const int row0 = u.pm * 256 + wr * 64 + fr, col0 = u.pn * 256 + wc * 32 + 8 * fq; const int kind = u.kind;
        const int gcol = (kind == 0 ? Z_GA : (kind == 1 ? Z_GC : Z_GB)) + col0;
        f32x4 ps[2][2];
#pragma unroll
        for (int bj = 0; bj < 2; ++bj)
#pragma unroll
            for (int n = 0; n < 2; ++n) ps[bj][n] = kind == 2 ? *(const f32x4*)(pscale + col0 + bj * 128 + 4 * n) : (f32x4){1.f, 1.f, 1.f, 1.f};
#pragma unroll
        for (int ai = 0; ai < 2; ++ai)
#pragma unroll
            for (int m = 0; m < 4; ++m) { const size_t row = (size_t)(row0 + ai * 128 + m * 16);
#pragma unroll
                for (int bj = 0; bj < 2; ++bj) {
                    const u32x4 gw = *(const u32x4*)(Z + row * INC + gcol + bj * 128);
                    const f32x4 g0 = {bflo(gw.x), bfhi(gw.x), bflo(gw.y), bfhi(gw.y)}, g1 = {bflo(gw.z), bfhi(gw.z), bflo(gw.w), bfhi(gw.w)};
                    float* mp = MIXF + row * D + col0 + bj * 128;
                    f32x4 o0 = g0 * ps[bj][0] * acc[ai][bj][m][0], o1 = g1 * ps[bj][1] * acc[ai][bj][m][1];
                    if (kind != 0) { o0 += *(const f32x4*)mp; o1 += *(const f32x4*)(mp + 4); }
                    if (kind != 2) { *(f32x4*)mp = o0; *(f32x4*)(mp + 4) = o1; }
                    else { u32x4 w; w.x = cvt_pk_bf16(o0[0], o0[1]); w.y = cvt_pk_bf16(o0[2], o0[3]); w.z = cvt_pk_bf16(o1[0], o1[1]); w.w = cvt_pk_bf16(o1[2], o1[3]);
                        *(u32x4*)(MIX + row * D + col0 + bj * 128) = w; }
                } }
    }
};
struct SchedMix {
    int G, c; const char *AIN, *CIN, *PIN, *WA, *WC, *WP;
    __device__ __forceinline__ bool next(int i, gm::Unit& u) const {
        const int rnd = i / 3, ty = i - rnd * 3; const int L = rnd * G + c; if (L >= 128 * 4) return false;
        int pm, pn; gm::tile_map(L, 128, 4, pm, pn);
        u.pm = pm; u.pn = pn; u.kind = ty; u.aux = 0;
        if (ty == 0) { u.A = AIN + (size_t)pm * gm::TSTEP; u.B = WA + (size_t)pn * gm::TSTEP; u.nt = 16; }
        else if (ty == 1) { u.A = CIN + (size_t)pm * gm::TSTEP; u.B = WC + (size_t)pn * gm::TSTEP; u.nt = 16; }
        else { u.A = PIN + (size_t)pm * gm::TSTEP + pn * 512; u.B = WP + (size_t)pn * gm::TSTEP + pn * 512; u.nt = 4; }
        return true;
    }
    __device__ __forceinline__ unsigned row_off(const gm::Unit&, int) const { return 0u; }
};

struct EpiOut {
    const float* xin; float* xout; const float* g1;
    __device__ __forceinline__ void operator()(const Acc& acc, const gm::Unit& u, int wr, int wc, int fr, int fq) const {
        const int row0 = u.pm * 256 + wr * 64 + fr, col0 = u.pn * 256 + wc * 32 + 8 * fq; const int b = u.pm / 16;
        f32x4 gv[2][2];
#pragma unroll
        for (int bj = 0; bj < 2; ++bj)
#pragma unroll
            for (int n = 0; n < 2; ++n) gv[bj][n] = *(const f32x4*)(g1 + (size_t)b * 6 * D + col0 + bj * 128 + 4 * n);
#pragma unroll
        for (int ai = 0; ai < 2; ++ai)
#pragma unroll
            for (int m = 0; m < 4; ++m) { const size_t off = (size_t)(row0 + ai * 128 + m * 16) * D + col0;
#pragma unroll
                for (int bj = 0; bj < 2; ++bj) {
                    const f32x4 x0 = *(const f32x4*)(xin + off + bj * 128), x1 = *(const f32x4*)(xin + off + bj * 128 + 4);
                    *(f32x4*)(xout + off + bj * 128) = x0 + gv[bj][0] * acc[ai][bj][m][0];
                    *(f32x4*)(xout + off + bj * 128 + 4) = x1 + gv[bj][1] * acc[ai][bj][m][1]; } }
    }
};
struct SchedOut {
    int G, c; const char *MIXP, *WO;
    __device__ __forceinline__ bool next(int i, gm::Unit& u) const {
        const int L = i * G + c; if (L >= 128 * 4) return false;
        int pm, pn; gm::tile_map(L, 128, 4, pm, pn);
        u.pm = pm; u.pn = pn; u.kind = 0; u.aux = 0; u.nt = 16; u.A = MIXP + (size_t)pm * gm::TSTEP; u.B = WO + (size_t)pn * gm::TSTEP;
        return true;
    }
    __device__ __forceinline__ unsigned row_off(const gm::Unit&, int) const { return 0u; }
};

struct SchedMoe {
    int NG, r, x, npn; const LAS int* tb;
    const char* Abase; const char* Wbase; unsigned wstride;
    const int* LIST; bool gather;
    __device__ __forceinline__ bool next(int i, gm::Unit& u) const {
        const int j = i * NG + r; int mt = j / npn; const int pn = j - mt * npn;
#define TB(i) __builtin_amdgcn_readfirstlane(tb[i])
        int e = x; int T = TB(e);
        if (mt >= T) { mt -= T; e += 8; T = TB(e);
            if (mt >= T) { mt -= T; e += 8; T = TB(e);
                if (mt >= T) { mt -= T; e += 8; T = TB(e); if (mt >= T) return false; } } }
        u.aux = e; u.pn = pn; u.nt = 16; u.kind = TB(64 + e) - 256 * mt;
        const int arow = TB(32 + e) + 256 * mt;
        if (gather) { u.A = Abase; u.pm = arow; u.B = Wbase + (size_t)e * wstride + (size_t)pn * gm::TSTEP; }
        else { u.A = Abase + (size_t)arow * gm::PITCH; u.pm = 256 * mt; u.B = Wbase + (size_t)e * wstride + (size_t)pn * gm::TSTEP; }
        return true;
    }
    __device__ __forceinline__ unsigned row_off(const gm::Unit& u, int rr) const {
        const int mt256 = u.pm - TB(32 + u.aux);
        const int slot = (rr < u.kind) ? LIST[(size_t)u.aux * NTOK + mt256 + rr] : 0;
        return (unsigned)(slot >> 2) * gm::PITCH;
    }
};
struct EpiGU {
    bf16* ACT; const float* bgu;
    __device__ __forceinline__ void operator()(const Acc& acc, const gm::Unit& u, int wr, int wc, int fr, int fq) const {
        const int e = u.aux, f0 = u.pn * 128 + wc * 32 + 8 * fq; const size_t arow0 = (size_t)u.pm + wr * 64 + fr;
        f32x4 bg[2], bu[2];
#pragma unroll
        for (int n = 0; n < 2; ++n) { bg[n] = *(const f32x4*)(bgu + (size_t)e * 2 * FF + f0 + 4 * n); bu[n] = *(const f32x4*)(bgu + (size_t)e * 2 * FF + FF + f0 + 4 * n); }
#pragma unroll
        for (int ai = 0; ai < 2; ++ai)
#pragma unroll
            for (int m = 0; m < 4; ++m) { float o[8];
#pragma unroll
                for (int j = 0; j < 8; ++j) { float g = acc[ai][0][m][j >> 2][j & 3] + bg[j >> 2][j & 3], up = acc[ai][1][m][j >> 2][j & 3] + bu[j >> 2][j & 3];
                    g = fminf(g, 7.0f); up = fminf(fmaxf(up, -7.0f), 7.0f);
                    const float glu = g * __builtin_amdgcn_rcpf(1.0f + __builtin_amdgcn_exp2f(-1.702f * 1.44269504089f * g));
                    o[j] = (up + 1.0f) * glu; }
                u32x4 w; w.x = cvt_pk_bf16(o[0], o[1]); w.y = cvt_pk_bf16(o[2], o[3]); w.z = cvt_pk_bf16(o[4], o[5]); w.w = cvt_pk_bf16(o[6], o[7]);
                *(u32x4*)(ACT + (arow0 + ai * 128 + m * 16) * FF + f0) = w; }
    }
};
struct EpiDown {
    bf16* YB; const float* bdn; const int* LIST; const float* WL;
    __device__ __forceinline__ void operator()(const Acc& acc, const gm::Unit& u, int wr, int wc, int fr, int fq) const {
        const int e = u.aux, col0 = u.pn * 256 + wc * 32 + 8 * fq, nvalid = u.kind; const size_t lbase = (size_t)e * NTOK + u.pm;
        f32x4 bd[2][2];
#pragma unroll
        for (int bj = 0; bj < 2; ++bj)
#pragma unroll
            for (int n = 0; n < 2; ++n) bd[bj][n] = *(const f32x4*)(bdn + (size_t)e * D + col0 + bj * 128 + 4 * n);
#pragma unroll
        for (int ai = 0; ai < 2; ++ai)
#pragma unroll
            for (int m = 0; m < 4; ++m) { const int r = wr * 64 + fr + ai * 128 + m * 16;
                if (r < nvalid) { const int slot = LIST[lbase + r]; const float w = WL[lbase + r];
#pragma unroll
                    for (int bj = 0; bj < 2; ++bj) { const f32x4 y0 = (acc[ai][bj][m][0] + bd[bj][0]) * w, y1 = (acc[ai][bj][m][1] + bd[bj][1]) * w;
                        u32x4 o; o.x = cvt_pk_bf16(y0[0], y0[1]); o.y = cvt_pk_bf16(y0[2], y0[3]); o.z = cvt_pk_bf16(y1[0], y1[1]); o.w = cvt_pk_bf16(y1[2], y1[3]);
                        *(u32x4*)(YB + (size_t)slot * D + col0 + bj * 128) = o; } } }
    }
};

__device__ __forceinline__ void transpose_tile(const float* W, int N, int k0, int n0, bf16* WT, int drow0, int dcol0, LAS float* scr, int lane) {
#pragma unroll 4
    for (int i = 0; i < 16; ++i) { const int kk = i * 4 + (lane >> 4); const f32x4 v = *(const f32x4*)(W + (size_t)(k0 + kk) * N + n0 + 4 * (lane & 15));
        LAS float* p = scr + kk * 65 + 4 * (lane & 15); p[0] = v.x; p[1] = v.y; p[2] = v.z; p[3] = v.w; }
    asm volatile("s_waitcnt lgkmcnt(0)" ::: "memory");
    const int c = lane & 7;
#pragma unroll
    for (int j = 0; j < 8; ++j) { const int n = (lane >> 3) + 8 * j; const LAS float* s = scr + (8 * c) * 65 + n;
        u32x4 o; o.x = cvt_pk_bf16(s[0 * 65], s[1 * 65]); o.y = cvt_pk_bf16(s[2 * 65], s[3 * 65]); o.z = cvt_pk_bf16(s[4 * 65], s[5 * 65]); o.w = cvt_pk_bf16(s[6 * 65], s[7 * 65]);
        *(u32x4*)(WT + (size_t)(drow0 + n0 + n) * 1024 + dcol0 + k0 + 8 * c) = o; }
    asm volatile("s_waitcnt lgkmcnt(0)" ::: "memory");
}
__device__ __forceinline__ void p0_prologue(Frame& F) {
    FRESH_IDS(F);
    LAS float* scr = (LAS float*)(F.lds + F.wave * 16640);
    const int gw = F.bid * NWAVES + F.wave, NGW = F.G * NWAVES;
    float* mods = WSP(float, WS_MODS);
    for (int task = gw; task < 48 * 8; task += NGW) {
        const int cg = task >> 3, ks = task & 7, l = cg / 24, c0 = (cg % 24) * 256 + 4 * F.lane;
        const float* cond = FIN(1); const float* aw = FIN(3) + (size_t)l * D * 6 * D + c0;
        f32x4 a[NB];
#pragma unroll
        for (int b = 0; b < NB; ++b) a[b] = (f32x4){0.f, 0.f, 0.f, 0.f};
        for (int k = ks * 128; k < ks * 128 + 128; ++k) { const f32x4 w = *(const f32x4*)(aw + (size_t)k * 6 * D);
#pragma unroll
            for (int b = 0; b < NB; ++b) { const float cv = cond[b * D + k]; const float s = cv * __builtin_amdgcn_rcpf(1.0f + __builtin_amdgcn_exp2f(-1.44269504089f * cv)); a[b] += w * s; } }
        if (ks == 0) { const f32x4 bb = *(const f32x4*)(FIN(4) + (size_t)l * 6 * D + c0);
#pragma unroll
            for (int b = 0; b < NB; ++b) a[b] += bb; }
#pragma unroll
        for (int b = 0; b < NB; ++b) { float* mp = mods + ((size_t)l * NB + b) * 6 * D + c0; atomicAdd(mp, a[b].x); atomicAdd(mp + 1, a[b].y); atomicAdd(mp + 2, a[b].z); atomicAdd(mp + 3, a[b].w); }
    }
    constexpr int I_GU = 16 * 32, I_DN = 16 * 16, I_IN = 16 * 144, I_SQ = 16 * 16, I_PL = 4 * 4;
    constexpr int N_GU = DEPTH * NE * I_GU, N_DN = DEPTH * NE * I_DN, N_IN = DEPTH * I_IN, N_SQ = DEPTH * I_SQ, N_PL = DEPTH * 4 * I_PL;
    constexpr int NITEMS = N_GU + N_DN + N_IN + 3 * N_SQ + N_PL;
    for (int it = gw; it < NITEMS; it += NGW) {
        int r = it;
        if (r < N_GU) { const int mat = r / I_GU, q = r % I_GU, kb = q / 32, nb = q % 32, n0 = 64 * nb, half = n0 / FF, f0 = n0 % FF;
            transpose_tile(FIN(18) + (size_t)mat * D * 2 * FF, 2 * FF, 64 * kb, n0, WSP(bf16, WS_WTGU) + (size_t)mat * 2 * FF * D, (f0 / 128) * 256 + 128 * half + (f0 % 128) - n0, 0, scr, F.lane); continue; }
        r -= N_GU;
        if (r < N_DN) { const int mat = r / I_DN, q = r % I_DN, kb = q / 16, nb = q % 16;
            transpose_tile(FIN(20) + (size_t)mat * FF * D, D, 64 * kb, 64 * nb, WSP(bf16, WS_WTDN) + (size_t)mat * D * FF, 0, 0, scr, F.lane); continue; }
        r -= N_DN;
        if (r < N_IN) { const int mat = r / I_IN, q = r % I_IN, kb = q / 144, nb = q % 144;
            transpose_tile(FIN(5) + (size_t)mat * D * INC, INC, 64 * kb, 64 * nb, WSP(bf16, WS_WTIN) + (size_t)mat * INC * D, 0, 0, scr, F.lane); continue; }
        r -= N_IN;
        if (r < 3 * N_SQ) { const int which = r / N_SQ, q2 = r % N_SQ, mat = q2 / I_SQ, q = q2 % I_SQ, kb = q / 16, nb = q % 16;
            const float* src = (which == 0 ? FIN(9) : (which == 1 ? FIN(13) : FIN(14))) + (size_t)mat * D * D;
            bf16* dst = WSP(bf16, which == 0 ? WS_WTA : (which == 1 ? WS_WTC : WS_WTO)) + (size_t)mat * D * D;
            transpose_tile(src, D, 64 * kb, 64 * nb, dst, 0, 0, scr, F.lane); continue; }
        r -= 3 * N_SQ;
        { const int mat = r / I_PL, q = r % I_PL, kb = q / 4, nb = q % 4, l = mat / 4, g = mat % 4;
            transpose_tile(FIN(10) + (size_t)mat * 256 * 256, 256, 64 * kb, 64 * nb, WSP(bf16, WS_WTPOOL) + (size_t)l * D * D, g * 256, g * 256, scr, F.lane); }
    }
}

template <int MODE>
__device__ __forceinline__ void norm_rows(Frame& F, const float* xin, const bf16* yb, const float* g2, float* xst, const float* gn, const float* sc, const float* sh, bf16* hout, float* fout) {
    FRESH_IDS(F);
    const int gw = F.bid * NWAVES + F.wave, NGW = F.G * NWAVES;
    for (int row = gw; row < NTOK; row += NGW) {
        const int b = row / SEQ; const size_t ro = (size_t)row * D;
        f32x4 v[4]; float s = 0.f;
#pragma unroll
        for (int j = 0; j < 4; ++j) { const int col = 256 * j + 4 * F.lane; v[j] = *(const f32x4*)(xin + ro + col);
            if (yb) { f32x4 ys = {0.f, 0.f, 0.f, 0.f};
#pragma unroll
                for (int k = 0; k < TOPK; ++k) { const u32x2 w = *(const u32x2*)(yb + ((size_t)row * TOPK + k) * D + col); ys += unpack_lo4(w); }
                v[j] += *(const f32x4*)(g2 + (size_t)b * 6 * D + col) * ys;
                if (xst) *(f32x4*)(xst + ro + col) = v[j]; }
            s += (v[j].x * v[j].x + v[j].y * v[j].y) + (v[j].z * v[j].z + v[j].w * v[j].w); }
        const float rstd = 1.0f / sqrtf(wave_sum(s) * (1.0f / D) + RMS_EPS);
#pragma unroll
        for (int j = 0; j < 4; ++j) { const int col = 256 * j + 4 * F.lane; const f32x4 g = *(const f32x4*)(gn + col);
            if (MODE == 0) { const f32x4 scv = *(const f32x4*)(sc + (size_t)b * 6 * D + col), shv = *(const f32x4*)(sh + (size_t)b * 6 * D + col);
                const f32x4 o = v[j] * rstd * g * (scv + 1.0f) + shv; u32x2 w; w.x = cvt_pk_bf16(o.x, o.y); w.y = cvt_pk_bf16(o.z, o.w); *(u32x2*)(hout + ro + col) = w; }
            else { *(f32x4*)(fout + ro + col) = v[j] * rstd * g; } }
    }
}

__device__ __forceinline__ void router_prep(Frame& F) {
    FRESH_IDS(F);
    const float* mods = WSP(float, WS_MODS); float* rwt = WSP(float, WS_RWT); float* rb = WSP(float, WS_RBIAS);
    const int gt = F.bid * NTHREADS + F.tid, NGT = F.G * NTHREADS;
    for (int i = gt; i < DEPTH * NB * NE * D; i += NGT) { const int k = i % D, e = (i / D) % NE, b = (i / (D * NE)) % NB, l = i / (D * NE * NB);
        rwt[i] = FIN(15)[l * D + k] * (1.0f + mods[((size_t)l * NB + b) * 6 * D + 4 * D + k]) * FIN(16)[((size_t)l * D + k) * NE + e]; }
    const int gw = F.bid * NWAVES + F.wave, NGW = F.G * NWAVES;
    for (int o = gw; o < DEPTH * NB * NE; o += NGW) { const int e = o % NE, b = (o / NE) % NB, l = o / (NE * NB); float s = 0.f;
        for (int k = F.lane; k < D; k += 64) s += mods[((size_t)l * NB + b) * 6 * D + 3 * D + k] * FIN(16)[((size_t)l * D + k) * NE + e];
        s = wave_sum(s); if (F.lane == 0) rb[o] = s + FIN(17)[l * NE + e]; }
}

__device__ __forceinline__ void mixer_prep(Frame& F, int l) {
    FRESH_IDS(F);
    const bf16* Z = WSP(bf16, WS_Z); const bf16* VT = WSP(bf16, WS_VT); const float* vss = WSP(float, WS_VSS) + (size_t)l * NTOK;
    bf16* AIN = WSP(bf16, WS_AIN); bf16* CIN = WSP(bf16, WS_CIN); bf16* PIN = WSP(bf16, WS_PIN);
    const float* convw = FIN(12) + (size_t)l * 3 * D; const float* gng = FIN(6) + (size_t)l * D; const float* ws = FIN(7) + (size_t)l * 8 * CHUNK * CHUNK; const float* bs = FIN(8) + (size_t)l * 8 * CHUNK;
    LAS unsigned char* Aimg = F.lds; LAS unsigned char* Bimg = F.lds + 32768; LAS float* rs = (LAS float*)(F.lds + 65536);
    const int tid = F.tid, lane = F.lane, wave = F.wave;
    for (int chunk = F.bid; chunk < NTOK / CHUNK; chunk += F.G) {
        const int tok0 = chunk * CHUNK, pos0 = tok0 % SEQ;
        {
            const int cg = tid & 127, rsq = tid >> 7, c0 = 8 * cg, t0 = 32 * rsq;
            float w0[8], w1[8], w2[8];
#pragma unroll
            for (int j = 0; j < 8; ++j) { w0[j] = convw[c0 + j]; w1[j] = convw[D + c0 + j]; w2[j] = convw[2 * D + c0 + j]; }
            float p2[8], p1[8];
#pragma unroll
            for (int j = 0; j < 8; ++j) { p2[j] = 0.f; p1[j] = 0.f; }
            if (pos0 + t0 >= 2) {
#pragma unroll
                for (int q = 0; q < 2; ++q) { const size_t zo = (size_t)(tok0 + t0 - 2 + q) * INC + c0; const u32x4 xv = *(const u32x4*)(Z + zo + Z_X), cv = *(const u32x4*)(Z + zo + Z_C);
                    const unsigned xa[4] = {xv.x, xv.y, xv.z, xv.w}, ca[4] = {cv.x, cv.y, cv.z, cv.w};
#pragma unroll
                    for (int j = 0; j < 4; ++j) { const float a = bflo(xa[j]) * bflo(ca[j]), bq = bfhi(xa[j]) * bfhi(ca[j]);
                        if (q == 0) { p2[2 * j] = a; p2[2 * j + 1] = bq; } else { p1[2 * j] = a; p1[2 * j + 1] = bq; } } }
            }
            const int pw = 2 << (cg >> 5);
            float sw[8];
#pragma unroll
            for (int j = 0; j < 8; ++j) sw[j] = 0.f;
            for (int q = 1; q < pw; ++q) { if (pos0 + t0 - q >= 0) { const u32x4 pv = *(const u32x4*)(Z + (size_t)(tok0 + t0 - q) * INC + Z_P + c0); const unsigned pa[4] = {pv.x, pv.y, pv.z, pv.w};
#pragma unroll
                    for (int j = 0; j < 4; ++j) { sw[2 * j] += bflo(pa[j]); sw[2 * j + 1] += bfhi(pa[j]); } } }
            for (int t = t0; t < t0 + 32; ++t) {
                const size_t zo = (size_t)(tok0 + t) * INC + c0; const int pos = pos0 + t;
                const u32x4 xv = *(const u32x4*)(Z + zo + Z_X), cv = *(const u32x4*)(Z + zo + Z_C), bv = *(const u32x4*)(Z + zo + Z_B), pv = *(const u32x4*)(Z + zo + Z_P);
                const unsigned xa[4] = {xv.x, xv.y, xv.z, xv.w}, ca[4] = {cv.x, cv.y, cv.z, cv.w}, ba[4] = {bv.x, bv.y, bv.z, bv.w}, pa[4] = {pv.x, pv.y, pv.z, pv.w};
                float zc[8], o[8], pf[8];
#pragma unroll
                for (int j = 0; j < 4; ++j) { zc[2 * j] = bflo(xa[j]) * bflo(ca[j]); zc[2 * j + 1] = bfhi(xa[j]) * bfhi(ca[j]); pf[2 * j] = bflo(pa[j]); pf[2 * j + 1] = bfhi(pa[j]); }
#pragma unroll
                for (int j = 0; j < 8; ++j) { const float cvv = w0[j] * p2[j] + w1[j] * p1[j] + w2[j] * zc[j]; const float bb = (j & 1) ? bfhi(ba[j >> 1]) : bflo(ba[j >> 1]); o[j] = bb * cvv; p2[j] = p1[j]; p1[j] = zc[j]; }
                u32x4 w; w.x = cvt_pk_bf16(o[0], o[1]); w.y = cvt_pk_bf16(o[2], o[3]); w.z = cvt_pk_bf16(o[4], o[5]); w.w = cvt_pk_bf16(o[6], o[7]);
                *(u32x4*)(CIN + (size_t)(tok0 + t) * D + c0) = w;
                const float inv = 1.0f / (float)((pos + 1) < pw ? (pos + 1) : pw);
#pragma unroll
                for (int j = 0; j < 8; ++j) { sw[j] += pf[j]; o[j] = sw[j] * inv - pf[j]; }
                w.x = cvt_pk_bf16(o[0], o[1]); w.y = cvt_pk_bf16(o[2], o[3]); w.z = cvt_pk_bf16(o[4], o[5]); w.w = cvt_pk_bf16(o[6], o[7]);
                *(u32x4*)(PIN + (size_t)(tok0 + t) * D + c0) = w;
                if (pos - (pw - 1) >= 0) { const u32x4 qv = *(const u32x4*)(Z + (size_t)(tok0 + t - (pw - 1)) * INC + Z_P + c0); const unsigned qa[4] = {qv.x, qv.y, qv.z, qv.w};
#pragma unroll
                    for (int j = 0; j < 4; ++j) { sw[2 * j] -= bflo(qa[j]); sw[2 * j + 1] -= bfhi(qa[j]); } }
            }
        }
        if (tid < CHUNK) rs[tid] = 1.0f / sqrtf(vss[tok0 + tid] * (1.0f / D) + RMS_EPS);
        __syncthreads();
        for (int h = 0; h < 8; ++h) {
#pragma unroll
            for (int i = 0; i < 4; ++i) { const int q = tid + 512 * i, t = q >> 4, kc = q & 15;
                u32x4 w = {0u, 0u, 0u, 0u};
                if (8 * kc <= t) { const float* wp = ws + ((size_t)h * CHUNK + t) * CHUNK + 8 * kc; const f32x4 a = *(const f32x4*)wp, b2 = *(const f32x4*)(wp + 4);
                    float v[8] = {a.x, a.y, a.z, a.w, b2.x, b2.y, b2.z, b2.w};
#pragma unroll
                    for (int j = 0; j < 8; ++j) v[j] = (8 * kc + j <= t) ? v[j] * rs[8 * kc + j] : 0.f;
                    w.x = cvt_pk_bf16(v[0], v[1]); w.y = cvt_pk_bf16(v[2], v[3]); w.z = cvt_pk_bf16(v[4], v[5]); w.w = cvt_pk_bf16(v[6], v[7]); }
                *(LAS u32x4*)(Aimg + t * 256 + ((kc ^ (t & 15)) << 4)) = w;
                const int d = t;
                const u32x4 gv = *(const u32x4*)(VT + (size_t)(h * CHUNK + d) * NTOK + tok0 + 8 * kc);
                *(LAS u32x4*)(Bimg + d * 256 + ((kc ^ (d & 15)) << 4)) = gv; }
            __syncthreads();
            const int wr = wave >> 1, wc = wave & 1, fr = lane & 15, fq = lane >> 4;
            f32x4 acc[2][4];
#pragma unroll
            for (int m = 0; m < 2; ++m)
#pragma unroll
                for (int n = 0; n < 4; ++n) acc[m][n] = (f32x4){0.f, 0.f, 0.f, 0.f};
            for (int kk = 0; kk <= wr; ++kk) {
                bf16x8 a[2], bq[4];
#pragma unroll
                for (int m = 0; m < 2; ++m) { const int row = 32 * wr + 16 * m + fr; a[m] = *(const LAS bf16x8*)(Aimg + row * 256 + (((4 * kk + fq) ^ (row & 15)) << 4)); }
#pragma unroll
                for (int n = 0; n < 4; ++n) { const int row = 64 * wc + 16 * n + fr; bq[n] = *(const LAS bf16x8*)(Bimg + row * 256 + (((4 * kk + fq) ^ (row & 15)) << 4)); }
#pragma unroll
                for (int m = 0; m < 2; ++m)
#pragma unroll
                    for (int n = 0; n < 4; ++n) acc[m][n] = __builtin_amdgcn_mfma_f32_16x16x32_bf16(bq[n], a[m], acc[m][n], 0, 0, 0);
            }
#pragma unroll
            for (int m = 0; m < 2; ++m) { const int t = 32 * wr + 16 * m + fr; const float bt = bs[h * CHUNK + t];
#pragma unroll
                for (int n = 0; n < 4; ++n) { const int col = h * CHUNK + 64 * wc + 16 * n + 4 * fq;
                    const f32x4 g = *(const f32x4*)(gng + col); const u32x2 uw = *(const u32x2*)(Z + (size_t)(tok0 + t) * INC + Z_U + col);
                    const f32x4 uu = unpack_lo4(uw); const f32x4 o = uu * (acc[m][n] * g + bt);
                    u32x2 w; w.x = cvt_pk_bf16(o.x, o.y); w.y = cvt_pk_bf16(o.z, o.w); *(u32x2*)(AIN + (size_t)(tok0 + t) * D + col) = w; } }
            __syncthreads();
        }
    }
}

__device__ __forceinline__ void router_phase(Frame& F, int l) {
    FRESH_IDS(F);
    const float* X = WSP(float, WS_XRES); const float* mods = WSP(float, WS_MODS) + (size_t)l * NB * 6 * D; const float* g2n = FIN(15) + (size_t)l * D;
    const float* rwt = WSP(float, WS_RWT) + (size_t)l * NB * NE * D; const float* rbias = WSP(float, WS_RBIAS) + (size_t)l * NB * NE;
    bf16* H = WSP(bf16, WS_H); int* LIST = WSP(int, WS_LIST); float* WL = WSP(float, WS_WLIST); unsigned* cnt = F.ctl + CW_CNT + l * NE;
    LAS float* lg = (LAS float*)(F.lds) + F.wave * (16 * 33);
    LAS float* rsd = (LAS float*)(F.lds + 17408) + F.wave * 16;
    LAS int* te = (LAS int*)(F.lds + 18432);
    LAS float* tw = (LAS float*)(F.lds + 20480);
    LAS unsigned* hist = (LAS unsigned*)(F.lds + 22528);
    LAS unsigned* base = (LAS unsigned*)(F.lds + 22656);
    const int lane = F.lane, tid = F.tid, q = lane >> 4, r = lane & 15;
    if (tid < 32) hist[tid] = 0u;
    __syncthreads();
    for (int tile = F.bid; tile < NTOK / 128; tile += F.G) {
        const int tok0 = tile * 128 + F.wave * 16, b = tok0 / SEQ;
        const float* xa = X + (size_t)(tok0 + r) * D + 4 * q;
        const float* w0 = rwt + ((size_t)b * NE + r) * D + 4 * q; const float* w1 = w0 + (size_t)16 * D;
        f32x4 acc0 = {0.f, 0.f, 0.f, 0.f}, acc1 = {0.f, 0.f, 0.f, 0.f}; float ss = 0.f;
#pragma unroll 4
        for (int j = 0; j < 64; ++j) { const f32x4 xv = *(const f32x4*)(xa + 16 * j), wa = *(const f32x4*)(w0 + 16 * j), wb = *(const f32x4*)(w1 + 16 * j);
            ss += (xv.x * xv.x + xv.y * xv.y) + (xv.z * xv.z + xv.w * xv.w);
            acc0 = __builtin_amdgcn_mfma_f32_16x16x4f32(xv.x, wa.x, acc0, 0, 0, 0); acc1 = __builtin_amdgcn_mfma_f32_16x16x4f32(xv.x, wb.x, acc1, 0, 0, 0);
            acc0 = __builtin_amdgcn_mfma_f32_16x16x4f32(xv.y, wa.y, acc0, 0, 0, 0); acc1 = __builtin_amdgcn_mfma_f32_16x16x4f32(xv.y, wb.y, acc1, 0, 0, 0);
            acc0 = __builtin_amdgcn_mfma_f32_16x16x4f32(xv.z, wa.z, acc0, 0, 0, 0); acc1 = __builtin_amdgcn_mfma_f32_16x16x4f32(xv.z, wb.z, acc1, 0, 0, 0);
            acc0 = __builtin_amdgcn_mfma_f32_16x16x4f32(xv.w, wa.w, acc0, 0, 0, 0); acc1 = __builtin_amdgcn_mfma_f32_16x16x4f32(xv.w, wb.w, acc1, 0, 0, 0); }
        ss += __shfl_xor(ss, 16); ss += __shfl_xor(ss, 32);
        const float rstd = 1.0f / sqrtf(ss * (1.0f / D) + RMS_EPS);
#pragma unroll
        for (int g = 0; g < 4; ++g) { lg[(4 * q + g) * 33 + r] = acc0[g]; lg[(4 * q + g) * 33 + 16 + r] = acc1[g]; }
        if (lane < 16) rsd[lane] = rstd;
        __syncthreads();
        if (lane < 16) {
            float v[NE]; const float rsv = rsd[lane];
#pragma unroll
            for (int e = 0; e < NE; ++e) v[e] = lg[lane * 33 + e] * rsv + rbias[b * NE + e];
            float tv[TOPK]; int ti[TOPK];
#pragma unroll
            for (int k = 0; k < TOPK; ++k) { float best = v[0]; int bi = 0;
#pragma unroll
                for (int e = 1; e < NE; ++e) { if (v[e] > best) { best = v[e]; bi = e; } }
                tv[k] = best; ti[k] = bi;
#pragma unroll
                for (int e = 0; e < NE; ++e) v[e] = (e == bi) ? -3.0e38f : v[e]; }
            float p[TOPK], ps = 0.f;
#pragma unroll
            for (int k = 0; k < TOPK; ++k) { p[k] = __expf(tv[k] - tv[0]); ps += p[k]; }
            const float inv = 1.0f / ps;
#pragma unroll
            for (int k = 0; k < TOPK; ++k) { te[(F.wave * 16 + lane) * 4 + k] = ti[k]; tw[(F.wave * 16 + lane) * 4 + k] = p[k] * inv; }
        }
        for (int i = 0; i < 16; ++i) { const float rsv = rsd[i]; const size_t ro = (size_t)(tok0 + i) * D;
#pragma unroll
            for (int j = 0; j < 4; ++j) { const int col = 256 * j + 4 * lane; const f32x4 xv = *(const f32x4*)(X + ro + col), g = *(const f32x4*)(g2n + col);
                const f32x4 scv = *(const f32x4*)(mods + (size_t)b * 6 * D + 4 * D + col), shv = *(const f32x4*)(mods + (size_t)b * 6 * D + 3 * D + col);
                const f32x4 o = xv * rsv * g * (scv + 1.0f) + shv; u32x2 w; w.x = cvt_pk_bf16(o.x, o.y); w.y = cvt_pk_bf16(o.z, o.w); *(u32x2*)(H + ro + col) = w; } }
        __syncthreads();
        const int t = tid >> 2, k = tid & 3, e = te[t * 4 + k];
        const unsigned rl = __hip_atomic_fetch_add(&hist[e], 1u, __ATOMIC_RELAXED, __HIP_MEMORY_SCOPE_WORKGROUP);
        __syncthreads();
        if (tid < 32) base[tid] = __hip_atomic_fetch_add(cnt + tid, hist[tid], RLX_AGENT);
        __syncthreads();
        const unsigned pos = base[e] + rl;
        LIST[(size_t)e * NTOK + pos] = (tile * 128 + t) * 4 + k; WL[(size_t)e * NTOK + pos] = tw[t * 4 + k];
        __syncthreads();
        if (tid < 32) hist[tid] = 0u;
        __syncthreads();
    }
}

__device__ __forceinline__ void moe_tables(Frame& F, int l) {
    FRESH_IDS(F);
    LAS int* tb = (LAS int*)(F.lds + LDSCTL_OFF + 256);
    __syncthreads();
    if (F.tid == 0) { int ps = 0; for (int e = 0; e < NE; ++e) { const int c = (int)__hip_atomic_load(F.ctl + CW_CNT + l * NE + e, RLX_AGENT); const int T = (c + 255) >> 8; tb[e] = T; tb[32 + e] = ps; tb[64 + e] = c; ps += T * 256; } }
    __syncthreads();
}

__global__ void __launch_bounds__(NTHREADS, 2) fwd_kernel(Args args) {
    extern __shared__ __attribute__((aligned(16))) unsigned char lds_raw[];
    Frame F;
    F.lds = (LAS unsigned char*)lds_raw; F.ws = args.ws; F.ctl = (unsigned*)(args.ws + WS_CTL);
    F.tid = threadIdx.x; F.lane = F.tid & 63; F.wave = __builtin_amdgcn_readfirstlane(F.tid >> 6); F.G = gridDim.x; F.bid = blockIdx.x;
    F.a = &args;
    for (int u = F.tid; u < 256; u += NTHREADS) ((LAS unsigned*)(F.lds + LDSCTL_OFF))[u] = 0u;
    __syncthreads();
    XcdBarrier bar; bar.bar = F.ctl + CW_BAR; bar.x = 0; bar.st = nullptr;
    if (N_LAUNCHES == 1) bar = xcd_barrier_post(F.ctl + CW_BAR, (volatile LAS unsigned*)(F.lds + LDSCTL_OFF + 16));
    const int lo = args.ph_lo, hi = args.ph_hi;
#ifdef ONLY_PH
#define IN(k) ((((k) < 2 ? (k) : 2 + ((k) - 2) % 8) == ONLY_PH) && lo <= (k) && (k) < hi)
#else
#define IN(k) (lo <= (k) && (k) < hi)
#endif
#define SEAM(k) do { if (IN(k) && IN((k) + 1)) xcd_barrier(bar); } while (0)

    if (IN(0)) { p0_prologue(F); } SEAM(0);
    if (IN(1)) {
        const float* mods = WSP(float, WS_MODS);
        norm_rows<0>(F, FIN(0), nullptr, nullptr, nullptr, FIN(2), mods + D, mods, WSP(bf16, WS_H), nullptr);
        router_prep(F);
    } SEAM(1);

    for (int l = 0; l < DEPTH; ++l) {
        const int pb = 2 + 8 * l;
        const float* mods = WSP(float, WS_MODS) + (size_t)l * NB * 6 * D;
        if (IN(pb + 0)) {
            SchedZ S{F.G, F.bid, (const char*)WSP(bf16, WS_H), (const char*)(WSP(bf16, WS_WTIN) + (size_t)l * INC * D)};
            EpiZ E{WSP(bf16, WS_Z), WSP(bf16, WS_VT), WSP(float, WS_VSS) + (size_t)l * NTOK};
            gm::gemm_phase<EpiZ, SchedZ, false>(F.lds, S, E);
        } SEAM(pb + 0);
        if (IN(pb + 1)) { mixer_prep(F, l); } SEAM(pb + 1);
        if (IN(pb + 2)) {
            SchedMix S{F.G, F.bid, (const char*)WSP(bf16, WS_AIN), (const char*)WSP(bf16, WS_CIN), (const char*)WSP(bf16, WS_PIN),
                       (const char*)(WSP(bf16, WS_WTA) + (size_t)l * D * D), (const char*)(WSP(bf16, WS_WTC) + (size_t)l * D * D), (const char*)(WSP(bf16, WS_WTPOOL) + (size_t)l * D * D)};
            EpiMix E{WSP(bf16, WS_Z), WSP(float, WS_MIXF), WSP(bf16, WS_MIX), FIN(11) + (size_t)l * D};
            gm::gemm_phase<EpiMix, SchedMix, false>(F.lds, S, E);
        } SEAM(pb + 2);
        if (IN(pb + 3)) {
            SchedOut S{F.G, F.bid, (const char*)WSP(bf16, WS_MIX), (const char*)(WSP(bf16, WS_WTO) + (size_t)l * D * D)};
            EpiOut E{l == 0 ? FIN(0) : WSP(float, WS_XRES), WSP(float, WS_XRES), mods + 2 * D};
            gm::gemm_phase<EpiOut, SchedOut, false>(F.lds, S, E);
        } SEAM(pb + 3);
        if (IN(pb + 4)) { router_phase(F, l); } SEAM(pb + 4);
        if (IN(pb + 5)) {
            moe_tables(F, l);
            SchedMoe S{F.G / 8, F.bid / 8, F.bid % 8, 8, (const LAS int*)(F.lds + LDSCTL_OFF + 256), (const char*)WSP(bf16, WS_H), (const char*)(WSP(bf16, WS_WTGU) + (size_t)l * NE * 2 * FF * D), (unsigned)(2 * FF * D * 2), WSP(int, WS_LIST), true};
            EpiGU E{WSP(bf16, WS_ACT), FIN(19) + (size_t)l * NE * 2 * FF};
            gm::gemm_phase<EpiGU, SchedMoe, true>(F.lds, S, E);
        } SEAM(pb + 5);
        if (IN(pb + 6)) {
            moe_tables(F, l);
            SchedMoe S{F.G / 8, F.bid / 8, F.bid % 8, 4, (const LAS int*)(F.lds + LDSCTL_OFF + 256), (const char*)WSP(bf16, WS_ACT), (const char*)(WSP(bf16, WS_WTDN) + (size_t)l * NE * D * FF), (unsigned)(D * FF * 2), WSP(int, WS_LIST), false};
            EpiDown E{WSP(bf16, WS_YB), FIN(21) + (size_t)l * NE * D, WSP(int, WS_LIST), WSP(float, WS_WLIST)};
            gm::gemm_phase<EpiDown, SchedMoe, false>(F.lds, S, E);
        } SEAM(pb + 6);
        if (IN(pb + 7)) {
            if (l + 1 < DEPTH) { const float* m2 = WSP(float, WS_MODS) + (size_t)(l + 1) * NB * 6 * D;
                norm_rows<0>(F, WSP(float, WS_XRES), WSP(bf16, WS_YB), mods + 5 * D, WSP(float, WS_XRES), FIN(2) + (size_t)(l + 1) * D, m2 + D, m2, WSP(bf16, WS_H), nullptr); }
            else norm_rows<1>(F, WSP(float, WS_XRES), WSP(bf16, WS_YB), mods + 5 * D, nullptr, FIN(22), nullptr, nullptr, nullptr, F.a->out);
        } SEAM(pb + 7);
    }
#undef IN
#undef SEAM
}

extern "C" void kernel_launch(void* const* d_in, const int* in_sizes, int n_in, void* d_out, int out_size, void* d_ws, size_t ws_size, hipStream_t stream) {
    static int grid = 0;
    if (grid == 0) {
        if (n_in != 23 || out_size != NTOK * D || ws_size < WS_END) { fprintf(stderr, "kernel_launch: unexpected shapes (n_in %d out %d ws %zu)\n", n_in, out_size, ws_size); grid = -1; return; }
        int dev = 0, cus = 0, per_cu = 0;
        if (hipGetDevice(&dev) != hipSuccess || hipDeviceGetAttribute(&cus, hipDeviceAttributeMultiprocessorCount, dev) != hipSuccess) { grid = -1; return; }
        if (hipFuncSetAttribute((const void*)fwd_kernel, hipFuncAttributeMaxDynamicSharedMemorySize, LDS_BYTES) != hipSuccess) { fprintf(stderr, "kernel_launch: hipFuncSetAttribute failed\n"); grid = -1; return; }
        if (hipOccupancyMaxActiveBlocksPerMultiprocessor(&per_cu, (const void*)fwd_kernel, NTHREADS, LDS_BYTES) != hipSuccess || per_cu < 1) fprintf(stderr, "kernel_launch: occupancy query reports %d\n", per_cu);
        (void)hipGetLastError();
        grid = (cus / 8) * 8;
        if (grid > 256) grid = 256;
        if (grid < 8) { grid = -1; return; }
    }
    if (grid < 0) return;
    if (hipMemsetAsync((char*)d_ws + WS_CTL, 0, CTL_ZERO_BYTES, stream) != hipSuccess) return;
    Args a{};
    for (int i = 0; i < 23; ++i) a.in[i] = (const float*)d_in[i];
    a.out = (float*)d_out; a.ws = (unsigned char*)d_ws;
    for (int li = 0; li < N_LAUNCHES; ++li) {
        a.ph_lo = (N_LAUNCHES == 1) ? 0 : li; a.ph_hi = (N_LAUNCHES == 1) ? NPHASES : li + 1;
        hipLaunchKernelGGL(fwd_kernel, dim3(grid), dim3(NTHREADS), LDS_BYTES, stream, a);
        if (hipPeekAtLastError() != hipSuccess) { fprintf(stderr, "kernel_launch: launch %d failed\n", li); break; }
    }
}
```

```cpp
#include <hip/hip_runtime.h>
#include <cstdio>
#include <cstdint>

#ifndef MK_N_LAUNCHES
#define MK_N_LAUNCHES 1
#endif

#define GAS __attribute__((address_space(1)))
#define LAS __attribute__((address_space(3)))
typedef unsigned short bf16;
typedef short bf16x8 __attribute__((ext_vector_type(8)));
typedef float f32x4 __attribute__((ext_vector_type(4)));
typedef float f32x2 __attribute__((ext_vector_type(2)));
typedef unsigned u32x4 __attribute__((ext_vector_type(4)));
typedef unsigned u32x2 __attribute__((ext_vector_type(2)));

constexpr int D = 1024, NB = 8, SEQ = 4096, NTOK = NB * SEQ, DEPTH = 2, INC = 9216, NE = 32, TOPK = 4, FF = 1024, CHUNK = 128;
constexpr int Z_U = 0, Z_V = 1024, Z_P = 2048, Z_X = 3072, Z_B = 4096, Z_C = 5120, Z_GA = 6144, Z_GB = 7168, Z_GC = 8192;
constexpr float RMS_EPS = 1e-5f;
constexpr int NWAVES = 8, NTHREADS = NWAVES * 64;
constexpr int NPHASES = 2 + 8 * DEPTH;
constexpr int N_LAUNCHES = MK_N_LAUNCHES;
static_assert(N_LAUNCHES == 1 || N_LAUNCHES == NPHASES, "MK_N_LAUNCHES must be 1 or NPHASES");

constexpr size_t MiB = 1u << 20;
constexpr size_t WS_CTL = 0, CTL_ZERO_BYTES = 1 * MiB;
constexpr int CW_BAR = 4096;
constexpr int CW_CNT = 8192;
constexpr size_t WS_VSS = 256 * 1024;
constexpr size_t WS_MODS = 512 * 1024;
constexpr size_t WS_RWT = 1 * MiB;
constexpr size_t WS_RBIAS = 3 * MiB;
constexpr size_t WS_LIST = 4 * MiB;
constexpr size_t WS_WLIST = 8 * MiB;
constexpr size_t WS_WTPOOL = 12 * MiB;
constexpr size_t WS_WTA = 16 * MiB, WS_WTC = 20 * MiB, WS_WTO = 24 * MiB;
constexpr size_t WS_WTIN = 28 * MiB;
constexpr size_t WS_WTGU = 64 * MiB;
constexpr size_t WS_WTDN = 320 * MiB;
constexpr size_t WS_H = 448 * MiB;
constexpr size_t WS_VT = 512 * MiB;
constexpr size_t WS_AIN = 576 * MiB, WS_CIN = 640 * MiB, WS_PIN = 704 * MiB;
constexpr size_t WS_MIX = 768 * MiB;
constexpr size_t WS_XRES = 832 * MiB;
constexpr size_t WS_MIXF = 960 * MiB;
constexpr size_t WS_Z = 1088 * MiB;
constexpr size_t WS_ACT = WS_Z;
constexpr size_t WS_YB = WS_Z + 288 * MiB;
constexpr size_t WS_END = 1664 * MiB;

constexpr int RING_BYTES = 131072;
constexpr int LDS_BYTES = 147456;
constexpr int LDSCTL_OFF = LDS_BYTES - 1024;

#define RLX_AGENT __ATOMIC_RELAXED, __HIP_MEMORY_SCOPE_AGENT
__device__ __forceinline__ unsigned cvt_pk_bf16(float lo, float hi) { unsigned r; asm volatile("v_cvt_pk_bf16_f32 %0, %1, %2" : "=v"(r) : "v"(lo), "v"(hi)); return r; }
__device__ __forceinline__ float bflo(unsigned u) { return __uint_as_float(u << 16); }
__device__ __forceinline__ float bfhi(unsigned u) { return __uint_as_float(u & 0xffff0000u); }
__device__ __forceinline__ float wave_sum(float v) {
#pragma unroll
    for (int o = 1; o < 64; o <<= 1) v += __shfl_xor(v, o);
    return v;
}
__device__ __forceinline__ float sigmoidf_fast(float x) { return __builtin_amdgcn_rcpf(1.0f + __builtin_amdgcn_exp2f(-1.44269504089f * x)); }
__device__ __forceinline__ float gelu_tanh(float x) {
    const float t = x * (1.0f + 0.044715f * x * x);
    return x * __builtin_amdgcn_rcpf(1.0f + __builtin_amdgcn_exp2f(-2.30220818f * t));
}
__device__ __forceinline__ f32x4 unpack_lo4(u32x2 w) { return (f32x4){bflo(w.x), bfhi(w.x), bflo(w.y), bfhi(w.y)}; }

#define XB_TMO      128
#define XB_XCNT(j)  (256  + 64 * (j))
#define XB_XSUB(j)  (1280 + 64 * (j))
#define XB_XGEN(j)  (2304 + 64 * (j))
#define XB_TOP      3328
#define XB_TOPGEN   3392
#define XCD_BAR_WORDS 3456
#define XB_SPIN_CAP (1u << 18)
__device__ __forceinline__ unsigned xb_ld(unsigned* p)              { return __hip_atomic_load(p, __ATOMIC_RELAXED, __HIP_MEMORY_SCOPE_AGENT); }
__device__ __forceinline__ unsigned xb_add(unsigned* p, unsigned v) { return __hip_atomic_fetch_add(p, v, __ATOMIC_RELAXED, __HIP_MEMORY_SCOPE_AGENT); }
__device__ __forceinline__ unsigned xb_xcc_id() { return (unsigned)__builtin_amdgcn_s_getreg((3 << 11) | 20) & 0xFu; }
#define XB_SPIN(cond, bar) do { unsigned _sp = 0; while (cond) { __builtin_amdgcn_s_sleep(1); \
    if ((++_sp & 255u) == 0u) { if (xb_ld(&(bar)[XB_TMO])) break; if (_sp > XB_SPIN_CAP) { atomicAdd(&(bar)[XB_TMO], 1u); break; } } } } while (0)
struct XcdBarrier { unsigned* bar; unsigned x; volatile LAS unsigned* st; };
__device__ __forceinline__ XcdBarrier xcd_barrier_post(unsigned* bar, volatile LAS unsigned* st) {
    XcdBarrier b; b.bar = bar; b.x = xb_xcc_id(); b.st = st;
    if (threadIdx.x == 0) (void)xb_add(&bar[XB_XCNT(b.x)], 1u);
    return b;
}
__device__ __forceinline__ void xcd_barrier_complete(unsigned* bar, unsigned x, unsigned& nloc, unsigned& nx) {
    const unsigned G = gridDim.x * gridDim.y * gridDim.z;
    unsigned sum, cnt, mine, sp = 0u;
    for (;;) {
        sum = 0u; cnt = 0u; mine = 0u;
#pragma unroll
        for (unsigned j = 0; j < 16; ++j) { const unsigned c = xb_ld(&bar[XB_XCNT(j)]); sum += c; cnt += (c > 0u) ? 1u : 0u; mine = (j == x) ? c : mine; }
        if (sum == G) break;
        __builtin_amdgcn_s_sleep(1);
        if ((++sp & 255u) == 0u) { if (xb_ld(&bar[XB_TMO])) break; if (sp > XB_SPIN_CAP) { atomicAdd(&bar[XB_TMO], 1u); break; } }
    }
    nloc = mine > 0u ? mine : 1u; nx = cnt > 0u ? cnt : 1u;
}
__device__ __forceinline__ void xcd_barrier(const XcdBarrier& b) {
    asm volatile("s_waitcnt vmcnt(0)" ::: "memory");
    __syncthreads();
    if (threadIdx.x == 0) {
        unsigned* bar = b.bar;
        __builtin_amdgcn_s_waitcnt(0);
        unsigned nloc = b.st[0], nx = b.st[1];
        if (nloc == 0u) { xcd_barrier_complete(bar, b.x, nloc, nx); b.st[0] = nloc; b.st[1] = nx; }
        const unsigned old = xb_add(&bar[XB_XSUB(b.x)], 1u);
        const unsigned gen = old / nloc;
        if (old + 1u == (gen + 1u) * nloc) {
            __builtin_amdgcn_fence(__ATOMIC_RELEASE, "agent");
            asm volatile("s_waitcnt vmcnt(0)" ::: "memory");
            const unsigned og = xb_add(&bar[XB_TOP], 1u);
            const unsigned tg = og / nx;
            if (og + 1u == (tg + 1u) * nx) xb_add(&bar[XB_TOPGEN], 1u);
            else XB_SPIN(xb_ld(&bar[XB_TOPGEN]) == tg, bar);
            __builtin_amdgcn_fence(__ATOMIC_ACQUIRE, "agent");
            xb_add(&bar[XB_XGEN(b.x)], 1u);
            asm volatile("s_waitcnt vmcnt(0)" ::: "memory");
        } else {
            XB_SPIN(xb_ld(&bar[XB_XGEN(b.x)]) == gen, bar);
            __builtin_amdgcn_fence(__ATOMIC_ACQUIRE, "agent");
            asm volatile("s_waitcnt vmcnt(0)" ::: "memory");
        }
    }
    __syncthreads();
}

namespace gm {
constexpr int BM = 256, BK = 64, HALF = 128, HTB = HALF * BK * 2;
constexpr unsigned PITCH = 2048u, HSTEP = 128u * PITCH, TSTEP = 256u * PITCH, KSTEP = 128u;
__device__ __forceinline__ int lds_byte(int r, int c) { const int st = (r >> 4) * 2 + (c >> 5), rr = r & 15, cc = c & 31, ob = rr * 64 + cc * 2; return st * 1024 + (ob ^ (((ob >> 9) & 1) << 5)); }
__device__ __forceinline__ void stage_rc(int b, int& R, int& C) { const int st = b / 1024, sb = b % 1024, swz = sb ^ (((sb >> 9) & 1) << 5); R = (st >> 1) * 16 + swz / 64; C = (st & 1) * 32 + (swz % 64) / 2; }
__device__ __forceinline__ int perm32(int rho) { const int n = rho >> 4, i = rho & 15; return 8 * (i >> 2) + 4 * n + (i & 3); }

struct Unit { const char* A; const char* B; int nt, kind, pm, pn, aux; };

__device__ __forceinline__ void tile_map(int L, int nM, int nN, int& pm, int& pn) {
    const int nwg = nM * nN; int wgid = L;
    { const int q = nwg / 8, r = nwg % 8, xcd = wgid % 8, off = wgid / 8; wgid = (xcd < r ? xcd * (q + 1) : r * (q + 1) + (xcd - r) * q) + off; }
    const int nig = 8 * nN, gid = wgid / nig, fm = gid * 8, gsz = (nM - fm) < 8 ? (nM - fm) : 8;
    pm = fm + ((wgid % nig) % gsz); pn = (wgid % nig) / gsz;
}

template <class Epi, class Sched, bool GATHER>
__device__ __forceinline__ void gemm_phase(LAS unsigned char* lds, const Sched& S, const Epi& E) {
    int tid_ = threadIdx.x; asm volatile("" : "+v"(tid_));
    const int tid = tid_, wid = __builtin_amdgcn_readfirstlane(tid >> 6), lane = tid & 63, wr = wid >> 2, wc = wid & 3, fr = lane & 15, fq = lane >> 4;
    unsigned voffB[2], cvA[2][2], nvA[2][2]; int rA[2]; unsigned cC[2];
#pragma unroll
    for (int i = 0; i < 2; ++i) { int R, C; stage_rc(tid * 16 + i * 8192, R, C); const int Rb = (R & ~31) + perm32(R & 31);
        voffB[i] = (unsigned)Rb * PITCH + (unsigned)C * 2u; rA[i] = R; cC[i] = (unsigned)C * 2u;
        cvA[0][i] = (unsigned)R * PITCH + cC[i]; cvA[1][i] = cvA[0][i] + HSTEP; nvA[0][i] = cvA[0][i]; nvA[1][i] = cvA[1][i]; }
    const unsigned ldsw = (unsigned)wid * 1024u;
    const int aoff = lds_byte(wr * 64 + fr, fq * 8), boff = lds_byte(wc * 32 + fr, fq * 8);
#define GM_SA(b, h) (((b) * 2 + (h)) * HTB)
#define GM_SB(b, h) ((4 + (b) * 2 + (h)) * HTB)
#define GM_STAGE(bufoff, gbase, voff) do { _Pragma("unroll") for (int _i = 0; _i < 2; ++_i) \
        __builtin_amdgcn_global_load_lds((const unsigned*)((const char*)(gbase) + (voff)[_i]), (LAS unsigned*)(lds + (bufoff) + ldsw + _i * 8192), 16, 0, 0); } while (0)
#define GM_LDA(dst, b, h) do { _Pragma("unroll") for (int m = 0; m < 4; ++m) _Pragma("unroll") for (int k = 0; k < 2; ++k) dst[m][k] = *(const LAS bf16x8*)(lds + GM_SA(b, h) + aoff + m * 2048 + k * 1024); } while (0)
#define GM_LDB(dst, b, h) do { _Pragma("unroll") for (int n = 0; n < 2; ++n) _Pragma("unroll") for (int k = 0; k < 2; ++k) dst[n][k] = *(const LAS bf16x8*)(lds + GM_SB(b, h) + boff + n * 2048 + k * 1024); } while (0)
#define GM_MMA(ai, bj, At, Bt) do { __builtin_amdgcn_s_setprio(1); _Pragma("unroll") for (int m = 0; m < 4; ++m) _Pragma("unroll") for (int n = 0; n < 2; ++n) _Pragma("unroll") for (int k = 0; k < 2; ++k) \
        acc[ai][bj][m][n] = __builtin_amdgcn_mfma_f32_16x16x32_bf16(Bt[n][k], At[m][k], acc[ai][bj][m][n], 0, 0, 0); __builtin_amdgcn_s_setprio(0); } while (0)
#define GM_WAIT_V(n) asm volatile("s_waitcnt vmcnt(" #n ")" ::: "memory")
#define GM_WAIT_L(n) asm volatile("s_waitcnt lgkmcnt(" #n ")" ::: "memory")
#define GM_BAR __builtin_amdgcn_s_barrier()
#define GM_SCHED __builtin_amdgcn_sched_barrier(0)
    Unit cur, nxt; int ui = 0;
    if (!S.next(0, cur)) return;
    f32x4 acc[2][2][4][2];
#pragma unroll
    for (int a = 0; a < 2; ++a)
#pragma unroll
        for (int b = 0; b < 2; ++b)
#pragma unroll
            for (int m = 0; m < 4; ++m)
#pragma unroll
                for (int n = 0; n < 2; ++n) acc[a][b][m][n] = (f32x4){0.f, 0.f, 0.f, 0.f};
    bf16x8 At[4][2], B0[2][2], B1[2][2];
    const char* cA = cur.A; const char* cB = cur.B;
    if constexpr (GATHER) {
#pragma unroll
        for (int h = 0; h < 2; ++h)
#pragma unroll
            for (int i = 0; i < 2; ++i) cvA[h][i] = S.row_off(cur, h * HALF + rA[i]) + cC[i];
    }
    GM_STAGE(GM_SB(0, 0), cB, voffB); GM_STAGE(GM_SB(0, 1), cB + HSTEP, voffB); GM_STAGE(GM_SA(0, 0), cA, cvA[0]); GM_STAGE(GM_SA(0, 1), cA, cvA[1]);
    if (wr == 1) GM_BAR;
    GM_WAIT_V(2); GM_BAR;
    GM_STAGE(GM_SB(1, 0), cB + KSTEP, voffB); GM_STAGE(GM_SA(1, 0), cA + KSTEP, cvA[0]); GM_STAGE(GM_SB(1, 1), cB + HSTEP + KSTEP, voffB);
    GM_WAIT_V(6); GM_BAR;
    for (;;) {
        const bool has_next = S.next(ui + 1, nxt);
        const char* nA = has_next ? nxt.A : cA; const char* nB = has_next ? nxt.B : cB;
        if constexpr (GATHER) {
            if (has_next) {
#pragma unroll
                for (int h = 0; h < 2; ++h)
#pragma unroll
                    for (int i = 0; i < 2; ++i) nvA[h][i] = S.row_off(nxt, h * HALF + rA[i]) + cC[i];
            } else {
#pragma unroll
                for (int h = 0; h < 2; ++h)
#pragma unroll
                    for (int i = 0; i < 2; ++i) nvA[h][i] = cvA[h][i];
            }
        }
        const int nt = cur.nt;
        for (int t = 0; t < nt; t += 2) {
            const bool last = (t == nt - 2);
            const char* a1 = cA + (size_t)(t + 1) * KSTEP;
            const char* a2 = last ? nA : cA + (size_t)(t + 2) * KSTEP; const char* b2 = last ? nB : cB + (size_t)(t + 2) * KSTEP;
            const char* a3 = a2 + KSTEP; const char* b3 = b2 + KSTEP;
            unsigned o0[2], o1[2];
            if constexpr (GATHER) { o0[0] = last ? nvA[0][0] : cvA[0][0]; o0[1] = last ? nvA[0][1] : cvA[0][1]; o1[0] = last ? nvA[1][0] : cvA[1][0]; o1[1] = last ? nvA[1][1] : cvA[1][1]; }
            else { o0[0] = cvA[0][0]; o0[1] = cvA[0][1]; o1[0] = cvA[1][0]; o1[1] = cvA[1][1]; }
            GM_LDB(B0, 0, 0); GM_LDB(B1, 0, 1); GM_SCHED; GM_LDA(At, 0, 0); GM_STAGE(GM_SA(1, 1), a1, cvA[1]);
            GM_WAIT_V(8); GM_WAIT_L(0); GM_BAR; GM_MMA(0, 0, At, B0); GM_MMA(0, 1, At, B1); GM_BAR; GM_SCHED;
            GM_LDA(At, 0, 1); GM_STAGE(GM_SB(0, 0), b2, voffB); GM_STAGE(GM_SB(0, 1), b2 + HSTEP, voffB); GM_STAGE(GM_SA(0, 0), a2, o0);
            GM_WAIT_V(8); GM_WAIT_L(0); GM_BAR; GM_MMA(1, 0, At, B0); GM_MMA(1, 1, At, B1); GM_BAR; GM_SCHED;
            GM_LDB(B0, 1, 0); GM_LDB(B1, 1, 1); GM_SCHED; GM_LDA(At, 1, 0); GM_STAGE(GM_SA(0, 1), a2, o1);
            GM_WAIT_V(8); GM_WAIT_L(0); GM_BAR; GM_MMA(0, 0, At, B0); GM_MMA(0, 1, At, B1); GM_BAR; GM_SCHED;
            GM_LDA(At, 1, 1); GM_STAGE(GM_SB(1, 0), b3, voffB); GM_STAGE(GM_SB(1, 1), b3 + HSTEP, voffB); GM_STAGE(GM_SA(1, 0), a3, o0);
            GM_WAIT_V(8); GM_WAIT_L(0); GM_BAR; GM_MMA(1, 0, At, B0); GM_MMA(1, 1, At, B1); GM_BAR; GM_SCHED;
        }
        if (wr == 0) GM_BAR;
        E(acc, cur, wr, wc, fr, fq);
        if (!has_next) break;
#pragma unroll
        for (int a = 0; a < 2; ++a)
#pragma unroll
            for (int b = 0; b < 2; ++b)
#pragma unroll
                for (int m = 0; m < 4; ++m)
#pragma unroll
                    for (int n = 0; n < 2; ++n) acc[a][b][m][n] = (f32x4){0.f, 0.f, 0.f, 0.f};
        cur = nxt; cA = nA; cB = nB; ++ui;
        if constexpr (GATHER) {
#pragma unroll
            for (int h = 0; h < 2; ++h)
#pragma unroll
                for (int i = 0; i < 2; ++i) cvA[h][i] = nvA[h][i];
        }
        if (wr == 1) GM_BAR;
    }
    GM_WAIT_V(0);
    GM_BAR;
#undef GM_SA
#undef GM_SB
#undef GM_STAGE
#undef GM_LDA
#undef GM_LDB
#undef GM_MMA
#undef GM_WAIT_V
#undef GM_WAIT_L
#undef GM_BAR
#undef GM_SCHED
}
}

struct Args { const float* in[23]; float* out; unsigned char* ws; int ph_lo, ph_hi; };
struct Frame {
    LAS unsigned char* lds;
    unsigned* ctl;
    unsigned char* ws;
    int tid, lane, wave, G, bid;
    const Args* a;
};
#define FIN(i) (F.a->in[i])
#define FRESH_IDS(F) do { int t_ = threadIdx.x; asm volatile("" : "+v"(t_)); (F).tid = t_; (F).lane = t_ & 63; (F).wave = __builtin_amdgcn_readfirstlane(t_ >> 6); } while (0)
#define WSP(T, off) ((T*)(F.ws + (off)))

typedef f32x4 Acc[2][2][4][2];

struct EpiZ {
    bf16* Z; bf16* VT; float* vss;
    __device__ __forceinline__ void operator()(const Acc& acc, const gm::Unit& u, int wr, int wc, int fr, int fq) const {
        if (u.kind == 1) {
            const int vrow0 = (u.pn - 4) * 256 + wr * 64 + fr, tok0 = u.pm * 256 + wc * 32 + 8 * fq;
            float ss[2][8];
#pragma unroll
            for (int bj = 0; bj < 2; ++bj)
#pragma unroll
                for (int j = 0; j < 8; ++j) ss[bj][j] = 0.f;
#pragma unroll
            for (int ai = 0; ai < 2; ++ai)
#pragma unroll
                for (int m = 0; m < 4; ++m) { bf16* rp = VT + (size_t)(vrow0 + ai * 128 + m * 16) * NTOK + tok0;
#pragma unroll
                    for (int bj = 0; bj < 2; ++bj) { float v[8];
#pragma unroll
                        for (int j = 0; j < 8; ++j) { v[j] = gelu_tanh(acc[ai][bj][m][j >> 2][j & 3]); ss[bj][j] += v[j] * v[j]; }
                        u32x4 w; w.x = cvt_pk_bf16(v[0], v[1]); w.y = cvt_pk_bf16(v[2], v[3]); w.z = cvt_pk_bf16(v[4], v[5]); w.w = cvt_pk_bf16(v[6], v[7]);
                        *(u32x4*)(rp + bj * 128) = w; } }
#pragma unroll
            for (int bj = 0; bj < 2; ++bj)
#pragma unroll
                for (int j = 0; j < 8; ++j) { float s = ss[bj][j]; s += __shfl_xor(s, 1); s += __shfl_xor(s, 2); s += __shfl_xor(s, 4); s += __shfl_xor(s, 8);
                    if (fr == 0) atomicAdd(vss + tok0 + bj * 128 + j, s); }
        } else {
            const int row0 = u.pm * 256 + wr * 64 + fr, col0 = u.pn * 256 + wc * 32 + 8 * fq; const int kind = u.kind;
#pragma unroll
            for (int ai = 0; ai < 2; ++ai)
#pragma unroll
                for (int m = 0; m < 4; ++m) { bf16* rp = Z + (size_t)(row0 + ai * 128 + m * 16) * INC + col0;
#pragma unroll
                    for (int bj = 0; bj < 2; ++bj) { float v[8];
#pragma unroll
                        for (int j = 0; j < 8; ++j) { const float a = acc[ai][bj][m][j >> 2][j & 3]; v[j] = kind == 0 ? gelu_tanh(a) : (kind == 3 ? sigmoidf_fast(a) : a); }
                        u32x4 w; w.x = cvt_pk_bf16(v[0], v[1]); w.y = cvt_pk_bf16(v[2], v[3]); w.z = cvt_pk_bf16(v[4], v[5]); w.w = cvt_pk_bf16(v[6], v[7]);
                        *(u32x4*)(rp + bj * 128) = w; } }
        }
    }
};
struct SchedZ {
    int G, c; const char* H; const char* W;
    __device__ __forceinline__ bool next(int i, gm::Unit& u) const {
        const int L = i * G + c; if (L >= 128 * 36) return false;
        int pm, pn; gm::tile_map(L, 128, 36, pm, pn);
        u.pm = pm; u.pn = pn; u.nt = 16; u.aux = 0;
        if (pn >= 4 && pn < 8) { u.A = W + (size_t)pn * gm::TSTEP; u.B = H + (size_t)pm * gm::TSTEP; u.kind = 1; }
        else { u.A = H + (size_t)pm * gm::TSTEP; u.B = W + (size_t)pn * gm::TSTEP; u.kind = pn < 4 ? 0 : (pn < 24 ? 2 : 3); }
        return true;
    }
    __device__ __forceinline__ unsigned row_off(const gm::Unit&, int) const { return 0u; }
};

struct EpiMix {
    const bf16* Z; float* MIXF; bf16* MIX; const float* pscale;
    __device__ __forceinline__ void operator()(const Acc& acc, const gm::Unit& u, int wr, int wc, int fr, int fq) const {
        const int row0 = u.pm * 256 + wr * 64 + fr, col0 = u.pn * 256 + wc * 32 + 8 * fq; const int kind = u.kind;
        const int gcol = (kind == 0 ? Z_GA : (kind == 1 ? Z_GC : Z_GB)) + col0;
        f32x4 ps[2][2];
#pragma unroll
        for (int bj = 0; bj < 2; ++bj)
#pragma unroll
            for (int n = 0; n < 2; ++n) ps[bj][n] = kind == 2 ? *(const f32x4*)(pscale + col0 + bj * 128 + 4 * n) : (f32x4){1.f, 1.f, 1.f, 1.f};
#pragma unroll
        for (int ai = 0; ai < 2; ++ai)
#pragma unroll
            for (int m = 0; m < 4; ++m) { const size_t row = (size_t)(row0 + ai * 128 + m * 16);
#pragma unroll
                for (int bj = 0; bj < 2; ++bj) {
                    const u32x4 gw = *(const u32x4*)(Z + row * INC + gcol + bj * 128);
                    const f32x4 g0 = {bflo(gw.x), bfhi(gw.x), bflo(gw.y), bfhi(gw.y)}, g1 = {bflo(gw.z), bfhi(gw.z), bflo(gw.w), bfhi(gw.w)};
                    float* mp = MIXF + row * D + col0 + bj * 128;
                    f32x4 o0 = g0 * ps[bj][0] * acc[ai][bj][m][0], o1 = g1 * ps[bj][1] * acc[ai][bj][m][1];
                    if (kind != 0) { o0 += *(const f32x4*)mp; o1 += *(const f32x4*)(mp + 4); }
                    if (kind != 2) { *(f32x4*)mp = o0; *(f32x4*)(mp + 4) = o1; }
                    else { u32x4 w; w.x = cvt_pk_bf16(o0[0], o0[1]); w.y = cvt_pk_bf16(o0[2], o0[3]); w.z = cvt_pk_bf16(o1[0], o1[1]); w.w = cvt_pk_bf16(o1[2], o1[3]);
                        *(u32x4*)(MIX + row * D + col0 + bj * 128) = w; }
                } }
    }
};
struct SchedMix {
    int G, c; const char *AIN, *CIN, *PIN, *WA, *WC, *WP;
    __device__ __forceinline__ bool next(int i, gm::Unit& u) const {
        const int rnd = i / 3, ty = i - rnd * 3; const int L = rnd * G + c; if (L >= 128 * 4) return false;
        int pm, pn; gm::tile_map(L, 128, 4, pm, pn);
        u.pm = pm; u.pn = pn; u.kind = ty; u.aux = 0;
        if (ty == 0) { u.A = AIN + (size_t)pm * gm::TSTEP; u.B = WA + (size_t)pn * gm::TSTEP; u.nt = 16; }
        else if (ty == 1) { u.A = CIN + (size_t)pm * gm::TSTEP; u.B = WC + (size_t)pn * gm::TSTEP; u.nt = 16; }
        else { u.A = PIN + (size_t)pm * gm::TSTEP + pn * 512; u.B = WP + (size_t)pn * gm::TSTEP + pn * 512; u.nt = 4; }
        return true;
    }
    __device__ __forceinline__ unsigned row_off(const gm::Unit&, int) const { return 0u; }
};

struct EpiOut {
    const float* xin; float* xout; const float* g1;
    __device__ __forceinline__ void operator()(const Acc& acc, const gm::Unit& u, int wr, int wc, int fr, int fq) const {
        const int row0 = u.pm * 256 + wr * 64 + fr, col0 = u.pn * 256 + wc * 32 + 8 * fq; const int b = u.pm / 16;
        f32x4 gv[2][2];
#pragma unroll
        for (int bj = 0; bj < 2; ++bj)
#pragma unroll
            for (int n = 0; n < 2; ++n) gv[bj][n] = *(const f32x4*)(g1 + (size_t)b * 6 * D + col0 + bj * 128 + 4 * n);
#pragma unroll
        for (int ai = 0; ai < 2; ++ai)
#pragma unroll
            for (int m = 0; m < 4; ++m) { const size_t off = (size_t)(row0 + ai * 128 + m * 16) * D + col0;
#pragma unroll
                for (int bj = 0; bj < 2; ++bj) {
                    const f32x4 x0 = *(const f32x4*)(xin + off + bj * 128), x1 = *(const f32x4*)(xin + off + bj * 128 + 4);
                    *(f32x4*)(xout + off + bj * 128) = x0 + gv[bj][0] * acc[ai][bj][m][0];
                    *(f32x4*)(xout + off + bj * 128 + 4) = x1 + gv[bj][1] * acc[ai][bj][m][1]; } }
    }
};
struct SchedOut {
    int G, c; const char *MIXP, *WO;
    __device__ __forceinline__ bool next(int i, gm::Unit& u) const {
        const int L = i * G + c; if (L >= 128 * 4) return false;
        int pm, pn; gm::tile_map(L, 128, 4, pm, pn);
        u.pm = pm; u.pn = pn; u.kind = 0; u.aux = 0; u.nt = 16; u.A = MIXP + (size_t)pm * gm::TSTEP; u.B = WO + (size_t)pn * gm::TSTEP;
        return true;
    }
    __device__ __forceinline__ unsigned row_off(const gm::Unit&, int) const { return 0u; }
};

struct SchedMoe {
    int NG, r, x, npn; const LAS int* tb;
    const char* Abase; const char* Wbase; unsigned wstride;
    const int* LIST; bool gather;
    __device__ __forceinline__ bool next(int i, gm::Unit& u) const {
        const int j = i * NG + r; int mt = j / npn; const int pn = j - mt * npn;
#define TB(i) __builtin_amdgcn_readfirstlane(tb[i])
        int e = x; int T = TB(e);
        if (mt >= T) { mt -= T; e += 8; T = TB(e);
            if (mt >= T) { mt -= T; e += 8; T = TB(e);
                if (mt >= T) { mt -= T; e += 8; T = TB(e); if (mt >= T) return false; } } }
        u.aux = e; u.pn = pn; u.nt = 16; u.kind = TB(64 + e) - 256 * mt;
        const int arow = TB(32 + e) + 256 * mt;
        if (gather) { u.A = Abase; u.pm = arow; u.B = Wbase + (size_t)e * wstride + (size_t)pn * gm::TSTEP; }
        else { u.A = Abase + (size_t)arow * gm::PITCH; u.pm = 256 * mt; u.B = Wbase + (size_t)e * wstride + (size_t)pn * gm::TSTEP; }
        return true;
    }
    __device__ __forceinline__ unsigned row_off(const gm::Unit& u, int rr) const {
        const int mt256 = u.pm - TB(32 + u.aux);
        const int slot = (rr < u.kind) ? LIST[(size_t)u.aux * NTOK + mt256 + rr] : 0;
        return (unsigned)(slot >> 2) * gm::PITCH;
    }
};
struct EpiGU {
    bf16* ACT; const float* bgu;
    __device__ __forceinline__ void operator()(const Acc& acc, const gm::Unit& u, int wr, int wc, int fr, int fq) const {
        const int e = u.aux, f0 = u.pn * 128 + wc * 32 + 8 * fq; const size_t arow0 = (size_t)u.pm + wr * 64 + fr;
        f32x4 bg[2], bu[2];
#pragma unroll
        for (int n = 0; n < 2; ++n) { bg[n] = *(const f32x4*)(bgu + (size_t)e * 2 * FF + f0 + 4 * n); bu[n] = *(const f32x4*)(bgu + (size_t)e * 2 * FF + FF + f0 + 4 * n); }
#pragma unroll
        for (int ai = 0; ai < 2; ++ai)
#pragma unroll
            for (int m = 0; m < 4; ++m) { float o[8];
#pragma unroll
                for (int j = 0; j < 8; ++j) { float g = acc[ai][0][m][j >> 2][j & 3] + bg[j >> 2][j & 3], up = acc[ai][1][m][j >> 2][j & 3] + bu[j >> 2][j & 3];
                    g = fminf(g, 7.0f); up = fminf(fmaxf(up, -7.0f), 7.0f);
                    const float glu = g * __builtin_amdgcn_rcpf(1.0f + __builtin_amdgcn_exp2f(-1.702f * 1.44269504089f * g));
                    o[j] = (up + 1.0f) * glu; }
                u32x4 w; w.x = cvt_pk_bf16(o[0], o[1]); w.y = cvt_pk_bf16(o[2], o[3]); w.z = cvt_pk_bf16(o[4], o[5]); w.w = cvt_pk_bf16(o[6], o[7]);
                *(u32x4*)(ACT + (arow0 + ai * 128 + m * 16) * FF + f0) = w; }
    }
};
struct EpiDown {
    bf16* YB; const float* bdn; const int* LIST; const float* WL;
    __device__ __forceinline__ void operator()(const Acc& acc, const gm::Unit& u, int wr, int wc, int fr, int fq) const {
        const int e = u.aux, col0 = u.pn * 256 + wc * 32 + 8 * fq, nvalid = u.kind; const size_t lbase = (size_t)e * NTOK + u.pm;
        f32x4 bd[2][2];
#pragma unroll
        for (int bj = 0; bj < 2; ++bj)
#pragma unroll
            for (int n = 0; n < 2; ++n) bd[bj][n] = *(const f32x4*)(bdn + (size_t)e * D + col0 + bj * 128 + 4 * n);
#pragma unroll
        for (int ai = 0; ai < 2; ++ai)
#pragma unroll
            for (int m = 0; m < 4; ++m) { const int r = wr * 64 + fr + ai * 128 + m * 16;
                if (r < nvalid) { const int slot = LIST[lbase + r]; const float w = WL[lbase + r];
#pragma unroll
                    for (int bj = 0; bj < 2; ++bj) { const f32x4 y0 = (acc[ai][bj][m][0] + bd[bj][0]) * w, y1 = (acc[ai][bj][m][1] + bd[bj][1]) * w;
                        u32x4 o; o.x = cvt_pk_bf16(y0[0], y0[1]); o.y = cvt_pk_bf16(y0[2], y0[3]); o.z = cvt_pk_bf16(y1[0], y1[1]); o.w = cvt_pk_bf16(y1[2], y1[3]);
                        *(u32x4*)(YB + (size_t)slot * D + col0 + bj * 128) = o; } } }
    }
};

__device__ __forceinline__ void transpose_tile(const float* W, int N, int k0, int n0, bf16* WT, int drow0, int dcol0, LAS float* scr, int lane) {
#pragma unroll 4
    for (int i = 0; i < 16; ++i) { const int kk = i * 4 + (lane >> 4); const f32x4 v = *(const f32x4*)(W + (size_t)(k0 + kk) * N + n0 + 4 * (lane & 15));
        LAS float* p = scr + kk * 65 + 4 * (lane & 15); p[0] = v.x; p[1] = v.y; p[2] = v.z; p[3] = v.w; }
    asm volatile("s_waitcnt lgkmcnt(0)" ::: "memory");
    const int c = lane & 7;
#pragma unroll
    for (int j = 0; j < 8; ++j) { const int n = (lane >> 3) + 8 * j; const LAS float* s = scr + (8 * c) * 65 + n;
        u32x4 o; o.x = cvt_pk_bf16(s[0 * 65], s[1 * 65]); o.y = cvt_pk_bf16(s[2 * 65], s[3 * 65]); o.z = cvt_pk_bf16(s[4 * 65], s[5 * 65]); o.w = cvt_pk_bf16(s[6 * 65], s[7 * 65]);
        *(u32x4*)(WT + (size_t)(drow0 + n0 + n) * 1024 + dcol0 + k0 + 8 * c) = o; }
    asm volatile("s_waitcnt lgkmcnt(0)" ::: "memory");
}
__device__ __forceinline__ void p0_prologue(Frame& F) {
    FRESH_IDS(F);
    LAS float* scr = (LAS float*)(F.lds + F.wave * 16640);
    const int gw = F.bid * NWAVES + F.wave, NGW = F.G * NWAVES;
    float* mods = WSP(float, WS_MODS);
    for (int task = gw; task < 48 * 8; task += NGW) {
        const int cg = task >> 3, ks = task & 7, l = cg / 24, c0 = (cg % 24) * 256 + 4 * F.lane;
        const float* cond = FIN(1); const float* aw = FIN(3) + (size_t)l * D * 6 * D + c0;
        f32x4 a[NB];
#pragma unroll
        for (int b = 0; b < NB; ++b) a[b] = (f32x4){0.f, 0.f, 0.f, 0.f};
        for (int k = ks * 128; k < ks * 128 + 128; ++k) { const f32x4 w = *(const f32x4*)(aw + (size_t)k * 6 * D);
#pragma unroll
            for (int b = 0; b < NB; ++b) { const float cv = cond[b * D + k]; const float s = cv * __builtin_amdgcn_rcpf(1.0f + __builtin_amdgcn_exp2f(-1.44269504089f * cv)); a[b] += w * s; } }
        if (ks == 0) { const f32x4 bb = *(const f32x4*)(FIN(4) + (size_t)l * 6 * D + c0);
#pragma unroll
            for (int b = 0; b < NB; ++b) a[b] += bb; }
#pragma unroll
        for (int b = 0; b < NB; ++b) { float* mp = mods + ((size_t)l * NB + b) * 6 * D + c0; atomicAdd(mp, a[b].x); atomicAdd(mp + 1, a[b].y); atomicAdd(mp + 2, a[b].z); atomicAdd(mp + 3, a[b].w); }
    }
    constexpr int I_GU = 16 * 32, I_DN = 16 * 16, I_IN = 16 * 144, I_SQ = 16 * 16, I_PL = 4 * 4;
    constexpr int N_GU = DEPTH * NE * I_GU, N_DN = DEPTH * NE * I_DN, N_IN = DEPTH * I_IN, N_SQ = DEPTH * I_SQ, N_PL = DEPTH * 4 * I_PL;
    constexpr int NITEMS = N_GU + N_DN + N_IN + 3 * N_SQ + N_PL;
    for (int it = gw; it < NITEMS; it += NGW) {
        int r = it;
        if (r < N_GU) { const int mat = r / I_GU, q = r % I_GU, kb = q / 32, nb = q % 32, n0 = 64 * nb, half = n0 / FF, f0 = n0 % FF;
            transpose_tile(FIN(18) + (size_t)mat * D * 2 * FF, 2 * FF, 64 * kb, n0, WSP(bf16, WS_WTGU) + (size_t)mat * 2 * FF * D, (f0 / 128) * 256 + 128 * half + (f0 % 128) - n0, 0, scr, F.lane); continue; }
        r -= N_GU;
        if (r < N_DN) { const int mat = r / I_DN, q = r % I_DN, kb = q / 16, nb = q % 16;
            transpose_tile(FIN(20) + (size_t)mat * FF * D, D, 64 * kb, 64 * nb, WSP(bf16, WS_WTDN) + (size_t)mat * D * FF, 0, 0, scr, F.lane); continue; }
        r -= N_DN;
        if (r < N_IN) { const int mat = r / I_IN, q = r % I_IN, kb = q / 144, nb = q % 144;
            transpose_tile(FIN(5) + (size_t)mat * D * INC, INC, 64 * kb, 64 * nb, WSP(bf16, WS_WTIN) + (size_t)mat * INC * D, 0, 0, scr, F.lane); continue; }
        r -= N_IN;
        if (r < 3 * N_SQ) { const int which = r / N_SQ, q2 = r % N_SQ, mat = q2 / I_SQ, q = q2 % I_SQ, kb = q / 16, nb = q % 16;
            const float* src = (which == 0 ? FIN(9) : (which == 1 ? FIN(13) : FIN(14))) + (size_t)mat * D * D;
            bf16* dst = WSP(bf16, which == 0 ? WS_WTA : (which == 1 ? WS_WTC : WS_WTO)) + (size_t)mat * D * D;
            transpose_tile(src, D, 64 * kb, 64 * nb, dst, 0, 0, scr, F.lane); continue; }
        r -= 3 * N_SQ;
        { const int mat = r / I_PL, q = r % I_PL, kb = q / 4, nb = q % 4, l = mat / 4, g = mat % 4;
            transpose_tile(FIN(10) + (size_t)mat * 256 * 256, 256, 64 * kb, 64 * nb, WSP(bf16, WS_WTPOOL) + (size_t)l * D * D, g * 256, g * 256, scr, F.lane); }
    }
}

template <int MODE>
__device__ __forceinline__ void norm_rows(Frame& F, const float* xin, const bf16* yb, const float* g2, float* xst, const float* gn, const float* sc, const float* sh, bf16* hout, float* fout) {
    FRESH_IDS(F);
    const int gw = F.bid * NWAVES + F.wave, NGW = F.G * NWAVES;
    for (int row = gw; row < NTOK; row += NGW) {
        const int b = row / SEQ; const size_t ro = (size_t)row * D;
        f32x4 v[4]; float s = 0.f;
#pragma unroll
        for (int j = 0; j < 4; ++j) { const int col = 256 * j + 4 * F.lane; v[j] = *(const f32x4*)(xin + ro + col);
            if (yb) { f32x4 ys = {0.f, 0.f, 0.f, 0.f};
#pragma unroll
                for (int k = 0; k < TOPK; ++k) { const u32x2 w = *(const u32x2*)(yb + ((size_t)row * TOPK + k) * D + col); ys += unpack_lo4(w); }
                v[j] += *(const f32x4*)(g2 + (size_t)b * 6 * D + col) * ys;
                if (xst) *(f32x4*)(xst + ro + col) = v[j]; }
            s += (v[j].x * v[j].x + v[j].y * v[j].y) + (v[j].z * v[j].z + v[j].w * v[j].w); }
        const float rstd = 1.0f / sqrtf(wave_sum(s) * (1.0f / D) + RMS_EPS);
#pragma unroll
        for (int j = 0; j < 4; ++j) { const int col = 256 * j + 4 * F.lane; const f32x4 g = *(const f32x4*)(gn + col);
            if (MODE == 0) { const f32x4 scv = *(const f32x4*)(sc + (size_t)b * 6 * D + col), shv = *(const f32x4*)(sh + (size_t)b * 6 * D + col);
                const f32x4 o = v[j] * rstd * g * (scv + 1.0f) + shv; u32x2 w; w.x = cvt_pk_bf16(o.x, o.y); w.y = cvt_pk_bf16(o.z, o.w); *(u32x2*)(hout + ro + col) = w; }
            else { *(f32x4*)(fout + ro + col) = v[j] * rstd * g; } }
    }
}

__device__ __forceinline__ void router_prep(Frame& F) {
    FRESH_IDS(F);
    const float* mods = WSP(float, WS_MODS); float* rwt = WSP(float, WS_RWT); float* rb = WSP(float, WS_RBIAS);
    const int gt = F.bid * NTHREADS + F.tid, NGT = F.G * NTHREADS;
    for (int i = gt; i < DEPTH * NB * NE * D; i += NGT) { const int k = i % D, e = (i / D) % NE, b = (i / (D * NE)) % NB, l = i / (D * NE * NB);
        rwt[i] = FIN(15)[l * D + k] * (1.0f + mods[((size_t)l * NB + b) * 6 * D + 4 * D + k]) * FIN(16)[((size_t)l * D + k) * NE + e]; }
    const int gw = F.bid * NWAVES + F.wave, NGW = F.G * NWAVES;
    for (int o = gw; o < DEPTH * NB * NE; o += NGW) { const int e = o % NE, b = (o / NE) % NB, l = o / (NE * NB); float s = 0.f;
        for (int k = F.lane; k < D; k += 64) s += mods[((size_t)l * NB + b) * 6 * D + 3 * D + k] * FIN(16)[((size_t)l * D + k) * NE + e];
        s = wave_sum(s); if (F.lane == 0) rb[o] = s + FIN(17)[l * NE + e]; }
}

__device__ __forceinline__ void mixer_prep(Frame& F, int l) {
    FRESH_IDS(F);
    const bf16* Z = WSP(bf16, WS_Z); const bf16* VT = WSP(bf16, WS_VT); const float* vss = WSP(float, WS_VSS) + (size_t)l * NTOK;
    bf16* AIN = WSP(bf16, WS_AIN); bf16* CIN = WSP(bf16, WS_CIN); bf16* PIN = WSP(bf16, WS_PIN);
    const float* convw = FIN(12) + (size_t)l * 3 * D; const float* gng = FIN(6) + (size_t)l * D; const float* ws = FIN(7) + (size_t)l * 8 * CHUNK * CHUNK; const float* bs = FIN(8) + (size_t)l * 8 * CHUNK;
    LAS unsigned char* Aimg = F.lds; LAS unsigned char* Bimg = F.lds + 32768; LAS float* rs = (LAS float*)(F.lds + 65536);
    const int tid = F.tid, lane = F.lane, wave = F.wave;
    for (int chunk = F.bid; chunk < NTOK / CHUNK; chunk += F.G) {
        const int tok0 = chunk * CHUNK, pos0 = tok0 % SEQ;
        {
            const int cg = tid & 127, rsq = tid >> 7, c0 = 8 * cg, t0 = 32 * rsq;
            float w0[8], w1[8], w2[8];
#pragma unroll
            for (int j = 0; j < 8; ++j) { w0[j] = convw[c0 + j]; w1[j] = convw[D + c0 + j]; w2[j] = convw[2 * D + c0 + j]; }
            float p2[8], p1[8];
#pragma unroll
            for (int j = 0; j < 8; ++j) { p2[j] = 0.f; p1[j] = 0.f; }
            if (pos0 + t0 >= 2) {
#pragma unroll
                for (int q = 0; q < 2; ++q) { const size_t zo = (size_t)(tok0 + t0 - 2 + q) * INC + c0; const u32x4 xv = *(const u32x4*)(Z + zo + Z_X), cv = *(const u32x4*)(Z + zo + Z_C);
                    const unsigned xa[4] = {xv.x, xv.y, xv.z, xv.w}, ca[4] = {cv.x, cv.y, cv.z, cv.w};
#pragma unroll
                    for (int j = 0; j < 4; ++j) { const float a = bflo(xa[j]) * bflo(ca[j]), bq = bfhi(xa[j]) * bfhi(ca[j]);
                        if (q == 0) { p2[2 * j] = a; p2[2 * j + 1] = bq; } else { p1[2 * j] = a; p1[2 * j + 1] = bq; } } }
            }
            const int pw = 2 << (cg >> 5);
            float sw[8];
#pragma unroll
            for (int j = 0; j < 8; ++j) sw[j] = 0.f;
            for (int q = 1; q < pw; ++q) { if (pos0 + t0 - q >= 0) { const u32x4 pv = *(const u32x4*)(Z + (size_t)(tok0 + t0 - q) * INC + Z_P + c0); const unsigned pa[4] = {pv.x, pv.y, pv.z, pv.w};
#pragma unroll
                    for (int j = 0; j < 4; ++j) { sw[2 * j] += bflo(pa[j]); sw[2 * j + 1] += bfhi(pa[j]); } } }
            for (int t = t0; t < t0 + 32; ++t) {
                const size_t zo = (size_t)(tok0 + t) * INC + c0; const int pos = pos0 + t;
                const u32x4 xv = *(const u32x4*)(Z + zo + Z_X), cv = *(const u32x4*)(Z + zo + Z_C), bv = *(const u32x4*)(Z + zo + Z_B), pv = *(const u32x4*)(Z + zo + Z_P);
                const unsigned xa[4] = {xv.x, xv.y, xv.z, xv.w}, ca[4] = {cv.x, cv.y, cv.z, cv.w}, ba[4] = {bv.x, bv.y, bv.z, bv.w}, pa[4] = {pv.x, pv.y, pv.z, pv.w};
                float zc[8], o[8], pf[8];
#pragma unroll
                for (int j = 0; j < 4; ++j) { zc[2 * j] = bflo(xa[j]) * bflo(ca[j]); zc[2 * j + 1] = bfhi(xa[j]) * bfhi(ca[j]); pf[2 * j] = bflo(pa[j]); pf[2 * j + 1] = bfhi(pa[j]); }
#pragma unroll
                for (int j = 0; j < 8; ++j) { const float cvv = w0[j] * p2[j] + w1[j] * p1[j] + w2[j] * zc[j]; const float bb = (j & 1) ? bfhi(ba[j >> 1]) : bflo(ba[j >> 1]); o[j] = bb * cvv; p2[j] = p1[j]; p1[j] = zc[j]; }
                u32x4 w; w.x = cvt_pk_bf16(o[0], o[1]); w.y = cvt_pk_bf16(o[2], o[3]); w.z = cvt_pk_bf16(o[4], o[5]); w.w = cvt_pk_bf16(o[6], o[7]);
                *(u32x4*)(CIN + (size_t)(tok0 + t) * D + c0) = w;
                const float inv = 1.0f / (float)((pos + 1) < pw ? (pos + 1) : pw);
#pragma unroll
                for (int j = 0; j < 8; ++j) { sw[j] += pf[j]; o[j] = sw[j] * inv - pf[j]; }
                w.x = cvt_pk_bf16(o[0], o[1]); w.y = cvt_pk_bf16(o[2], o[3]); w.z = cvt_pk_bf16(o[4], o[5]); w.w = cvt_pk_bf16(o[6], o[7]);
                *(u32x4*)(PIN + (size_t)(tok0 + t) * D + c0) = w;
                if (pos - (pw - 1) >= 0) { const u32x4 qv = *(const u32x4*)(Z + (size_t)(tok0 + t - (pw - 1)) * INC + Z_P + c0); const unsigned qa[4] = {qv.x, qv.y, qv.z, qv.w};
#pragma unroll
                    for (int j = 0; j < 4; ++j) { sw[2 * j] -= bflo(qa[j]); sw[2 * j + 1] -= bfhi(qa[j]); } }
            }
        }
        if (tid < CHUNK) rs[tid] = 1.0f / sqrtf(vss[tok0 + tid] * (1.0f / D) + RMS_EPS);
        __syncthreads();
        for (int h = 0; h < 8; ++h) {
#pragma unroll
            for (int i = 0; i < 4; ++i) { const int q = tid + 512 * i, t = q >> 4, kc = q & 15;
                u32x4 w = {0u, 0u, 0u, 0u};
                if (8 * kc <= t) { const float* wp = ws + ((size_t)h * CHUNK + t) * CHUNK + 8 * kc; const f32x4 a = *(const f32x4*)wp, b2 = *(const f32x4*)(wp + 4);
                    float v[8] = {a.x, a.y, a.z, a.w, b2.x, b2.y, b2.z, b2.w};
#pragma unroll
                    for (int j = 0; j < 8; ++j) v[j] = (8 * kc + j <= t) ? v[j] * rs[8 * kc + j] : 0.f;
                    w.x = cvt_pk_bf16(v[0], v[1]); w.y = cvt_pk_bf16(v[2], v[3]); w.z = cvt_pk_bf16(v[4], v[5]); w.w = cvt_pk_bf16(v[6], v[7]); }
                *(LAS u32x4*)(Aimg + t * 256 + ((kc ^ (t & 15)) << 4)) = w;
                const int d = t;
                const u32x4 gv = *(const u32x4*)(VT + (size_t)(h * CHUNK + d) * NTOK + tok0 + 8 * kc);
                *(LAS u32x4*)(Bimg + d * 256 + ((kc ^ (d & 15)) << 4)) = gv; }
            __syncthreads();
            const int wr = wave >> 1, wc = wave & 1, fr = lane & 15, fq = lane >> 4;
            f32x4 acc[2][4];
#pragma unroll
            for (int m = 0; m < 2; ++m)
#pragma unroll
                for (int n = 0; n < 4; ++n) acc[m][n] = (f32x4){0.f, 0.f, 0.f, 0.f};
            for (int kk = 0; kk <= wr; ++kk) {
                bf16x8 a[2], bq[4];
#pragma unroll
                for (int m = 0; m < 2; ++m) { const int row = 32 * wr + 16 * m + fr; a[m] = *(const LAS bf16x8*)(Aimg + row * 256 + (((4 * kk + fq) ^ (row & 15)) << 4)); }
#pragma unroll
                for (int n = 0; n < 4; ++n) { const int row = 64 * wc + 16 * n + fr; bq[n] = *(const LAS bf16x8*)(Bimg + row * 256 + (((4 * kk + fq) ^ (row & 15)) << 4)); }
#pragma unroll
                for (int m = 0; m < 2; ++m)
#pragma unroll
                    for (int n = 0; n < 4; ++n) acc[m][n] = __builtin_amdgcn_mfma_f32_16x16x32_bf16(bq[n], a[m], acc[m][n], 0, 0, 0);
            }
#pragma unroll
            for (int m = 0; m < 2; ++m) { const int t = 32 * wr + 16 * m + fr; const float bt = bs[h * CHUNK + t];
#pragma unroll
                for (int n = 0; n < 4; ++n) { const int col = h * CHUNK + 64 * wc + 16 * n + 4 * fq;
                    const f32x4 g = *(const f32x4*)(gng + col); const u32x2 uw = *(const u32x2*)(Z + (size_t)(tok0 + t) * INC + Z_U + col);
                    const f32x4 uu = unpack_lo4(uw); const f32x4 o = uu * (acc[m][n] * g + bt);
                    u32x2 w; w.x = cvt_pk_bf16(o.x, o.y); w.y = cvt_pk_bf16(o.z, o.w); *(u32x2*)(AIN + (size_t)(tok0 + t) * D + col) = w; } }
            __syncthreads();
        }
    }
}

__device__ __forceinline__ void router_phase(Frame& F, int l) {
    FRESH_IDS(F);
    const float* X = WSP(float, WS_XRES); const float* mods = WSP(float, WS_MODS) + (size_t)l * NB * 6 * D; const float* g2n = FIN(15) + (size_t)l * D;
    const float* rwt = WSP(float, WS_RWT) + (size_t)l * NB * NE * D; const float* rbias = WSP(float, WS_RBIAS) + (size_t)l * NB * NE;
    bf16* H = WSP(bf16, WS_H); int* LIST = WSP(int, WS_LIST); float* WL = WSP(float, WS_WLIST); unsigned* cnt = F.ctl + CW_CNT + l * NE;
    LAS float* lg = (LAS float*)(F.lds) + F.wave * (16 * 33);
    LAS float* rsd = (LAS float*)(F.lds + 17408) + F.wave * 16;
    LAS int* te = (LAS int*)(F.lds + 18432);
    LAS float* tw = (LAS float*)(F.lds + 20480);
    LAS unsigned* hist = (LAS unsigned*)(F.lds + 22528);
    LAS unsigned* base = (LAS unsigned*)(F.lds + 22656);
    const int lane = F.lane, tid = F.tid, q = lane >> 4, r = lane & 15;
    if (tid < 32) hist[tid] = 0u;
    __syncthreads();
    for (int tile = F.bid; tile < NTOK / 128; tile += F.G) {
        const int tok0 = tile * 128 + F.wave * 16, b = tok0 / SEQ;
        const float* xa = X + (size_t)(tok0 + r) * D + 4 * q;
        const float* w0 = rwt + ((size_t)b * NE + r) * D + 4 * q; const float* w1 = w0 + (size_t)16 * D;
        f32x4 acc0 = {0.f, 0.f, 0.f, 0.f}, acc1 = {0.f, 0.f, 0.f, 0.f}; float ss = 0.f;
#pragma unroll 4
        for (int j = 0; j < 64; ++j) { const f32x4 xv = *(const f32x4*)(xa + 16 * j), wa = *(const f32x4*)(w0 + 16 * j), wb = *(const f32x4*)(w1 + 16 * j);
            ss += (xv.x * xv.x + xv.y * xv.y) + (xv.z * xv.z + xv.w * xv.w);
            acc0 = __builtin_amdgcn_mfma_f32_16x16x4f32(xv.x, wa.x, acc0, 0, 0, 0); acc1 = __builtin_amdgcn_mfma_f32_16x16x4f32(xv.x, wb.x, acc1, 0, 0, 0);
            acc0 = __builtin_amdgcn_mfma_f32_16x16x4f32(xv.y, wa.y, acc0, 0, 0, 0); acc1 = __builtin_amdgcn_mfma_f32_16x16x4f32(xv.y, wb.y, acc1, 0, 0, 0);
            acc0 = __builtin_amdgcn_mfma_f32_16x16x4f32(xv.z, wa.z, acc0, 0, 0, 0); acc1 = __builtin_amdgcn_mfma_f32_16x16x4f32(xv.z, wb.z, acc1, 0, 0, 0);
            acc0 = __builtin_amdgcn_mfma_f32_16x16x4f32(xv.w, wa.w, acc0, 0, 0, 0); acc1 = __builtin_amdgcn_mfma_f32_16x16x4f32(xv.w, wb.w, acc1, 0, 0, 0); }
        ss += __shfl_xor(ss, 16); ss += __shfl_xor(ss, 32);
        const float rstd = 1.0f / sqrtf(ss * (1.0f / D) + RMS_EPS);
#pragma unroll
        for (int g = 0; g < 4; ++g) { lg[(4 * q + g) * 33 + r] = acc0[g]; lg[(4 * q + g) * 33 + 16 + r] = acc1[g]; }
        if (lane < 16) rsd[lane] = rstd;
        __syncthreads();
        if (lane < 16) {
            float v[NE]; const float rsv = rsd[lane];
#pragma unroll
            for (int e = 0; e < NE; ++e) v[e] = lg[lane * 33 + e] * rsv + rbias[b * NE + e];
            float tv[TOPK]; int ti[TOPK];
#pragma unroll
            for (int k = 0; k < TOPK; ++k) { float best = v[0]; int bi = 0;
#pragma unroll
                for (int e = 1; e < NE; ++e) { if (v[e] > best) { best = v[e]; bi = e; } }
                tv[k] = best; ti[k] = bi;
#pragma unroll
                for (int e = 0; e < NE; ++e) v[e] = (e == bi) ? -3.0e38f : v[e]; }
            float p[TOPK], ps = 0.f;
#pragma unroll
            for (int k = 0; k < TOPK; ++k) { p[k] = __expf(tv[k] - tv[0]); ps += p[k]; }
            const float inv = 1.0f / ps;
#pragma unroll
            for (int k = 0; k < TOPK; ++k) { te[(F.wave * 16 + lane) * 4 + k] = ti[k]; tw[(F.wave * 16 + lane) * 4 + k] = p[k] * inv; }
        }
        for (int i = 0; i < 16; ++i) { const float rsv = rsd[i]; const size_t ro = (size_t)(tok0 + i) * D;
#pragma unroll
            for (int j = 0; j < 4; ++j) { const int col = 256 * j + 4 * lane; const f32x4 xv = *(const f32x4*)(X + ro + col), g = *(const f32x4*)(g2n + col);
                const f32x4 scv = *(const f32x4*)(mods + (size_t)b * 6 * D + 4 * D + col), shv = *(const f32x4*)(mods + (size_t)b * 6 * D + 3 * D + col);
                const f32x4 o = xv * rsv * g * (scv + 1.0f) + shv; u32x2 w; w.x = cvt_pk_bf16(o.x, o.y); w.y = cvt_pk_bf16(o.z, o.w); *(u32x2*)(H + ro + col) = w; } }
        __syncthreads();
        const int t = tid >> 2, k = tid & 3, e = te[t * 4 + k];
        const unsigned rl = __hip_atomic_fetch_add(&hist[e], 1u, __ATOMIC_RELAXED, __HIP_MEMORY_SCOPE_WORKGROUP);
        __syncthreads();
        if (tid < 32) base[tid] = __hip_atomic_fetch_add(cnt + tid, hist[tid], RLX_AGENT);
        __syncthreads();
        const unsigned pos = base[e] + rl;
        LIST[(size_t)e * NTOK + pos] = (tile * 128 + t) * 4 + k; WL[(size_t)e * NTOK + pos] = tw[t * 4 + k];
        __syncthreads();
        if (tid < 32) hist[tid] = 0u;
        __syncthreads();
    }
}

__device__ __forceinline__ void moe_tables(Frame& F, int l) {
    FRESH_IDS(F);
    LAS int* tb = (LAS int*)(F.lds + LDSCTL_OFF + 256);
    __syncthreads();
    if (F.tid == 0) { int ps = 0; for (int e = 0; e < NE; ++e) { const int c = (int)__hip_atomic_load(F.ctl + CW_CNT + l * NE + e, RLX_AGENT); const int T = (c + 255) >> 8; tb[e] = T; tb[32 + e] = ps; tb[64 + e] = c; ps += T * 256; } }
    __syncthreads();
}

__global__ void __launch_bounds__(NTHREADS, 2) fwd_kernel(Args args) {
    extern __shared__ __attribute__((aligned(16))) unsigned char lds_raw[];
    Frame F;
    F.lds = (LAS unsigned char*)lds_raw; F.ws = args.ws; F.ctl = (unsigned*)(args.ws + WS_CTL);
    F.tid = threadIdx.x; F.lane = F.tid & 63; F.wave = __builtin_amdgcn_readfirstlane(F.tid >> 6); F.G = gridDim.x; F.bid = blockIdx.x;
    F.a = &args;
    for (int u = F.tid; u < 256; u += NTHREADS) ((LAS unsigned*)(F.lds + LDSCTL_OFF))[u] = 0u;
    __syncthreads();
    XcdBarrier bar; bar.bar = F.ctl + CW_BAR; bar.x = 0; bar.st = nullptr;
    if (N_LAUNCHES == 1) bar = xcd_barrier_post(F.ctl + CW_BAR, (volatile LAS unsigned*)(F.lds + LDSCTL_OFF + 16));
    const int lo = args.ph_lo, hi = args.ph_hi;
#ifdef ONLY_PH
#define IN(k) ((((k) < 2 ? (k) : 2 + ((k) - 2) % 8) == ONLY_PH) && lo <= (k) && (k) < hi)
#else
#define IN(k) (lo <= (k) && (k) < hi)
#endif
#define SEAM(k) do { if (IN(k) && IN((k) + 1)) xcd_barrier(bar); } while (0)

    if (IN(0)) { p0_prologue(F); } SEAM(0);
    if (IN(1)) {
        const float* mods = WSP(float, WS_MODS);
        norm_rows<0>(F, FIN(0), nullptr, nullptr, nullptr, FIN(2), mods + D, mods, WSP(bf16, WS_H), nullptr);
        router_prep(F);
    } SEAM(1);

    for (int l = 0; l < DEPTH; ++l) {
        const int pb = 2 + 8 * l;
        const float* mods = WSP(float, WS_MODS) + (size_t)l * NB * 6 * D;
        if (IN(pb + 0)) {
            SchedZ S{F.G, F.bid, (const char*)WSP(bf16, WS_H), (const char*)(WSP(bf16, WS_WTIN) + (size_t)l * INC * D)};
            EpiZ E{WSP(bf16, WS_Z), WSP(bf16, WS_VT), WSP(float, WS_VSS) + (size_t)l * NTOK};
            gm::gemm_phase<EpiZ, SchedZ, false>(F.lds, S, E);
        } SEAM(pb + 0);
        if (IN(pb + 1)) { mixer_prep(F, l); } SEAM(pb + 1);
        if (IN(pb + 2)) {
            SchedMix S{F.G, F.bid, (const char*)WSP(bf16, WS_AIN), (const char*)WSP(bf16, WS_CIN), (const char*)WSP(bf16, WS_PIN),
                       (const char*)(WSP(bf16, WS_WTA) + (size_t)l * D * D), (const char*)(WSP(bf16, WS_WTC) + (size_t)l * D * D), (const char*)(WSP(bf16, WS_WTPOOL) + (size_t)l * D * D)};
            EpiMix E{WSP(bf16, WS_Z), WSP(float, WS_MIXF), WSP(bf16, WS_MIX), FIN(11) + (size_t)l * D};
            gm::gemm_phase<EpiMix, SchedMix, false>(F.lds, S, E);
        } SEAM(pb + 2);
        if (IN(pb + 3)) {
            SchedOut S{F.G, F.bid, (const char*)WSP(bf16, WS_MIX), (const char*)(WSP(bf16, WS_WTO) + (size_t)l * D * D)};
            EpiOut E{l == 0 ? FIN(0) : WSP(float, WS_XRES), WSP(float, WS_XRES), mods + 2 * D};
            gm::gemm_phase<EpiOut, SchedOut, false>(F.lds, S, E);
        } SEAM(pb + 3);
        if (IN(pb + 4)) { router_phase(F, l); } SEAM(pb + 4);
        if (IN(pb + 5)) {
            moe_tables(F, l);
            SchedMoe S{F.G / 8, F.bid / 8, F.bid % 8, 8, (const LAS int*)(F.lds + LDSCTL_OFF + 256), (const char*)WSP(bf16, WS_H), (const char*)(WSP(bf16, WS_WTGU) + (size_t)l * NE * 2 * FF * D), (unsigned)(2 * FF * D * 2), WSP(int, WS_LIST), true};
            EpiGU E{WSP(bf16, WS_ACT), FIN(19) + (size_t)l * NE * 2 * FF};
            gm::gemm_phase<EpiGU, SchedMoe, true>(F.lds, S, E);
        } SEAM(pb + 5);
        if (IN(pb + 6)) {
            moe_tables(F, l);
            SchedMoe S{F.G / 8, F.bid / 8, F.bid % 8, 4, (const LAS int*)(F.lds + LDSCTL_OFF + 256), (const char*)WSP(bf16, WS_ACT), (const char*)(WSP(bf16, WS_WTDN) + (size_t)l * NE * D * FF), (unsigned)(D * FF * 2), WSP(int, WS_LIST), false};
            EpiDown E{WSP(bf16, WS_YB), FIN(21) + (size_t)l * NE * D, WSP(int, WS_LIST), WSP(float, WS_WLIST)};
            gm::gemm_phase<EpiDown, SchedMoe, false>(F.lds, S, E);
        } SEAM(pb + 6);
        if (IN(pb + 7)) {
            if (l + 1 < DEPTH) { const float* m2 = WSP(float, WS_MODS) + (size_t)(l + 1) * NB * 6 * D;
                norm_rows<0>(F, WSP(float, WS_XRES), WSP(bf16, WS_YB), mods + 5 * D, WSP(float, WS_XRES), FIN(2) + (size_t)(l + 1) * D, m2 + D, m2, WSP(bf16, WS_H), nullptr); }
            else norm_rows<1>(F, WSP(float, WS_XRES), WSP(bf16, WS_YB), mods + 5 * D, nullptr, FIN(22), nullptr, nullptr, nullptr, F.a->out);
        } SEAM(pb + 7);
    }
#undef IN
#undef SEAM
}

extern "C" void kernel_launch(void* const* d_in, const int* in_sizes, int n_in, void* d_out, int out_size, void* d_ws, size_t ws_size, hipStream_t stream) {
    static int grid = 0;
    if (grid == 0) {
        if (n_in != 23 || out_size != NTOK * D || ws_size < WS_END) { fprintf(stderr, "kernel_launch: unexpected shapes (n_in %d out %d ws %zu)\n", n_in, out_size, ws_size); grid = -1; return; }
        int dev = 0, cus = 0, per_cu = 0;
        if (hipGetDevice(&dev) != hipSuccess || hipDeviceGetAttribute(&cus, hipDeviceAttributeMultiprocessorCount, dev) != hipSuccess) { grid = -1; return; }
        if (hipFuncSetAttribute((const void*)fwd_kernel, hipFuncAttributeMaxDynamicSharedMemorySize, LDS_BYTES) != hipSuccess) { fprintf(stderr, "kernel_launch: hipFuncSetAttribute failed\n"); grid = -1; return; }
        if (hipOccupancyMaxActiveBlocksPerMultiprocessor(&per_cu, (const void*)fwd_kernel, NTHREADS, LDS_BYTES) != hipSuccess || per_cu < 1) fprintf(stderr, "kernel_launch: occupancy query reports %d\n", per_cu);
        (void)hipGetLastError();
        grid = (cus / 8) * 8;
        if (grid > 256) grid = 256;
        if (grid < 8) { grid = -1; return; }
    }
    if (grid < 0) return;
    if (hipMemsetAsync((char*)d_ws + WS_CTL, 0, CTL_ZERO_BYTES, stream) != hipSuccess) return;
    Args a{};
    for (int i = 0; i < 23; ++i) a.in[i] = (const float*)d_in[i];
    a.out = (float*)d_out; a.ws = (unsigned char*)d_ws;
    for (int li = 0; li < N_LAUNCHES; ++li) {
        a.ph_lo = (N_LAUNCHES == 1) ? 0 : li; a.ph_hi = (N_LAUNCHES == 1) ? NPHASES : li + 1;
        hipLaunchKernelGGL(fwd_kernel, dim3(grid), dim3(NTHREADS), LDS_BYTES, stream, a);
        if (hipPeekAtLastError() != hipSuccess) { fprintf(stderr, "kernel_launch: launch %d failed\n", li); break; }
    }
}
```

```cpp
#include <hip/hip_runtime.h>
#include <cstdio>
#include <cstdint>

#ifndef MK_N_LAUNCHES
#define MK_N_LAUNCHES 1
#endif

#define GAS __attribute__((address_space(1)))
#define LAS __attribute__((address_space(3)))
typedef unsigned short bf16;
typedef short bf16x8 __attribute__((ext_vector_type(8)));
typedef float f32x4 __attribute__((ext_vector_type(4)));
typedef float f32x2 __attribute__((ext_vector_type(2)));
typedef unsigned u32x4 __attribute__((ext_vector_type(4)));
typedef unsigned u32x2 __attribute__((ext_vector_type(2)));

constexpr int D = 1024, NB = 8, SEQ = 4096, NTOK = NB * SEQ, DEPTH = 2, INC = 9216, NE = 32, TOPK = 4, FF = 1024, CHUNK = 128;
constexpr int Z_U = 0, Z_V = 1024, Z_P = 2048, Z_X = 3072, Z_B = 4096, Z_C = 5120, Z_GA = 6144, Z_GB = 7168, Z_GC = 8192;
constexpr float RMS_EPS = 1e-5f;
constexpr int NWAVES = 8, NTHREADS = NWAVES * 64;
constexpr int NPHASES = 2 + 8 * DEPTH;
constexpr int N_LAUNCHES = MK_N_LAUNCHES;
static_assert(N_LAUNCHES == 1 || N_LAUNCHES == NPHASES, "MK_N_LAUNCHES must be 1 or NPHASES");

constexpr size_t MiB = 1u << 20;
constexpr size_t WS_CTL = 0, CTL_ZERO_BYTES = 1 * MiB;
constexpr int CW_BAR = 4096;
constexpr int CW_CNT = 8192;
constexpr int CW_QZ = 8192 + 512;
constexpr int CW_CVCTR = 8192 + 320;
constexpr int CW_P0CTR = 8192 + 256;
constexpr size_t WS_VSS = 256 * 1024;
constexpr size_t WS_MODS = 512 * 1024;
constexpr size_t WS_RWT = 1 * MiB;
constexpr size_t WS_RBIAS = 3 * MiB;
constexpr size_t WS_LIST = 4 * MiB;
constexpr size_t WS_WLIST = 8 * MiB;
constexpr size_t WS_WTPOOL = 12 * MiB;
constexpr size_t WS_WTA = 16 * MiB, WS_WTC = 20 * MiB, WS_WTO = 24 * MiB;
constexpr size_t WS_WTIN = 28 * MiB;
constexpr size_t WS_WTGU = 64 * MiB;
constexpr size_t WS_WTDN = 320 * MiB;
constexpr size_t WS_H = 448 * MiB;
constexpr size_t WS_VT = 512 * MiB;
constexpr size_t WS_AIN = 576 * MiB, WS_CIN = 640 * MiB, WS_PIN = 704 * MiB;
constexpr size_t WS_MIX = 768 * MiB;
constexpr size_t WS_XRES = 832 * MiB;
constexpr size_t WS_MIXF = 960 * MiB;
constexpr size_t WS_Z = 1088 * MiB;
constexpr size_t WS_ACT = WS_Z;
constexpr size_t WS_YB = WS_Z + 288 * MiB;
constexpr size_t WS_END = 1664 * MiB;

constexpr int RING_BYTES = 131072;
constexpr int LDS_BYTES = 147456;
constexpr int LDSCTL_OFF = LDS_BYTES - 1024;

#define RLX_AGENT __ATOMIC_RELAXED, __HIP_MEMORY_SCOPE_AGENT
typedef __bf16 bf16x2_t __attribute__((ext_vector_type(2)));
__device__ __forceinline__ unsigned cvt_pk_bf16(float lo, float hi) { const f32x2 v = {lo, hi}; const bf16x2_t r = __builtin_convertvector(v, bf16x2_t); return __builtin_bit_cast(unsigned, r); }
__device__ __forceinline__ float bflo(unsigned u) { return __uint_as_float(u << 16); }
__device__ __forceinline__ float bfhi(unsigned u) { return __uint_as_float(u & 0xffff0000u); }
__device__ __forceinline__ float wave_sum(float v) {
#pragma unroll
    for (int o = 1; o < 64; o <<= 1) v += __shfl_xor(v, o);
    return v;
}
__device__ __forceinline__ float sigmoidf_fast(float x) { return __builtin_amdgcn_rcpf(1.0f + __builtin_amdgcn_exp2f(-1.44269504089f * x)); }
__device__ __forceinline__ float gelu_tanh(float x) {
    const float t = x * (1.0f + 0.044715f * x * x);
    return x * __builtin_amdgcn_rcpf(1.0f + __builtin_amdgcn_exp2f(-2.30220818f * t));
}
__device__ __forceinline__ f32x4 unpack_lo4(u32x2 w) { return (f32x4){bflo(w.x), bfhi(w.x), bflo(w.y), bfhi(w.y)}; }

__device__ __forceinline__ int tid_of(int wave0) { int l; asm volatile("v_mbcnt_lo_u32_b32 %0, -1, 0\n\tv_mbcnt_hi_u32_b32 %0, -1, %0" : "=v"(l)); return wave0 * 64 + l; }
#define XB_TMO      128
#define XB_XCNT(j)  (256  + 64 * (j))
#define XB_XSUB(j)  (1280 + 64 * (j))
#define XB_XGEN(j)  (2304 + 64 * (j))
#define XB_TOP      3328
#define XB_TOPGEN   3392
#define XCD_BAR_WORDS 3456
#define XB_SPIN_CAP (1u << 18)
__device__ __forceinline__ unsigned xb_ld(unsigned* p)              { return __hip_atomic_load(p, __ATOMIC_RELAXED, __HIP_MEMORY_SCOPE_AGENT); }
__device__ __forceinline__ unsigned xb_add(unsigned* p, unsigned v) { return __hip_atomic_fetch_add(p, v, __ATOMIC_RELAXED, __HIP_MEMORY_SCOPE_AGENT); }
__device__ __forceinline__ unsigned xb_xcc_id() { return (unsigned)__builtin_amdgcn_s_getreg((3 << 11) | 20) & 0xFu; }
#define XB_SPIN(cond, bar) do { unsigned _sp = 0; while (cond) { __builtin_amdgcn_s_sleep(1); \
    if ((++_sp & 255u) == 0u) { if (xb_ld(&(bar)[XB_TMO])) break; if (_sp > XB_SPIN_CAP) { atomicAdd(&(bar)[XB_TMO], 1u); break; } } } } while (0)
struct XcdBarrier { unsigned* bar; unsigned x; volatile LAS unsigned* st; int wave0; };
__device__ __forceinline__ XcdBarrier xcd_barrier_post(unsigned* bar, volatile LAS unsigned* st, int wave0) {
    XcdBarrier b; b.bar = bar; b.x = xb_xcc_id(); b.st = st; b.wave0 = wave0;
    if (tid_of(wave0) == 0) (void)xb_add(&bar[XB_XCNT(b.x)], 1u);
    return b;
}
__device__ __forceinline__ void xcd_barrier_complete(unsigned* bar, unsigned x, unsigned& nloc, unsigned& nx) {
    const unsigned G = gridDim.x * gridDim.y * gridDim.z;
    unsigned sum, cnt, mine, sp = 0u;
    for (;;) {
        sum = 0u; cnt = 0u; mine = 0u;
#pragma unroll
        for (unsigned j = 0; j < 16; ++j) { const unsigned c = xb_ld(&bar[XB_XCNT(j)]); sum += c; cnt += (c > 0u) ? 1u : 0u; mine = (j == x) ? c : mine; }
        if (sum == G) break;
        __builtin_amdgcn_s_sleep(1);
        if ((++sp & 255u) == 0u) { if (xb_ld(&bar[XB_TMO])) break; if (sp > XB_SPIN_CAP) { atomicAdd(&bar[XB_TMO], 1u); break; } }
    }
    nloc = mine > 0u ? mine : 1u; nx = cnt > 0u ? cnt : 1u;
}
__device__ __forceinline__ void xcd_barrier(const XcdBarrier& b) {
    asm volatile("s_waitcnt vmcnt(0)" ::: "memory");
    __syncthreads();
    if (tid_of(b.wave0) == 0) {
        unsigned* bar = b.bar;
        __builtin_amdgcn_s_waitcnt(0);
        unsigned nloc = b.st[0], nx = b.st[1];
        if (nloc == 0u) { xcd_barrier_complete(bar, b.x, nloc, nx); b.st[0] = nloc; b.st[1] = nx; }
        const unsigned old = xb_add(&bar[XB_XSUB(b.x)], 1u);
        const unsigned gen = old / nloc;
        if (old + 1u == (gen + 1u) * nloc) {
            __builtin_amdgcn_fence(__ATOMIC_RELEASE, "agent");
            asm volatile("s_waitcnt vmcnt(0)" ::: "memory");
            const unsigned og = xb_add(&bar[XB_TOP], 1u);
            const unsigned tg = og / nx;
            if (og + 1u == (tg + 1u) * nx) xb_add(&bar[XB_TOPGEN], 1u);
            else XB_SPIN(xb_ld(&bar[XB_TOPGEN]) == tg, bar);
            __builtin_amdgcn_fence(__ATOMIC_ACQUIRE, "agent");
            xb_add(&bar[XB_XGEN(b.x)], 1u);
            asm volatile("s_waitcnt vmcnt(0)" ::: "memory");
        } else {
            XB_SPIN(xb_ld(&bar[XB_XGEN(b.x)]) == gen, bar);
            __builtin_amdgcn_fence(__ATOMIC_ACQUIRE, "agent");
            asm volatile("s_waitcnt vmcnt(0)" ::: "memory");
        }
    }
    __syncthreads();
}

namespace gm {
constexpr int BM = 256, BK = 64, HALF = 128, HTB = HALF * BK * 2;
constexpr unsigned PITCH = 2048u, HSTEP = 128u * PITCH, TSTEP = 256u * PITCH, KSTEP = 128u;
__device__ __forceinline__ int lds_byte(int r, int c) { const int st = (r >> 4) * 2 + (c >> 5), rr = r & 15, cc = c & 31, ob = rr * 64 + cc * 2; return st * 1024 + (ob ^ (((ob >> 9) & 1) << 5)); }
__device__ __forceinline__ void stage_rc(int b, int& R, int& C) { const int st = b / 1024, sb = b % 1024, swz = sb ^ (((sb >> 9) & 1) << 5); R = (st >> 1) * 16 + swz / 64; C = (st & 1) * 32 + (swz % 64) / 2; }
__device__ __forceinline__ int perm32(int rho) { const int n = rho >> 4, i = rho & 15; return 8 * (i >> 2) + 4 * n + (i & 3); }

struct Unit { const char* A; const char* B; int nt, kind, pm, pn, aux; };

__device__ __forceinline__ void tile_map(int L, int nM, int nN, int& pm, int& pn) {
    const int nwg = nM * nN; int wgid = L;
    { const int q = nwg / 8, r = nwg % 8, xcd = wgid % 8, off = wgid / 8; wgid = (xcd < r ? xcd * (q + 1) : r * (q + 1) + (xcd - r) * q) + off; }
    constexpr int WGM = 2; const int nig = WGM * nN, gid = wgid / nig, fm = gid * WGM, gsz = (nM - fm) < WGM ? (nM - fm) : WGM;
    pm = fm + ((wgid % nig) % gsz); pn = (wgid % nig) / gsz;
}

template <class Epi, class Sched, bool GATHER, bool DYN = false>
__device__ __forceinline__ void gemm_phase(LAS unsigned char* lds, const Sched& S, const Epi& E, int wave0) {
    int tid_ = tid_of(wave0); asm volatile("" : "+v"(tid_));
    const int tid = tid_, wid = __builtin_amdgcn_readfirstlane(tid >> 6), lane = tid & 63, wr = wid >> 2, wc = wid & 3, fr = lane & 15, fq = lane >> 4;
    unsigned voffB[2], cvA[2][2], nvA[2][2]; int rA[2]; unsigned cC[2];
#pragma unroll
    for (int i = 0; i < 2; ++i) { int R, C; stage_rc(tid * 16 + i * 8192, R, C); const int Rb = (R & ~31) + perm32(R & 31);
        voffB[i] = (unsigned)Rb * PITCH + (unsigned)C * 2u; rA[i] = R; cC[i] = (unsigned)C * 2u;
        cvA[0][i] = (unsigned)R * PITCH + cC[i]; cvA[1][i] = cvA[0][i] + HSTEP; nvA[0][i] = cvA[0][i]; nvA[1][i] = cvA[1][i]; }
    const unsigned ldsw = (unsigned)wid * 1024u;
    const int aoff = lds_byte(wr * 64 + fr, fq * 8), boff = lds_byte(wc * 32 + fr, fq * 8);
#define GM_SA(b, h) (((b) * 2 + (h)) * HTB)
#define GM_SB(b, h) ((4 + (b) * 2 + (h)) * HTB)
#define GM_STAGE(bufoff, gbase, voff) do { _Pragma("unroll") for (int _i = 0; _i < 2; ++_i) \
        __builtin_amdgcn_global_load_lds((const unsigned*)((const char*)(gbase) + (voff)[_i]), (LAS unsigned*)(lds + (bufoff) + ldsw + _i * 8192), 16, 0, 0); } while (0)
#define GM_LDA(dst, b, h) do { _Pragma("unroll") for (int m = 0; m < 4; ++m) _Pragma("unroll") for (int k = 0; k < 2; ++k) dst[m][k] = *(const LAS bf16x8*)(lds + GM_SA(b, h) + aoff + m * 2048 + k * 1024); } while (0)
#define GM_LDB(dst, b, h) do { _Pragma("unroll") for (int n = 0; n < 2; ++n) _Pragma("unroll") for (int k = 0; k < 2; ++k) dst[n][k] = *(const LAS bf16x8*)(lds + GM_SB(b, h) + boff + n * 2048 + k * 1024); } while (0)
#define GM_MMA(ai, bj, At, Bt) do { __builtin_amdgcn_s_setprio(1); _Pragma("unroll") for (int m = 0; m < 4; ++m) _Pragma("unroll") for (int n = 0; n < 2; ++n) _Pragma("unroll") for (int k = 0; k < 2; ++k) \
        acc[ai][bj][m][n] = __builtin_amdgcn_mfma_f32_16x16x32_bf16(Bt[n][k], At[m][k], acc[ai][bj][m][n], 0, 0, 0); __builtin_amdgcn_s_setprio(0); } while (0)
#define GM_WAIT_V(n) asm volatile("s_waitcnt vmcnt(" #n ")" ::: "memory")
#define GM_WAIT_VE() asm volatile("s_waitcnt vmcnt(%0)" :: "n"(8 + Epi::MIN_VMEM) : "memory")
#define GM_WAIT_L(n) asm volatile("s_waitcnt lgkmcnt(" #n ")" ::: "memory")
#define GM_BAR __builtin_amdgcn_s_barrier()
#define GM_SCHED __builtin_amdgcn_sched_barrier(0)
    Unit cur, nxt; int ui = 0;
    volatile LAS int* dq = (volatile LAS int*)(lds + LDSCTL_OFF + 128);
    unsigned dtok = 0u;
    if constexpr (DYN) {
        __syncthreads();
        if (tid == 0) { unsigned* q = S.draw_ptr(); dq[0] = (int)__hip_atomic_fetch_add(q, 1u, RLX_AGENT); dq[1] = (int)__hip_atomic_fetch_add(q, 1u, RLX_AGENT); }
        __syncthreads();
        if (!S.next(__builtin_amdgcn_readfirstlane(dq[0]), cur)) return;
    } else {
        if (!S.next(0, cur)) return;
    }
    f32x4 acc[2][2][4][2];
#pragma unroll
    for (int a = 0; a < 2; ++a)
#pragma unroll
        for (int b = 0; b < 2; ++b)
#pragma unroll
            for (int m = 0; m < 4; ++m)
#pragma unroll
                for (int n = 0; n < 2; ++n) acc[a][b][m][n] = (f32x4){0.f, 0.f, 0.f, 0.f};
    bf16x8 At[4][2], B0[2][2], B1[2][2];
    const char* cA = cur.A; const char* cB = cur.B;
    if constexpr (GATHER) {
#pragma unroll
        for (int h = 0; h < 2; ++h)
#pragma unroll
            for (int i = 0; i < 2; ++i) cvA[h][i] = S.row_off(cur, h * HALF + rA[i]) + cC[i];
    }
    GM_STAGE(GM_SB(0, 0), cB, voffB); GM_STAGE(GM_SB(0, 1), cB + HSTEP, voffB); GM_STAGE(GM_SA(0, 0), cA, cvA[0]); GM_STAGE(GM_SA(0, 1), cA, cvA[1]);
    if (wr == 1) GM_BAR;
    GM_WAIT_V(2); GM_BAR;
    GM_STAGE(GM_SB(1, 0), cB + KSTEP, voffB); GM_STAGE(GM_SA(1, 0), cA + KSTEP, cvA[0]); GM_STAGE(GM_SB(1, 1), cB + HSTEP + KSTEP, voffB);
    GM_WAIT_V(6); GM_BAR;
    for (;;) {
        bool has_next;
        if constexpr (DYN) {
            has_next = S.next(__builtin_amdgcn_readfirstlane(dq[(ui + 1) & 1]), nxt);
            if (tid == 0) { unsigned* q = S.draw_ptr(); const unsigned one = 1u; asm volatile("global_atomic_add %0, %1, %2, off sc0" : "=v"(dtok) : "v"(q), "v"(one) : "memory"); }
        } else has_next = S.next(ui + 1, nxt);
        const char* nA = has_next ? nxt.A : cA; const char* nB = has_next ? nxt.B : cB;
        if constexpr (GATHER) {
            if (has_next) {
#pragma unroll
                for (int h = 0; h < 2; ++h)
#pragma unroll
                    for (int i = 0; i < 2; ++i) nvA[h][i] = S.row_off(nxt, h * HALF + rA[i]) + cC[i];
            } else {
#pragma unroll
                for (int h = 0; h < 2; ++h)
#pragma unroll
                    for (int i = 0; i < 2; ++i) nvA[h][i] = cvA[h][i];
            }
        }
        const int nt = cur.nt;
        for (int t = 0; t < nt; t += 2) {
            const bool last = (t == nt - 2);
            if constexpr (DYN) { if (last && tid == 0) dq[ui & 1] = (int)dtok; }
            const char* a1 = cA + (size_t)(t + 1) * KSTEP;
            const char* a2 = last ? nA : cA + (size_t)(t + 2) * KSTEP; const char* b2 = last ? nB : cB + (size_t)(t + 2) * KSTEP;
            const char* a3 = a2 + KSTEP; const char* b3 = b2 + KSTEP;
            unsigned o0[2], o1[2];
            if constexpr (GATHER) { o0[0] = last ? nvA[0][0] : cvA[0][0]; o0[1] = last ? nvA[0][1] : cvA[0][1]; o1[0] = last ? nvA[1][0] : cvA[1][0]; o1[1] = last ? nvA[1][1] : cvA[1][1]; }
            else { o0[0] = cvA[0][0]; o0[1] = cvA[0][1]; o1[0] = cvA[1][0]; o1[1] = cvA[1][1]; }
            GM_LDB(B0, 0, 0); GM_LDB(B1, 0, 1); GM_SCHED; GM_LDA(At, 0, 0); GM_STAGE(GM_SA(1, 1), a1, cvA[1]);
            GM_WAIT_V(8); GM_WAIT_L(0); GM_BAR; GM_MMA(0, 0, At, B0); GM_MMA(0, 1, At, B1); GM_BAR; GM_SCHED;
            GM_LDA(At, 0, 1); GM_STAGE(GM_SB(0, 0), b2, voffB); GM_STAGE(GM_SB(0, 1), b2 + HSTEP, voffB); GM_STAGE(GM_SA(0, 0), a2, o0);
            GM_WAIT_V(8); GM_WAIT_L(0); GM_BAR; GM_MMA(1, 0, At, B0); GM_MMA(1, 1, At, B1); GM_BAR; GM_SCHED;
            GM_LDB(B0, 1, 0); GM_LDB(B1, 1, 1); GM_SCHED; GM_LDA(At, 1, 0); GM_STAGE(GM_SA(0, 1), a2, o1);
            GM_WAIT_V(8); GM_WAIT_L(0); GM_BAR; GM_MMA(0, 0, At, B0); GM_MMA(0, 1, At, B1); GM_BAR; GM_SCHED;
            GM_LDA(At, 1, 1); GM_STAGE(GM_SB(1, 0), b3, voffB); GM_STAGE(GM_SB(1, 1), b3 + HSTEP, voffB); GM_STAGE(GM_SA(1, 0), a3, o0);
            GM_WAIT_V(8); GM_WAIT_L(0); GM_BAR; GM_MMA(1, 0, At, B0); GM_MMA(1, 1, At, B1); GM_BAR; GM_SCHED;
        }
        if (wr == 0) GM_BAR;
        E(acc, cur, wr, wc, fr, fq);
        if (!has_next) break;
#pragma unroll
        for (int a = 0; a < 2; ++a)
#pragma unroll
            for (int b = 0; b < 2; ++b)
#pragma unroll
                for (int m = 0; m < 4; ++m)
#pragma unroll
                    for (int n = 0; n < 2; ++n) acc[a][b][m][n] = (f32x4){0.f, 0.f, 0.f, 0.f};
        cur = nxt; cA = nA; cB = nB; ++ui;
        if constexpr (GATHER) {
#pragma unroll
            for (int h = 0; h < 2; ++h)
#pragma unroll
                for (int i = 0; i < 2; ++i) cvA[h][i] = nvA[h][i];
        }
        if (wr == 1) GM_BAR;
    }
    GM_WAIT_V(0);
    GM_BAR;
#undef GM_SA
#undef GM_SB
#undef GM_STAGE
#undef GM_LDA
#undef GM_LDB
#undef GM_MMA
#undef GM_WAIT_V
#undef GM_WAIT_VE
#undef GM_WAIT_L
#undef GM_BAR
#undef GM_SCHED
}
}

struct Args { const float* in[23]; float* out; unsigned char* ws; int ph_lo, ph_hi; };
struct Frame {
    LAS unsigned char* lds;
    unsigned* ctl;
    unsigned char* ws;
    int tid, lane, wave, G, bid, wave0;
    const Args* a;
};
#define FIN(i) (F.a->in[i])
#define FRESH_IDS(F) do { int t_ = tid_of((F).wave0); asm volatile("" : "+v"(t_)); (F).tid = t_; (F).lane = t_ & 63; (F).wave = __builtin_amdgcn_readfirstlane(t_ >> 6); } while (0)
#define WSP(T, off) ((T*)(F.ws + (off)))

template <class T> __device__ __forceinline__ T ldg(const void* base, unsigned off) { return *(const T*)((const char*)base + off); }
template <class T> __device__ __forceinline__ void stg(void* base, unsigned off, T v) { *(T*)((char*)base + off) = v; }
typedef f32x4 Acc[2][2][4][2];

struct EpiZ {
    static constexpr int MIN_VMEM = 16;
    bf16* Z; bf16* VT; float* vss;
    __device__ __forceinline__ void operator()(const Acc& acc, const gm::Unit& u, int wr, int wc, int fr, int fq) const {
        asm volatile("" : "+v"(fr), "+v"(fq));
        if (u.kind == 1) {
            bf16* base = VT + (size_t)((u.pn - 4) * 256) * NTOK + u.pm * 256; const unsigned lo = ((unsigned)(wr * 64 + fr) * NTOK + wc * 32 + 8 * fq) * 2u;
            float ss[2][8];
#pragma unroll
            for (int bj = 0; bj < 2; ++bj)
#pragma unroll
                for (int j = 0; j < 8; ++j) ss[bj][j] = 0.f;
#pragma unroll
            for (int ai = 0; ai < 2; ++ai)
#pragma unroll
                for (int m = 0; m < 4; ++m) {
#pragma unroll
                    for (int bj = 0; bj < 2; ++bj) { float v[8];
#pragma unroll
                        for (int j = 0; j < 8; ++j) { v[j] = gelu_tanh(acc[ai][bj][m][j >> 2][j & 3]); ss[bj][j] += v[j] * v[j]; }
                        u32x4 w; w.x = cvt_pk_bf16(v[0], v[1]); w.y = cvt_pk_bf16(v[2], v[3]); w.z = cvt_pk_bf16(v[4], v[5]); w.w = cvt_pk_bf16(v[6], v[7]);
                        stg<u32x4>(base, lo + (unsigned)((ai * 128 + m * 16) * NTOK + bj * 128) * 2u, w); }
                    asm volatile("" ::: "memory"); __builtin_amdgcn_sched_barrier(0); }
            float* vb = vss + u.pm * 256; const unsigned vo = (unsigned)(wc * 32 + 8 * fq) * 4u;
#pragma unroll
            for (int bj = 0; bj < 2; ++bj)
#pragma unroll
                for (int j = 0; j < 8; ++j) { float sv = ss[bj][j]; sv += __shfl_xor(sv, 1); sv += __shfl_xor(sv, 2); sv += __shfl_xor(sv, 4); sv += __shfl_xor(sv, 8); ss[bj][j] = sv; }
            if (fr == 0) {
#pragma unroll
                for (int bj = 0; bj < 2; ++bj)
#pragma unroll
                    for (int j = 0; j < 8; ++j) atomicAdd((float*)((char*)vb + vo + (bj * 128 + j) * 4), ss[bj][j]); }
        } else if (u.kind == 4) {
            const int j = u.pn < 16 ? u.pn - 12 : u.pn - 16;
            bf16* base = Z + (size_t)(u.pm * 256) * INC + Z_X + 128 * j; const unsigned lo = ((unsigned)(wr * 64 + fr) * INC + wc * 32 + 8 * fq) * 2u;
#pragma unroll
            for (int ai = 0; ai < 2; ++ai)
#pragma unroll
                for (int m = 0; m < 4; ++m) { const f32x4 o0 = acc[ai][0][m][0] * acc[ai][1][m][0], o1 = acc[ai][0][m][1] * acc[ai][1][m][1];
                    u32x4 w; w.x = cvt_pk_bf16(o0[0], o0[1]); w.y = cvt_pk_bf16(o0[2], o0[3]); w.z = cvt_pk_bf16(o1[0], o1[1]); w.w = cvt_pk_bf16(o1[2], o1[3]);
                    stg<u32x4>(base, lo + (unsigned)((ai * 128 + m * 16) * INC) * 2u, w); }
        } else if (u.kind == 0) rowmajor<0>(acc, u, wr, wc, fr, fq);
        else if (u.kind == 3) rowmajor<3>(acc, u, wr, wc, fr, fq);
        else rowmajor<2>(acc, u, wr, wc, fr, fq);
    }
    template <int KIND> __device__ __forceinline__ void rowmajor(const Acc& acc, const gm::Unit& u, int wr, int wc, int fr, int fq) const {
        bf16* base = Z + (size_t)(u.pm * 256) * INC + u.pn * 256; const unsigned lo = ((unsigned)(wr * 64 + fr) * INC + wc * 32 + 8 * fq) * 2u;
#pragma unroll
        for (int ai = 0; ai < 2; ++ai)
#pragma unroll
            for (int m = 0; m < 4; ++m) {
#pragma unroll
                for (int bj = 0; bj < 2; ++bj) { float v[8];
#pragma unroll
                    for (int j = 0; j < 8; ++j) { const float a = acc[ai][bj][m][j >> 2][j & 3]; v[j] = KIND == 0 ? gelu_tanh(a) : (KIND == 3 ? sigmoidf_fast(a) : a); }
                    u32x4 w; w.x = cvt_pk_bf16(v[0], v[1]); w.y = cvt_pk_bf16(v[2], v[3]); w.z = cvt_pk_bf16(v[4], v[5]); w.w = cvt_pk_bf16(v[6], v[7]);
                    stg<u32x4>(base, lo + (unsigned)((ai * 128 + m * 16) * INC + bj * 128) * 2u, w); }
                asm volatile("" ::: "memory"); __builtin_amdgcn_sched_barrier(0); }
    }
};
struct SchedZ {
    int G, c; const char* H; const char* W; unsigned* q;
    __device__ __forceinline__ unsigned* draw_ptr() const { return q + 16 * (c & 7); }
    __device__ __forceinline__ bool next(int j, gm::Unit& u) const {
        const int L = 8 * j + (c & 7); if (j < 0 || L >= 128 * 36) return false;
        int pm, pn; gm::tile_map(L, 128, 36, pm, pn);
        u.pm = pm; u.pn = pn; u.nt = 16; u.aux = 0;
        if (pn >= 4 && pn < 8) { u.A = W + (size_t)pn * gm::TSTEP; u.B = H + (size_t)pm * gm::TSTEP; u.kind = 1; }
        else { u.A = H + (size_t)pm * gm::TSTEP; u.B = W + (size_t)pn * gm::TSTEP; u.kind = pn < 4 ? 0 : (pn >= 24 ? 3 : (((pn >= 12 && pn < 16) || (pn >= 20 && pn < 24)) ? 4 : 2)); }
        return true;
    }
    __device__ __forceinline__ unsigned row_off(const gm::Unit&, int) const { return 0u; }
};

struct EpiMix {
    static constexpr int MIN_VMEM = 16;
    const bf16* Z; bf16* MIX; const float* pscale;
    __device__ __forceinline__ void operator()(const Acc& acc, const gm::Unit& u, int wr, int wc, int fr, int fq) const {
        asm volatile("" : "+v"(fr), "+v"(fq));
        if (u.kind == 0) body<0>(acc, u, wr, wc, fr, fq); else if (u.kind == 1) body<1>(acc, u, wr, wc, fr, fq); else body<2>(acc, u, wr, wc, fr, fq);
    }
    template <int KIND> __device__ __forceinline__ void body(const Acc& acc, const gm::Unit& u, int wr, int wc, int fr, int fq) const {
        const int lr = wr * 64 + fr, lc = wc * 32 + 8 * fq;
        const bf16* zb = Z + (size_t)(u.pm * 256) * INC + (KIND == 0 ? Z_GA : (KIND == 1 ? Z_GC : Z_GB)) + u.pn * 256; const unsigned zo = ((unsigned)lr * INC + lc) * 2u;
        bf16* xb = MIX + (size_t)(u.pm * 256) * D + u.pn * 256; const unsigned xo = ((unsigned)lr * D + lc) * 2u;
        f32x4 ps[2][2];
#pragma unroll
        for (int bj = 0; bj < 2; ++bj)
#pragma unroll
            for (int n = 0; n < 2; ++n) ps[bj][n] = KIND == 2 ? ldg<f32x4>(pscale + u.pn * 256, (unsigned)(lc + bj * 128 + 4 * n) * 4u) : (f32x4){1.f, 1.f, 1.f, 1.f};
#pragma unroll
        for (int ai = 0; ai < 2; ++ai)
#pragma unroll
          for (int mp = 0; mp < 2; ++mp) {
            u32x4 gw[2][2], mw[2][2];
#pragma unroll
            for (int mm = 0; mm < 2; ++mm)
#pragma unroll
                for (int bj = 0; bj < 2; ++bj) { const unsigned ro = (unsigned)(ai * 128 + (2 * mp + mm) * 16);
                    gw[mm][bj] = ldg<u32x4>(zb, zo + (ro * INC + bj * 128) * 2u);
                    if (KIND != 0) mw[mm][bj] = ldg<u32x4>(xb, xo + (ro * D + bj * 128) * 2u); else mw[mm][bj] = (u32x4){0u, 0u, 0u, 0u}; }
#pragma unroll
            for (int mm = 0; mm < 2; ++mm)
#pragma unroll
                for (int bj = 0; bj < 2; ++bj) { const int m = 2 * mp + mm; const unsigned ro = (unsigned)(ai * 128 + m * 16); const u32x4 g = gw[mm][bj], q = mw[mm][bj];
                    f32x4 g0 = {bflo(g.x), bfhi(g.x), bflo(g.y), bfhi(g.y)}, g1 = {bflo(g.z), bfhi(g.z), bflo(g.w), bfhi(g.w)};
                    if (KIND == 2) { g0 *= ps[bj][0]; g1 *= ps[bj][1]; }
                    const f32x4 o0 = g0 * acc[ai][bj][m][0] + (f32x4){bflo(q.x), bfhi(q.x), bflo(q.y), bfhi(q.y)}, o1 = g1 * acc[ai][bj][m][1] + (f32x4){bflo(q.z), bfhi(q.z), bflo(q.w), bfhi(q.w)};
                    u32x4 w; w.x = cvt_pk_bf16(o0[0], o0[1]); w.y = cvt_pk_bf16(o0[2], o0[3]); w.z = cvt_pk_bf16(o1[0], o1[1]); w.w = cvt_pk_bf16(o1[2], o1[3]);
                    stg<u32x4>(xb, xo + (ro * D + bj * 128) * 2u, w); }
            asm volatile("" ::: "memory");
          }
    }
};
struct SchedMix {
    int G, c; const char *AIN, *CIN, *PIN, *WA, *WC, *WP;
    __device__ __forceinline__ bool next(int i, gm::Unit& u) const {
        const int rnd = i / 3, ty = i - rnd * 3; const int L = rnd * G + c; if (L >= 128 * 4) return false;
        int pm, pn; gm::tile_map(L, 128, 4, pm, pn);
        u.pm = pm; u.pn = pn; u.kind = ty; u.aux = 0;
        if (ty == 0) { u.A = AIN + (size_t)pm * gm::TSTEP; u.B = WA + (size_t)pn * gm::TSTEP; u.nt = 16; }
        else if (ty == 1) { u.A = CIN + (size_t)pm * gm::TSTEP; u.B = WC + (size_t)pn * gm::TSTEP; u.nt = 16; }
        else { u.A = PIN + (size_t)pm * gm::TSTEP + pn * 512; u.B = WP + (size_t)pn * gm::TSTEP + pn * 512; u.nt = 4; }
        return true;
    }
    __device__ __forceinline__ unsigned row_off(const gm::Unit&, int) const { return 0u; }
};

template <bool XF32> struct EpiOut {
    static constexpr bool CHAIN = false;
    const void* xin; bf16* xout; const float* g1;
    __device__ __forceinline__ void operator()(const Acc& acc, const gm::Unit& u, int wr, int wc, int fr, int fq) const {
        asm volatile("" : "+v"(fr), "+v"(fq));
        const int lr = wr * 64 + fr, lc = wc * 32 + 8 * fq; const int b = u.pm / 16;
        bf16* ob = xout + (size_t)(u.pm * 256) * D + u.pn * 256; const unsigned xo = ((unsigned)lr * D + lc) * 2u;
        f32x4 gv[2][2];
#pragma unroll
        for (int bj = 0; bj < 2; ++bj)
#pragma unroll
            for (int n = 0; n < 2; ++n) gv[bj][n] = ldg<f32x4>(g1 + (size_t)b * 6 * D + u.pn * 256, (unsigned)(lc + bj * 128 + 4 * n) * 4u);
        if constexpr (XF32) {
            const float* ib = (const float*)xin + (size_t)(u.pm * 256) * D + u.pn * 256;
#pragma unroll
            for (int ai = 0; ai < 2; ++ai)
#pragma unroll
                for (int mp = 0; mp < 2; ++mp) {
                    f32x4 xv[2][2][2];
#pragma unroll
                    for (int mm = 0; mm < 2; ++mm)
#pragma unroll
                        for (int bj = 0; bj < 2; ++bj) { const unsigned o = 2u * xo + ((unsigned)(ai * 128 + (2 * mp + mm) * 16) * D + bj * 128) * 4u; xv[mm][bj][0] = ldg<f32x4>(ib, o); xv[mm][bj][1] = ldg<f32x4>(ib, o + 16u); }
#pragma unroll
                    for (int mm = 0; mm < 2; ++mm)
#pragma unroll
                        for (int bj = 0; bj < 2; ++bj) { const int m = 2 * mp + mm; const f32x4 o0 = xv[mm][bj][0] + gv[bj][0] * acc[ai][bj][m][0], o1 = xv[mm][bj][1] + gv[bj][1] * acc[ai][bj][m][1];
                            u32x4 w; w.x = cvt_pk_bf16(o0[0], o0[1]); w.y = cvt_pk_bf16(o0[2], o0[3]); w.z = cvt_pk_bf16(o1[0], o1[1]); w.w = cvt_pk_bf16(o1[2], o1[3]);
                            stg<u32x4>(ob, xo + ((unsigned)(ai * 128 + m * 16) * D + bj * 128) * 2u, w); }
                    asm volatile("" ::: "memory");
                }
        } else {
            const bf16* ib = (const bf16*)xin + (size_t)(u.pm * 256) * D + u.pn * 256;
#pragma unroll
            for (int ai = 0; ai < 2; ++ai) {
                u32x4 xv[4][2];
#pragma unroll
                for (int m = 0; m < 4; ++m)
#pragma unroll
                    for (int bj = 0; bj < 2; ++bj) xv[m][bj] = ldg<u32x4>(ib, xo + ((unsigned)(ai * 128 + m * 16) * D + bj * 128) * 2u);
#pragma unroll
                for (int m = 0; m < 4; ++m)
#pragma unroll
                    for (int bj = 0; bj < 2; ++bj) { const u32x4 q = xv[m][bj];
                        const f32x4 o0 = (f32x4){bflo(q.x), bfhi(q.x), bflo(q.y), bfhi(q.y)} + gv[bj][0] * acc[ai][bj][m][0], o1 = (f32x4){bflo(q.z), bfhi(q.z), bflo(q.w), bfhi(q.w)} + gv[bj][1] * acc[ai][bj][m][1];
                        u32x4 w; w.x = cvt_pk_bf16(o0[0], o0[1]); w.y = cvt_pk_bf16(o0[2], o0[3]); w.z = cvt_pk_bf16(o1[0], o1[1]); w.w = cvt_pk_bf16(o1[2], o1[3]);
                        stg<u32x4>(ob, xo + ((unsigned)(ai * 128 + m * 16) * D + bj * 128) * 2u, w); }
                asm volatile("" ::: "memory");
            }
        }
    }
};
struct SchedOut {
    int G, c; const char *MIXP, *WO;
    __device__ __forceinline__ bool next(int i, gm::Unit& u) const {
        const int L = i * G + c; if (L >= 128 * 4) return false;
        int pm, pn; gm::tile_map(L, 128, 4, pm, pn);
        u.pm = pm; u.pn = pn; u.kind = 0; u.aux = 0; u.nt = 16; u.A = MIXP + (size_t)pm * gm::TSTEP; u.B = WO + (size_t)pn * gm::TSTEP;
        return true;
    }
    __device__ __forceinline__ unsigned row_off(const gm::Unit&, int) const { return 0u; }
};

struct SchedMoe {
    int NG, r, x, npn; const LAS int* tb;
    const char* Abase; const char* Wbase; unsigned wstride;
    const int* LIST; bool gather;
    __device__ __forceinline__ bool next(int i, gm::Unit& u) const {
        const int j = i * NG + r; int mt = j / npn; const int pn = j - mt * npn;
#define TB(i) __builtin_amdgcn_readfirstlane(tb[i])
        int e = x; int T = TB(e);
        if (mt >= T) { mt -= T; e += 8; T = TB(e);
            if (mt >= T) { mt -= T; e += 8; T = TB(e);
                if (mt >= T) { mt -= T; e += 8; T = TB(e); if (mt >= T) return false; } } }
        u.aux = e; u.pn = pn; u.nt = 16; u.kind = TB(64 + e) - 256 * mt;
        const int arow = TB(32 + e) + 256 * mt;
        if (gather) { u.A = Abase; u.pm = arow; u.B = Wbase + (size_t)e * wstride + (size_t)pn * gm::TSTEP; }
        else { u.A = Abase + (size_t)arow * gm::PITCH; u.pm = 256 * mt; u.B = Wbase + (size_t)e * wstride + (size_t)pn * gm::TSTEP; }
        return true;
    }
    __device__ __forceinline__ unsigned row_off(const gm::Unit& u, int rr) const {
        const int mt256 = u.pm - TB(32 + u.aux);
        int slot = LIST[(size_t)u.aux * NTOK + mt256 + rr]; slot = (rr < u.kind) ? slot : 0;
        return (unsigned)(slot >> 2) * gm::PITCH;
    }
};
struct EpiGU {
    static constexpr int MIN_VMEM = 8;
    bf16* ACT; const float* bgu;
    __device__ __forceinline__ void operator()(const Acc& acc, const gm::Unit& u, int wr, int wc, int fr, int fq) const {
        asm volatile("" : "+v"(fr), "+v"(fq));
        const int e = u.aux, lc = wc * 32 + 8 * fq;
        bf16* ab = ACT + (size_t)u.pm * FF + u.pn * 128; const unsigned ao = ((unsigned)(wr * 64 + fr) * FF + lc) * 2u;
        const float* bb = bgu + (size_t)e * 2 * FF + u.pn * 128;
        f32x4 bg[2], bu[2];
#pragma unroll
        for (int n = 0; n < 2; ++n) { bg[n] = ldg<f32x4>(bb, (unsigned)(lc + 4 * n) * 4u); bu[n] = ldg<f32x4>(bb + FF, (unsigned)(lc + 4 * n) * 4u); }
#pragma unroll
        for (int ai = 0; ai < 2; ++ai)
#pragma unroll
            for (int m = 0; m < 4; ++m) { float o[8];
#pragma unroll
                for (int j = 0; j < 8; ++j) { float g = acc[ai][0][m][j >> 2][j & 3] + bg[j >> 2][j & 3], up = acc[ai][1][m][j >> 2][j & 3] + bu[j >> 2][j & 3];
                    g = fminf(g, 7.0f); up = fminf(fmaxf(up, -7.0f), 7.0f);
                    const float glu = g * __builtin_amdgcn_rcpf(1.0f + __builtin_amdgcn_exp2f(-1.702f * 1.44269504089f * g));
                    o[j] = (up + 1.0f) * glu; }
                u32x4 w; w.x = cvt_pk_bf16(o[0], o[1]); w.y = cvt_pk_bf16(o[2], o[3]); w.z = cvt_pk_bf16(o[4], o[5]); w.w = cvt_pk_bf16(o[6], o[7]);
                stg<u32x4>(ab, ao + (unsigned)((ai * 128 + m * 16) * FF) * 2u, w);
                asm volatile("" ::: "memory"); }
    }
};
struct EpiDown {
    static constexpr int MIN_VMEM = 16;
    bf16* YB; const float* bdn; const int* LIST; const float* WL;
    __device__ __forceinline__ void operator()(const Acc& acc, const gm::Unit& u, int wr, int wc, int fr, int fq) const {
        asm volatile("" : "+v"(fr), "+v"(fq));
        const int e = u.aux, lc = wc * 32 + 8 * fq, nvalid = u.kind, lr = wr * 64 + fr;
        const int* lb = LIST + (size_t)e * NTOK + u.pm; const float* wb = WL + (size_t)e * NTOK + u.pm;
        bf16* yb = YB + u.pn * 256; const float* bb = bdn + (size_t)e * D + u.pn * 256;
        f32x4 bd[2][2];
#pragma unroll
        for (int bj = 0; bj < 2; ++bj)
#pragma unroll
            for (int n = 0; n < 2; ++n) bd[bj][n] = ldg<f32x4>(bb, (unsigned)(lc + bj * 128 + 4 * n) * 4u);
        int slots[2][4]; float wts[2][4];
#pragma unroll
        for (int ai = 0; ai < 2; ++ai)
#pragma unroll
            for (int m = 0; m < 4; ++m) { const unsigned r = (unsigned)(lr + ai * 128 + m * 16); slots[ai][m] = ldg<int>(lb, r * 4u); wts[ai][m] = ldg<float>(wb, r * 4u); }
#pragma unroll
        for (int ai = 0; ai < 2; ++ai)
#pragma unroll
            for (int m = 0; m < 4; ++m) { const int r = lr + ai * 128 + m * 16;
                const unsigned slot = (r < nvalid) ? (unsigned)slots[ai][m] : (unsigned)(NTOK * TOPK); const float w = (r < nvalid) ? wts[ai][m] : 0.f;
#pragma unroll
                for (int bj = 0; bj < 2; ++bj) { const f32x4 y0 = (acc[ai][bj][m][0] + bd[bj][0]) * w, y1 = (acc[ai][bj][m][1] + bd[bj][1]) * w;
                    u32x4 o; o.x = cvt_pk_bf16(y0[0], y0[1]); o.y = cvt_pk_bf16(y0[2], y0[3]); o.z = cvt_pk_bf16(y1[0], y1[1]); o.w = cvt_pk_bf16(y1[2], y1[3]);
                    stg<u32x4>(yb, (slot * D + lc + bj * 128) * 2u, o); }
                asm volatile("" ::: "memory"); }
    }
};

__device__ __forceinline__ void tt_load(f32x4 (&tv)[16], const float* W, int N, int k0, int n0, int lane) {
#pragma unroll
    for (int i = 0; i < 16; ++i) tv[i] = ldg<f32x4>(W + (size_t)k0 * N + n0, ((unsigned)(i * 4 + (lane >> 4)) * (unsigned)N + 4u * (lane & 15)) * 4u);
}
__device__ __forceinline__ void tt_store(const f32x4 (&tv)[16], int k0, int n0, bf16* WT, int drow0, int dcol0, LAS float* scr, int lane) {
#pragma unroll
    for (int i = 0; i < 16; ++i) { const int kk = i * 4 + (lane >> 4); LAS float* p = scr + kk * 65 + 4 * (lane & 15); p[0] = tv[i].x; p[1] = tv[i].y; p[2] = tv[i].z; p[3] = tv[i].w; }
    asm volatile("s_waitcnt lgkmcnt(0)" ::: "memory");
    const int c = lane & 7;
#pragma unroll
    for (int j = 0; j < 8; ++j) { const int n = (lane >> 3) + 8 * j; const LAS float* s = scr + (8 * c) * 65 + n;
        u32x4 o; o.x = cvt_pk_bf16(s[0 * 65], s[1 * 65]); o.y = cvt_pk_bf16(s[2 * 65], s[3 * 65]); o.z = cvt_pk_bf16(s[4 * 65], s[5 * 65]); o.w = cvt_pk_bf16(s[6 * 65], s[7 * 65]);
        stg<u32x4>(WT + (size_t)(drow0 + n0) * 1024 + dcol0 + k0, ((unsigned)n * 1024u + 8u * c) * 2u, o);
        if (j & 1) __builtin_amdgcn_sched_barrier(0); }
    asm volatile("s_waitcnt lgkmcnt(0)" ::: "memory");
}
struct P0Item { const float* W; bf16* WT; int N, k0, n0, drow0, dcol0; };
__device__ __forceinline__ P0Item p0_decode(Frame& F, int it) {
    constexpr int I_GU = 16 * 32, I_DN = 16 * 16, I_IN = 16 * 144, I_SQ = 16 * 16, I_PL = 4 * 4;
    constexpr int N_GU = DEPTH * NE * I_GU, N_DN = DEPTH * NE * I_DN, N_IN = DEPTH * I_IN, N_SQ = DEPTH * I_SQ;
    P0Item t; t.dcol0 = 0; t.drow0 = 0;
    int r = it;
    if (r < N_GU) { const int mat = r / I_GU, q = r % I_GU, kb = q / 32, nb = q % 32, n0 = 64 * nb, half = n0 / FF, f0 = n0 % FF;
        t.W = FIN(18) + (size_t)mat * D * 2 * FF; t.N = 2 * FF; t.k0 = 64 * kb; t.n0 = n0; t.WT = WSP(bf16, WS_WTGU) + (size_t)mat * 2 * FF * D; t.drow0 = (f0 / 128) * 256 + 128 * half + (f0 % 128) - n0; return t; }
    r -= N_GU;
    if (r < N_DN) { const int mat = r / I_DN, q = r % I_DN, kb = q / 16, nb = q % 16;
        t.W = FIN(20) + (size_t)mat * FF * D; t.N = D; t.k0 = 64 * kb; t.n0 = 64 * nb; t.WT = WSP(bf16, WS_WTDN) + (size_t)mat * D * FF; return t; }
    r -= N_DN;
    if (r < N_IN) { const int mat = r / I_IN, q = r % I_IN, kb = q / 144, nb = q % 144;
        const int n0 = 64 * nb; int dr = n0;
        if (n0 >= Z_X && n0 < Z_X + D) { const int f = n0 - Z_X, j = f >> 7; dr = (j < 4 ? 12 + j : 16 + j) * 256 + (f & 127); }
        else if (n0 >= Z_C && n0 < Z_C + D) { const int f = n0 - Z_C, j = f >> 7; dr = (j < 4 ? 12 + j : 16 + j) * 256 + 128 + (f & 127); }
        t.W = FIN(5) + (size_t)mat * D * INC; t.N = INC; t.k0 = 64 * kb; t.n0 = n0; t.WT = WSP(bf16, WS_WTIN) + (size_t)mat * INC * D; t.drow0 = dr - n0; return t; }
    r -= N_IN;
    if (r < 3 * N_SQ) { const int which = r / N_SQ, q2 = r % N_SQ, mat = q2 / I_SQ, q = q2 % I_SQ, kb = q / 16, nb = q % 16;
        t.W = (which == 0 ? FIN(9) : (which == 1 ? FIN(13) : FIN(14))) + (size_t)mat * D * D;
        t.WT = WSP(bf16, which == 0 ? WS_WTA : (which == 1 ? WS_WTC : WS_WTO)) + (size_t)mat * D * D;
        t.N = D; t.k0 = 64 * kb; t.n0 = 64 * nb; return t; }
    r -= 3 * N_SQ;
    { const int mat = r / I_PL, q = r % I_PL, kb = q / 4, nb = q % 4, l = mat / 4, g = mat % 4;
        t.W = FIN(10) + (size_t)mat * 256 * 256; t.N = 256; t.k0 = 64 * kb; t.n0 = 64 * nb; t.WT = WSP(bf16, WS_WTPOOL) + (size_t)l * D * D; t.drow0 = g * 256; t.dcol0 = g * 256; }
    return t;
}
template <int MODE>
__device__ __forceinline__ void convert_items(Frame& F, unsigned* ctr, int l) {
    constexpr int I_GU = 16 * 32, I_DN = 16 * 16, I_IN = 16 * 144, I_SQ = 16 * 16, I_PL = 4 * 4;
    constexpr int N_GU = DEPTH * NE * I_GU, N_DN = DEPTH * NE * I_DN, N_IN = DEPTH * I_IN, N_SQ = DEPTH * I_SQ, N_PL = DEPTH * 4 * I_PL;
    constexpr int NV = MODE == 0 ? N_IN + 3 * N_SQ + N_PL : (N_GU + N_DN) / DEPTH;
    static_assert(NV % 8 == 0 && (N_GU / DEPTH) % 8 == 0, "chunks of eight (a chunk is whole or absent, and of one kind)");
    FRESH_IDS(F);
    LAS float* scr = (LAS float*)(F.lds + F.wave * 16640);
    LAS int* nbs = (LAS int*)(F.lds + LDSCTL_OFF + 64);
#define CV_ITEM(v) (MODE == 0 ? N_GU + N_DN + (v) : ((v) < N_GU / DEPTH ? l * (N_GU / DEPTH) + (v) : N_GU + l * (N_DN / DEPTH) + (v) - N_GU / DEPTH))
    __syncthreads();
    if (F.tid == 0) { nbs[0] = (int)__hip_atomic_fetch_add(ctr, 8u, RLX_AGENT); nbs[1] = (int)__hip_atomic_fetch_add(ctr, 8u, RLX_AGENT); }
    __syncthreads();
    int cur = __builtin_amdgcn_readfirstlane(nbs[0]), nxt = __builtin_amdgcn_readfirstlane(nbs[1]);
    f32x4 ta[16], tb[16];
    if (cur < NV) { const P0Item t = p0_decode(F, CV_ITEM(cur + F.wave)); tt_load(ta, t.W, t.N, t.k0, t.n0, F.lane); }
#define P0_STEP(TC, TN, slot) { int nn = 0; if (F.tid == 0) nn = (int)__hip_atomic_fetch_add(ctr, 8u, RLX_AGENT); \
        if (nxt < NV) { const P0Item t = p0_decode(F, CV_ITEM(nxt + F.wave)); tt_load(TN, t.W, t.N, t.k0, t.n0, F.lane); } \
        { const P0Item t = p0_decode(F, CV_ITEM(cur + F.wave)); tt_store(TC, t.k0, t.n0, t.WT, t.drow0, t.dcol0, scr, F.lane); } \
        if (F.tid == 0) nbs[slot] = nn; \
        __syncthreads(); \
        cur = nxt; nxt = __builtin_amdgcn_readfirstlane(nbs[slot]); }
    while (cur < NV) {
        P0_STEP(ta, tb, 0)
        if (cur >= NV) break;
        P0_STEP(tb, ta, 1)
    }
#undef P0_STEP
#undef CV_ITEM
    __syncthreads();
}
__device__ __forceinline__ void p0_prologue(Frame& F) {
    FRESH_IDS(F);
    float* mods = WSP(float, WS_MODS);
    {
        LAS float* sil = (LAS float*)(F.lds + 65536);
        LAS f32x4* part = (LAS f32x4*)F.lds;
        for (int i = F.tid; i < NB * D; i += NTHREADS) { const float cv = FIN(1)[i]; sil[i] = cv * __builtin_amdgcn_rcpf(1.0f + __builtin_amdgcn_exp2f(-1.44269504089f * cv)); }
        __syncthreads();
        for (int cb = F.bid; cb < 256; cb += F.G) {
            const int l = cb >> 7, colq = F.lane % 12, rsub = F.lane / 12, cbase = (cb & 127) * 48, k0 = F.wave * 128;
            const float* aw = FIN(3) + (size_t)l * D * 6 * D + cbase;
            f32x4 a[NB];
#pragma unroll
            for (int b = 0; b < NB; ++b) a[b] = (f32x4){0.f, 0.f, 0.f, 0.f};
#pragma unroll
            for (int jb = 0; jb < 2; ++jb) { f32x4 w[13]; int kk[13];
#pragma unroll
                for (int j = 0; j < 13; ++j) { const int k = k0 + 5 * (13 * jb + j) + rsub; kk[j] = k < k0 + 128 ? k : k0 + 127; w[j] = ldg<f32x4>(aw, ((unsigned)kk[j] * (6u * D) + 4u * colq) * 4u);
                    if (!(rsub < 5 && k < k0 + 128)) w[j] = (f32x4){0.f, 0.f, 0.f, 0.f}; }
#pragma unroll
                for (int j = 0; j < 13; ++j) {
#pragma unroll
                    for (int b = 0; b < NB; ++b) a[b] += w[j] * sil[b * D + kk[j]];
                    __builtin_amdgcn_sched_barrier(0); } }
#pragma unroll
            for (int b = 0; b < NB; ++b) part[(F.wave * 64 + F.lane) * NB + b] = a[b];
            __syncthreads();
            if (F.tid < 96) { const int b = F.tid / 12, cq = F.tid % 12;
                f32x4 sum = ldg<f32x4>(FIN(4) + (size_t)l * 6 * D + cbase, (unsigned)(4 * cq) * 4u);
#pragma unroll
                for (int w = 0; w < 8; ++w) {
#pragma unroll
                    for (int rs = 0; rs < 5; ++rs) sum += part[(w * 64 + cq + 12 * rs) * NB + b];
                    __builtin_amdgcn_sched_barrier(0); }
                stg<f32x4>(mods + (size_t)l * NB * 6 * D + cbase, ((unsigned)b * (6u * D) + 4u * cq) * 4u, sum); }
            __syncthreads();
        }
    }
    convert_items<0>(F, F.ctl + CW_P0CTR, 0);
}

struct RowBuf { f32x4 x[4]; u32x2 xb[4]; u32x2 y[4][4]; };
template <bool HASY>
__device__ __forceinline__ void row_load(RowBuf& R, const void* xin, const bf16* yb, int row, int lane) {
    if (HASY) {
#pragma unroll
        for (int j = 0; j < 4; ++j) R.xb[j] = *(const u32x2*)((const bf16*)xin + (size_t)row * D + 256 * j + 4 * lane);
#pragma unroll
        for (int j = 0; j < 4; ++j)
#pragma unroll
            for (int k = 0; k < TOPK; ++k) R.y[j][k] = *(const u32x2*)(yb + ((size_t)row * TOPK + k) * D + 256 * j + 4 * lane);
    } else {
#pragma unroll
        for (int j = 0; j < 4; ++j) R.x[j] = *(const f32x4*)((const float*)xin + (size_t)row * D + 256 * j + 4 * lane);
    }
}
template <int MODE, bool HASY>
__device__ __forceinline__ void norm_rows(Frame& F, const void* xin, const bf16* yb, const float* g2, bf16* xst, const float* gn, const float* sc, const float* sh, bf16* hout, float* fout) {
    FRESH_IDS(F);
    const int gw = F.bid * NWAVES + F.wave, NGW = F.G * NWAVES, lane = F.lane;
    f32x4 gnv[4], g2v[4], scv[4], shv[4]; int bcur = -1;
#pragma unroll
    for (int j = 0; j < 4; ++j) gnv[j] = *(const f32x4*)(gn + 256 * j + 4 * lane);
    RowBuf R0, R1;
    int row = gw;
    if (row < NTOK) row_load<HASY>(R0, xin, yb, row, lane);
#define NORM_PROCESS(R, row_) do { const int b = (row_) / SEQ; const size_t ro = (size_t)(row_) * D; \
        if (b != bcur) { bcur = b; _Pragma("unroll") for (int j = 0; j < 4; ++j) { const int col = 256 * j + 4 * lane; \
            if (HASY) g2v[j] = *(const f32x4*)(g2 + (size_t)b * 6 * D + col); \
            if (MODE == 0) { scv[j] = *(const f32x4*)(sc + (size_t)b * 6 * D + col); shv[j] = *(const f32x4*)(sh + (size_t)b * 6 * D + col); } } } \
        f32x4 v[4]; float s = 0.f; \
        _Pragma("unroll") for (int j = 0; j < 4; ++j) { \
            if (HASY) { f32x4 ys = unpack_lo4((R).y[j][0]); _Pragma("unroll") for (int k = 1; k < TOPK; ++k) ys += unpack_lo4((R).y[j][k]); v[j] = unpack_lo4((R).xb[j]) + g2v[j] * ys; } \
            else v[j] = (R).x[j]; \
            s += (v[j].x * v[j].x + v[j].y * v[j].y) + (v[j].z * v[j].z + v[j].w * v[j].w); } \
        if (xst) { _Pragma("unroll") for (int j = 0; j < 4; ++j) { u32x2 w; w.x = cvt_pk_bf16(v[j].x, v[j].y); w.y = cvt_pk_bf16(v[j].z, v[j].w); *(u32x2*)(xst + ro + 256 * j + 4 * lane) = w; } } \
        const float rstd = 1.0f / sqrtf(wave_sum(s) * (1.0f / D) + RMS_EPS); \
        _Pragma("unroll") for (int j = 0; j < 4; ++j) { const int col = 256 * j + 4 * lane; \
            if (MODE == 0) { const f32x4 o = v[j] * rstd * gnv[j] * (scv[j] + 1.0f) + shv[j]; u32x2 w; w.x = cvt_pk_bf16(o.x, o.y); w.y = cvt_pk_bf16(o.z, o.w); *(u32x2*)(hout + ro + col) = w; } \
            else { *(f32x4*)(fout + ro + col) = v[j] * rstd * gnv[j]; } } } while (0)
    while (row < NTOK) {
        const int r1 = row + NGW;
        if (r1 < NTOK) row_load<HASY>(R1, xin, yb, r1, lane);
        NORM_PROCESS(R0, row);
        if (r1 >= NTOK) break;
        const int r2 = r1 + NGW;
        if (r2 < NTOK) row_load<HASY>(R0, xin, yb, r2, lane);
        NORM_PROCESS(R1, r1);
        row = r2;
    }
#undef NORM_PROCESS
}

__device__ __forceinline__ void router_prep(Frame& F) {
    FRESH_IDS(F);
    const float* mods = WSP(float, WS_MODS); bf16* rwh = WSP(bf16, WS_RWT); bf16* rwl = WSP(bf16, WS_RWT + 1 * MiB); float* rb = WSP(float, WS_RBIAS);
    const int gt = F.bid * NTHREADS + F.tid, NGT = F.G * NTHREADS;
    for (int i = gt; i < DEPTH * NB * NE * D; i += NGT) { const int k = i % D, e = (i / D) % NE, b = (i / (D * NE)) % NB, l = i / (D * NE * NB);
        const float w = FIN(15)[l * D + k] * (1.0f + mods[((size_t)l * NB + b) * 6 * D + 4 * D + k]) * FIN(16)[((size_t)l * D + k) * NE + e];
        const unsigned hi = cvt_pk_bf16(w, 0.f) & 0xffffu, lo = cvt_pk_bf16(w - __uint_as_float(hi << 16), 0.f) & 0xffffu;
        rwh[i] = (bf16)hi; rwl[i] = (bf16)lo; }
    const int gw = F.bid * NWAVES + F.wave, NGW = F.G * NWAVES;
    for (int o = gw; o < DEPTH * NB * NE; o += NGW) { const int e = o % NE, b = (o / NE) % NB, l = o / (NE * NB); float s = 0.f;
        for (int k = F.lane; k < D; k += 64) s += mods[((size_t)l * NB + b) * 6 * D + 3 * D + k] * FIN(16)[((size_t)l * D + k) * NE + e];
        s = wave_sum(s); if (F.lane == 0) rb[o] = s + FIN(17)[l * NE + e]; }
}

__device__ __forceinline__ void mixer_prep(Frame& F, int l) {
    FRESH_IDS(F);
    const bf16* Z = WSP(bf16, WS_Z); const bf16* VT = WSP(bf16, WS_VT); const float* vss = WSP(float, WS_VSS) + (size_t)l * NTOK;
    bf16* AIN = WSP(bf16, WS_AIN); bf16* CIN = WSP(bf16, WS_CIN); bf16* PIN = WSP(bf16, WS_PIN);
    const float* convw = FIN(12) + (size_t)l * 3 * D; const float* gng = FIN(6) + (size_t)l * D; const float* ws = FIN(7) + (size_t)l * 8 * CHUNK * CHUNK; const float* bs = FIN(8) + (size_t)l * 8 * CHUNK;
    LAS unsigned char* Aimg = F.lds; LAS unsigned char* Bimg = F.lds + 32768; LAS float* rs = (LAS float*)(F.lds + 65536);
    for (int chunk = F.bid; chunk < NTOK / CHUNK; chunk += F.G) {
        const int tok0 = chunk * CHUNK, pos0 = tok0 % SEQ;
        FRESH_IDS(F);
        int tid = F.tid, lane = F.lane, wave = F.wave;
        {
            const int cg = (wave & 1) * 64 + lane, rsq = wave >> 1, t0 = 32 * rsq; const unsigned c0b = 16u * (unsigned)cg;
            float w0[8], w1[8], w2[8];
#pragma unroll
            for (int j = 0; j < 8; ++j) { w0[j] = ldg<float>(convw, 2 * c0b + 4 * j); w1[j] = ldg<float>(convw + D, 2 * c0b + 4 * j); w2[j] = ldg<float>(convw + 2 * D, 2 * c0b + 4 * j); }
            float p2[8], p1[8];
#pragma unroll
            for (int j = 0; j < 8; ++j) { p2[j] = 0.f; p1[j] = 0.f; }
            if (pos0 + t0 >= 2) {
#pragma unroll
                for (int q = 0; q < 2; ++q) { const bf16* zr = Z + (size_t)(tok0 + t0 - 2 + q) * INC; const u32x4 xv = ldg<u32x4>(zr + Z_X, c0b);
                    const unsigned xa[4] = {xv.x, xv.y, xv.z, xv.w};
#pragma unroll
                    for (int j = 0; j < 4; ++j) { const float a = bflo(xa[j]), bq = bfhi(xa[j]);
                        if (q == 0) { p2[2 * j] = a; p2[2 * j + 1] = bq; } else { p1[2 * j] = a; p1[2 * j + 1] = bq; } } }
            }
            const int pwin = 2 << (cg >> 5);
            float sw[8];
#pragma unroll
            for (int j = 0; j < 8; ++j) sw[j] = 0.f;
            for (int q = 1; q < 16; ++q) { if (q < pwin && pos0 + t0 - q >= 0) { const u32x4 pv = ldg<u32x4>(Z + (size_t)(tok0 + t0 - q) * INC + Z_P, c0b); const unsigned pa[4] = {pv.x, pv.y, pv.z, pv.w};
#pragma unroll
                    for (int j = 0; j < 4; ++j) { sw[2 * j] += bflo(pa[j]); sw[2 * j + 1] += bfhi(pa[j]); } } }
#pragma unroll 1
            for (int tb = t0; tb < t0 + 32; tb += 4) {
                u32x4 xv4[4], bv4[4], pv4[4], qv4[4];
#pragma unroll
                for (int r = 0; r < 4; ++r) { const bf16* zr = Z + (size_t)(tok0 + tb + r) * INC; const int pos = pos0 + tb + r;
                    xv4[r] = ldg<u32x4>(zr + Z_X, c0b); bv4[r] = ldg<u32x4>(zr + Z_B, c0b); pv4[r] = ldg<u32x4>(zr + Z_P, c0b);
                    const int back = (pos - (pwin - 1) >= 0) ? (pwin - 1) : 0;
                    qv4[r] = ldg<u32x4>(zr + Z_P - (ptrdiff_t)back * INC, c0b); }
#pragma unroll
                for (int r = 0; r < 4; ++r) { const int t = tb + r, pos = pos0 + t;
                    const unsigned xa[4] = {xv4[r].x, xv4[r].y, xv4[r].z, xv4[r].w}, ba[4] = {bv4[r].x, bv4[r].y, bv4[r].z, bv4[r].w},
                                   pa[4] = {pv4[r].x, pv4[r].y, pv4[r].z, pv4[r].w}, qa[4] = {qv4[r].x, qv4[r].y, qv4[r].z, qv4[r].w};
                    float zc[8], o[8], pf[8];
#pragma unroll
                    for (int j = 0; j < 4; ++j) { zc[2 * j] = bflo(xa[j]); zc[2 * j + 1] = bfhi(xa[j]); pf[2 * j] = bflo(pa[j]); pf[2 * j + 1] = bfhi(pa[j]); }
#pragma unroll
                    for (int j = 0; j < 8; ++j) { const float cvv = w0[j] * p2[j] + w1[j] * p1[j] + w2[j] * zc[j]; const float bb = (j & 1) ? bfhi(ba[j >> 1]) : bflo(ba[j >> 1]); o[j] = bb * cvv; p2[j] = p1[j]; p1[j] = zc[j]; }
                    u32x4 w; w.x = cvt_pk_bf16(o[0], o[1]); w.y = cvt_pk_bf16(o[2], o[3]); w.z = cvt_pk_bf16(o[4], o[5]); w.w = cvt_pk_bf16(o[6], o[7]);
                    stg<u32x4>(CIN + (size_t)(tok0 + t) * D, c0b, w);
                    const float inv = 1.0f / (float)((pos + 1) < pwin ? (pos + 1) : pwin);
#pragma unroll
                    for (int j = 0; j < 8; ++j) { sw[j] += pf[j]; o[j] = sw[j] * inv - pf[j]; }
                    w.x = cvt_pk_bf16(o[0], o[1]); w.y = cvt_pk_bf16(o[2], o[3]); w.z = cvt_pk_bf16(o[4], o[5]); w.w = cvt_pk_bf16(o[6], o[7]);
                    stg<u32x4>(PIN + (size_t)(tok0 + t) * D, c0b, w);
                    const float qm = (pos - (pwin - 1) >= 0) ? 1.0f : 0.0f;
#pragma unroll
                    for (int j = 0; j < 4; ++j) { sw[2 * j] -= qm * bflo(qa[j]); sw[2 * j + 1] -= qm * bfhi(qa[j]); } }
            }
        }
        FRESH_IDS(F); tid = F.tid; lane = F.lane; wave = F.wave;
        if (tid < CHUNK) rs[tid] = 1.0f / sqrtf(vss[tok0 + tid] * (1.0f / D) + RMS_EPS);
        f32x4 wa[4][2]; u32x4 gvv[4];
        const int tq = tid >> 4, kc = tid & 15;
        const unsigned woff = (unsigned)(tq * CHUNK + 8 * kc) * 4u, voff = ((unsigned)tq * NTOK + 8u * kc) * 2u;
#define GM_PREFETCH(h_) do { const float* wsh = ws + (size_t)(h_) * CHUNK * CHUNK; const bf16* vth = VT + (size_t)(h_) * CHUNK * NTOK + tok0; \
            _Pragma("unroll") for (int i = 0; i < 4; ++i) { \
                if (8 * kc <= tq + 32 * i) { wa[i][0] = ldg<f32x4>(wsh + 32 * i * CHUNK, woff); wa[i][1] = ldg<f32x4>(wsh + 32 * i * CHUNK, woff + 16); } \
                gvv[i] = ldg<u32x4>(vth + (size_t)32 * i * NTOK, voff); } } while (0)
        const int wr = wave >> 1, wc = wave & 1, fr = lane & 15, fq = lane >> 4;
        u32x2 uwA[2][4], uwB[2][4]; f32x4 ggA[4], ggB[4]; float btA[2], btB[2];
#define GM_EPI_LOAD(h_, UW, GG, BT) do { const unsigned coff_ = (unsigned)((h_) * CHUNK + 64 * wc + 4 * fq); \
            _Pragma("unroll") for (int n = 0; n < 4; ++n) GG[n] = ldg<f32x4>(gng, (coff_ + 16 * n) * 4u); \
            _Pragma("unroll") for (int m = 0; m < 2; ++m) { const int t = 32 * wr + 16 * m + fr; BT[m] = ldg<float>(bs, (unsigned)((h_) * CHUNK + t) * 4u); \
                _Pragma("unroll") for (int n = 0; n < 4; ++n) UW[m][n] = ldg<u32x2>(Z + (size_t)tok0 * INC + Z_U, ((unsigned)t * INC + coff_ + 16 * n) * 2u); } } while (0)
#define GM_HEAD(h, UW, GG, BT, UWN, GGN, BTN) do { \
            _Pragma("unroll") for (int i = 0; i < 4; ++i) { const int t = tq + 32 * i; \
                u32x4 w = {0u, 0u, 0u, 0u}; \
                if (8 * kc <= t) { float v[8] = {wa[i][0].x, wa[i][0].y, wa[i][0].z, wa[i][0].w, wa[i][1].x, wa[i][1].y, wa[i][1].z, wa[i][1].w}; \
                    _Pragma("unroll") for (int j = 0; j < 8; ++j) v[j] = (8 * kc + j <= t) ? v[j] * rs[8 * kc + j] : 0.f; \
                    w.x = cvt_pk_bf16(v[0], v[1]); w.y = cvt_pk_bf16(v[2], v[3]); w.z = cvt_pk_bf16(v[4], v[5]); w.w = cvt_pk_bf16(v[6], v[7]); } \
                *(LAS u32x4*)(Aimg + t * 256 + ((kc ^ (t & 15)) << 4)) = w; \
                *(LAS u32x4*)(Bimg + t * 256 + ((kc ^ (t & 15)) << 4)) = gvv[i]; }     \
            __syncthreads(); \
            if ((h) + 1 < 8) { GM_PREFETCH((h) + 1); GM_EPI_LOAD((h) + 1, UWN, GGN, BTN); } \
            const unsigned coff = (unsigned)((h) * CHUNK + 64 * wc + 4 * fq);     \
            f32x4 acc[2][4]; \
            _Pragma("unroll") for (int m = 0; m < 2; ++m) _Pragma("unroll") for (int n = 0; n < 4; ++n) acc[m][n] = (f32x4){0.f, 0.f, 0.f, 0.f}; \
            for (int kk = 0; kk <= wr; ++kk) { \
                bf16x8 a[2], bq[4]; \
                _Pragma("unroll") for (int m = 0; m < 2; ++m) { const int row = 32 * wr + 16 * m + fr; a[m] = *(const LAS bf16x8*)(Aimg + row * 256 + (((4 * kk + fq) ^ (row & 15)) << 4)); } \
                _Pragma("unroll") for (int n = 0; n < 4; ++n) { const int row = 64 * wc + 16 * n + fr; bq[n] = *(const LAS bf16x8*)(Bimg + row * 256 + (((4 * kk + fq) ^ (row & 15)) << 4)); } \
                _Pragma("unroll") for (int m = 0; m < 2; ++m) _Pragma("unroll") for (int n = 0; n < 4; ++n) acc[m][n] = __builtin_amdgcn_mfma_f32_16x16x32_bf16(bq[n], a[m], acc[m][n], 0, 0, 0); \
            } \
            _Pragma("unroll") for (int m = 0; m < 2; ++m) { const int t = 32 * wr + 16 * m + fr; \
                _Pragma("unroll") for (int n = 0; n < 4; ++n) { \
                    const f32x4 uu = unpack_lo4(UW[m][n]); const f32x4 o = uu * (acc[m][n] * GG[n] + BT[m]); \
                    u32x2 w; w.x = cvt_pk_bf16(o.x, o.y); w.y = cvt_pk_bf16(o.z, o.w); stg<u32x2>(AIN + (size_t)tok0 * D, ((unsigned)t * D + coff + 16 * n) * 2u, w); } } \
            __syncthreads(); } while (0)
        GM_PREFETCH(0); GM_EPI_LOAD(0, uwA, ggA, btA);
        __syncthreads();
#pragma unroll 1
        for (int h = 0; h < 8; h += 2) {
            GM_HEAD(h, uwA, ggA, btA, uwB, ggB, btB);
            GM_HEAD(h + 1, uwB, ggB, btB, uwA, ggA, btA);
        }
#undef GM_HEAD
#undef GM_EPI_LOAD
#undef GM_PREFETCH
    }
}

__device__ __forceinline__ void router_phase(Frame& F, int l) {
    FRESH_IDS(F);
    const bf16* X = WSP(bf16, WS_XRES); const float* mods = WSP(float, WS_MODS) + (size_t)l * NB * 6 * D; const float* g2n = FIN(15) + (size_t)l * D;
    const bf16* rwh = WSP(bf16, WS_RWT) + (size_t)l * NB * NE * D; const float* rbias = WSP(float, WS_RBIAS) + (size_t)l * NB * NE;
    bf16* H = WSP(bf16, WS_H); int* LIST = WSP(int, WS_LIST); float* WL = WSP(float, WS_WLIST); unsigned* cnt = F.ctl + CW_CNT + l * NE;
    LAS float* lg = (LAS float*)(F.lds) + F.wave * (16 * 33);
    LAS float* rsd = (LAS float*)(F.lds + 17408) + F.wave * 16;
    LAS int* te = (LAS int*)(F.lds + 18432);
    LAS float* tw = (LAS float*)(F.lds + 20480);
    LAS unsigned* hist = (LAS unsigned*)(F.lds + 22528);
    LAS unsigned* base = (LAS unsigned*)(F.lds + 22656);
    const int lane = F.lane, tid = F.tid, q = lane >> 4, r = lane & 15;
    if (tid < 32) hist[tid] = 0u;
    __syncthreads();
    for (int tile = F.bid; tile < NTOK / 128; tile += F.G) {
        const int tok0 = tile * 128 + F.wave * 16, b = tok0 / SEQ;
        u32x4 xr[32];
#pragma unroll
        for (int J = 0; J < 32; ++J) xr[J] = ldg<u32x4>(X + (size_t)tok0 * D, ((unsigned)r * D + 8u * q + 32u * J) * 2u);
        {
            const char* wsrc = (const char*)(rwh + (size_t)b * NE * D);
#pragma unroll
            for (int i = 0; i < 16; ++i) { const int idx = F.wave * 16 + i, hl = idx >> 6, row = (idx >> 1) & 31, hf = idx & 1;
                __builtin_amdgcn_global_load_lds((const unsigned*)(wsrc + (size_t)hl * MiB + row * 2048 + hf * 1024 + lane * 16), (LAS unsigned*)(F.lds + hl * 66048 + row * 2064 + hf * 1024), 16, 0, 0); }
            asm volatile("s_waitcnt vmcnt(0)" ::: "memory");
            __syncthreads();
        }
        const LAS unsigned char* wl = F.lds + r * 2064 + 16 * q;
        f32x4 acc0 = {0.f, 0.f, 0.f, 0.f}, acc1 = {0.f, 0.f, 0.f, 0.f}; float ss = 0.f;
#pragma unroll
        for (int J = 0; J < 32; ++J) {
            const bf16x8 h0 = *(const LAS bf16x8*)(wl + 64 * J), h1 = *(const LAS bf16x8*)(wl + 16 * 2064 + 64 * J), l0 = *(const LAS bf16x8*)(wl + 66048 + 64 * J), l1 = *(const LAS bf16x8*)(wl + 66048 + 16 * 2064 + 64 * J);
            const u32x4 xw = xr[J]; const bf16x8 xf = __builtin_bit_cast(bf16x8, xw);
            const f32x4 x0 = {bflo(xw.x), bfhi(xw.x), bflo(xw.y), bfhi(xw.y)}, x1 = {bflo(xw.z), bfhi(xw.z), bflo(xw.w), bfhi(xw.w)};
            ss += ((x0.x * x0.x + x0.y * x0.y) + (x0.z * x0.z + x0.w * x0.w)) + ((x1.x * x1.x + x1.y * x1.y) + (x1.z * x1.z + x1.w * x1.w));
            acc0 = __builtin_amdgcn_mfma_f32_16x16x32_bf16(xf, h0, acc0, 0, 0, 0); acc1 = __builtin_amdgcn_mfma_f32_16x16x32_bf16(xf, h1, acc1, 0, 0, 0);
            acc0 = __builtin_amdgcn_mfma_f32_16x16x32_bf16(xf, l0, acc0, 0, 0, 0); acc1 = __builtin_amdgcn_mfma_f32_16x16x32_bf16(xf, l1, acc1, 0, 0, 0);
            if ((J & 3) == 3) __builtin_amdgcn_sched_barrier(0); }
        ss += __shfl_xor(ss, 16); ss += __shfl_xor(ss, 32);
        __syncthreads();
        if (tid < 32) hist[tid] = 0u;
        const float rstd = 1.0f / sqrtf(ss * (1.0f / D) + RMS_EPS);
#pragma unroll
        for (int g = 0; g < 4; ++g) { lg[(4 * q + g) * 33 + r] = acc0[g]; lg[(4 * q + g) * 33 + 16 + r] = acc1[g]; }
        if (lane < 16) rsd[lane] = rstd;
        __syncthreads();
        if (lane < 16) {
            float v[NE]; const float rsv = rsd[lane];
#pragma unroll
            for (int e = 0; e < NE; ++e) v[e] = lg[lane * 33 + e] * rsv + rbias[b * NE + e];
            float tv[TOPK]; int ti[TOPK];
#pragma unroll
            for (int k = 0; k < TOPK; ++k) { float best = v[0]; int bi = 0;
#pragma unroll
                for (int e = 1; e < NE; ++e) { if (v[e] > best) { best = v[e]; bi = e; } }
                tv[k] = best; ti[k] = bi;
#pragma unroll
                for (int e = 0; e < NE; ++e) v[e] = (e == bi) ? -3.0e38f : v[e]; }
            float p[TOPK], ps = 0.f;
#pragma unroll
            for (int k = 0; k < TOPK; ++k) { p[k] = __expf(tv[k] - tv[0]); ps += p[k]; }
            const float inv = 1.0f / ps;
#pragma unroll
            for (int k = 0; k < TOPK; ++k) { te[(F.wave * 16 + lane) * 4 + k] = ti[k]; tw[(F.wave * 16 + lane) * 4 + k] = p[k] * inv; }
        }
        {
            f32x4 gmul[4], gadd[4];
#pragma unroll
            for (int j = 0; j < 4; ++j) { const int col = 256 * j + 4 * lane; const f32x4 g = *(const f32x4*)(g2n + col), scv = *(const f32x4*)(mods + (size_t)b * 6 * D + 4 * D + col);
                gmul[j] = g * (scv + 1.0f); gadd[j] = *(const f32x4*)(mods + (size_t)b * 6 * D + 3 * D + col); }
            u32x2 xa0[4], xa1[4];
#pragma unroll
            for (int j = 0; j < 4; ++j) xa0[j] = *(const u32x2*)(X + (size_t)tok0 * D + 256 * j + 4 * lane);
#pragma unroll
            for (int i = 0; i < 16; i += 2) {
#pragma unroll
                for (int j = 0; j < 4; ++j) xa1[j] = *(const u32x2*)(X + (size_t)(tok0 + i + 1) * D + 256 * j + 4 * lane);
                { const float rsv = rsd[i];
#pragma unroll
                  for (int j = 0; j < 4; ++j) { const f32x4 o = unpack_lo4(xa0[j]) * rsv * gmul[j] + gadd[j]; u32x2 w; w.x = cvt_pk_bf16(o.x, o.y); w.y = cvt_pk_bf16(o.z, o.w); *(u32x2*)(H + (size_t)(tok0 + i) * D + 256 * j + 4 * lane) = w; } }
                if (i + 2 < 16) {
#pragma unroll
                    for (int j = 0; j < 4; ++j) xa0[j] = *(const u32x2*)(X + (size_t)(tok0 + i + 2) * D + 256 * j + 4 * lane); }
                { const float rsv = rsd[i + 1];
#pragma unroll
                  for (int j = 0; j < 4; ++j) { const f32x4 o = unpack_lo4(xa1[j]) * rsv * gmul[j] + gadd[j]; u32x2 w; w.x = cvt_pk_bf16(o.x, o.y); w.y = cvt_pk_bf16(o.z, o.w); *(u32x2*)(H + (size_t)(tok0 + i + 1) * D + 256 * j + 4 * lane) = w; } }
            }
        }
        __syncthreads();
        const int t = tid >> 2, k = tid & 3, e = te[t * 4 + k];
        const unsigned rl = __hip_atomic_fetch_add(&hist[e], 1u, __ATOMIC_RELAXED, __HIP_MEMORY_SCOPE_WORKGROUP);
        __syncthreads();
        if (tid < 32) base[tid] = __hip_atomic_fetch_add(cnt + tid, hist[tid], RLX_AGENT);
        __syncthreads();
        const unsigned pos = base[e] + rl;
        LIST[(size_t)e * NTOK + pos] = (tile * 128 + t) * 4 + k; WL[(size_t)e * NTOK + pos] = tw[t * 4 + k];
        __syncthreads();
        if (tid < 32) hist[tid] = 0u;
        __syncthreads();
    }
}

__device__ __forceinline__ void moe_tables(Frame& F, int l) {
    FRESH_IDS(F);
    LAS int* tb = (LAS int*)(F.lds + LDSCTL_OFF + 256);
    __syncthreads();
    if (F.tid == 0) { int ps = 0; for (int e = 0; e < NE; ++e) { const int c = (int)__hip_atomic_load(F.ctl + CW_CNT + l * NE + e, RLX_AGENT); const int T = (c + 255) >> 8; tb[e] = T; tb[32 + e] = ps; tb[64 + e] = c; ps += T * 256; } }
    __syncthreads();
}

__global__ void __launch_bounds__(NTHREADS, 2) fwd_kernel(Args args) {
    extern __shared__ __attribute__((aligned(16))) unsigned char lds_raw[];
    Frame F;
    F.lds = (LAS unsigned char*)lds_raw; F.ws = args.ws; F.ctl = (unsigned*)(args.ws + WS_CTL);
    F.tid = threadIdx.x; F.lane = F.tid & 63; F.wave = __builtin_amdgcn_readfirstlane(F.tid >> 6); F.wave0 = F.wave; F.G = gridDim.x; F.bid = blockIdx.x;
    F.a = &args;
    for (int u = F.tid; u < 256; u += NTHREADS) ((LAS unsigned*)(F.lds + LDSCTL_OFF))[u] = 0u;
    __syncthreads();
    XcdBarrier bar; bar.bar = F.ctl + CW_BAR; bar.x = 0; bar.st = nullptr; bar.wave0 = F.wave0;
    if (N_LAUNCHES == 1) bar = xcd_barrier_post(F.ctl + CW_BAR, (volatile LAS unsigned*)(F.lds + LDSCTL_OFF + 16), F.wave0);
    const int lo = args.ph_lo, hi = args.ph_hi;
#ifdef ONLY_PH
#define IN(k) ((((k) < 2 ? (k) : 2 + ((k) - 2) % 8) == ONLY_PH) && lo <= (k) && (k) < hi)
#else
#define IN(k) (lo <= (k) && (k) < hi)
#endif
#ifdef DIAG_A
#define STAMP(k) do { if (blockIdx.x == 0 && threadIdx.x == 0) ((LAS unsigned long long*)(F.lds + LDSCTL_OFF + 704))[k] = __builtin_amdgcn_s_memrealtime(); } while (0)
#else
#define STAMP(k) do { } while (0)
#endif
#define SEAM(k) do { if (IN(k) && IN((k) + 1)) xcd_barrier(bar); } while (0)

    if (IN(0)) { STAMP(0); p0_prologue(F); } SEAM(0);
    if (IN(1)) {
        STAMP(1);
        const float* mods = WSP(float, WS_MODS);
        norm_rows<0, false>(F, FIN(0), nullptr, nullptr, nullptr, FIN(2), mods + D, mods, WSP(bf16, WS_H), nullptr);
        router_prep(F);
    } SEAM(1);

    for (int l = 0; l < DEPTH; ++l) {
        const int pb = 2 + 8 * l;
        const float* mods = WSP(float, WS_MODS) + (size_t)l * NB * 6 * D;
        if (IN(pb + 0)) { STAMP(pb + 0);
            SchedZ S{F.G, F.bid, (const char*)WSP(bf16, WS_H), (const char*)(WSP(bf16, WS_WTIN) + (size_t)l * INC * D), F.ctl + CW_QZ + l * 128};
            EpiZ E{WSP(bf16, WS_Z), WSP(bf16, WS_VT), WSP(float, WS_VSS) + (size_t)l * NTOK};
            if (((F.bid >> 3) & 3) == 3) convert_items<1>(F, F.ctl + CW_CVCTR + 32 * l, l);
            gm::gemm_phase<EpiZ, SchedZ, false, true>(F.lds, S, E, F.wave0);
        } SEAM(pb + 0);
        if (IN(pb + 1)) { STAMP(pb + 1); mixer_prep(F, l); } SEAM(pb + 1);
        if (IN(pb + 2)) { STAMP(pb + 2);
            SchedMix S{F.G, F.bid, (const char*)WSP(bf16, WS_AIN), (const char*)WSP(bf16, WS_CIN), (const char*)WSP(bf16, WS_PIN),
                       (const char*)(WSP(bf16, WS_WTA) + (size_t)l * D * D), (const char*)(WSP(bf16, WS_WTC) + (size_t)l * D * D), (const char*)(WSP(bf16, WS_WTPOOL) + (size_t)l * D * D)};
            EpiMix E{WSP(bf16, WS_Z), WSP(bf16, WS_MIX), FIN(11) + (size_t)l * D};
            gm::gemm_phase<EpiMix, SchedMix, false>(F.lds, S, E, F.wave0);
        } SEAM(pb + 2);
        if (IN(pb + 3)) { STAMP(pb + 3);
            SchedOut S{F.G, F.bid, (const char*)WSP(bf16, WS_MIX), (const char*)(WSP(bf16, WS_WTO) + (size_t)l * D * D)};
            if (l == 0) { EpiOut<true> E{FIN(0), WSP(bf16, WS_XRES), mods + 2 * D}; gm::gemm_phase<EpiOut<true>, SchedOut, false>(F.lds, S, E, F.wave0); }
            else { EpiOut<false> E{WSP(bf16, WS_XRES), WSP(bf16, WS_XRES), mods + 2 * D}; gm::gemm_phase<EpiOut<false>, SchedOut, false>(F.lds, S, E, F.wave0); }
        } SEAM(pb + 3);
        if (IN(pb + 4)) { STAMP(pb + 4); router_phase(F, l); } SEAM(pb + 4);
        if (IN(pb + 5)) { STAMP(pb + 5);
            moe_tables(F, l);
            SchedMoe S{F.G / 8, F.bid / 8, F.bid % 8, 8, (const LAS int*)(F.lds + LDSCTL_OFF + 256), (const char*)WSP(bf16, WS_H), (const char*)(WSP(bf16, WS_WTGU) + (size_t)l * NE * 2 * FF * D), (unsigned)(2 * FF * D * 2), WSP(int, WS_LIST), true};
            EpiGU E{WSP(bf16, WS_ACT), FIN(19) + (size_t)l * NE * 2 * FF};
            gm::gemm_phase<EpiGU, SchedMoe, true>(F.lds, S, E, F.wave0);
        } SEAM(pb + 5);
        if (IN(pb + 6)) { STAMP(pb + 6);
            moe_tables(F, l);
            SchedMoe S{F.G / 8, F.bid / 8, F.bid % 8, 4, (const LAS int*)(F.lds + LDSCTL_OFF + 256), (const char*)WSP(bf16, WS_ACT), (const char*)(WSP(bf16, WS_WTDN) + (size_t)l * NE * D * FF), (unsigned)(D * FF * 2), WSP(int, WS_LIST), false};
            EpiDown E{WSP(bf16, WS_YB), FIN(21) + (size_t)l * NE * D, WSP(int, WS_LIST), WSP(float, WS_WLIST)};
            gm::gemm_phase<EpiDown, SchedMoe, false>(F.lds, S, E, F.wave0);
        } SEAM(pb + 6);
        if (IN(pb + 7)) { STAMP(pb + 7);
            if (l + 1 < DEPTH) { const float* m2 = WSP(float, WS_MODS) + (size_t)(l + 1) * NB * 6 * D;
                norm_rows<0, true>(F, WSP(bf16, WS_XRES), WSP(bf16, WS_YB), mods + 5 * D, WSP(bf16, WS_XRES), FIN(2) + (size_t)(l + 1) * D, m2 + D, m2, WSP(bf16, WS_H), nullptr); }
            else norm_rows<1, true>(F, WSP(bf16, WS_XRES), WSP(bf16, WS_YB), mods + 5 * D, nullptr, FIN(22), nullptr, nullptr, nullptr, F.a->out);
        } SEAM(pb + 7);
    }
#undef IN
#undef SEAM
}

extern "C" void kernel_launch(void* const* d_in, const int* in_sizes, int n_in, void* d_out, int out_size, void* d_ws, size_t ws_size, hipStream_t stream) {
    static int grid = 0;
    if (grid == 0) {
        if (n_in != 23 || out_size != NTOK * D || ws_size < WS_END) { fprintf(stderr, "kernel_launch: unexpected shapes (n_in %d out %d ws %zu)\n", n_in, out_size, ws_size); grid = -1; return; }
        int dev = 0, cus = 0, per_cu = 0;
        if (hipGetDevice(&dev) != hipSuccess || hipDeviceGetAttribute(&cus, hipDeviceAttributeMultiprocessorCount, dev) != hipSuccess) { grid = -1; return; }
        if (hipFuncSetAttribute((const void*)fwd_kernel, hipFuncAttributeMaxDynamicSharedMemorySize, LDS_BYTES) != hipSuccess) { fprintf(stderr, "kernel_launch: hipFuncSetAttribute failed\n"); grid = -1; return; }
        if (hipOccupancyMaxActiveBlocksPerMultiprocessor(&per_cu, (const void*)fwd_kernel, NTHREADS, LDS_BYTES) != hipSuccess || per_cu < 1) fprintf(stderr, "kernel_launch: occupancy query reports %d\n", per_cu);
        (void)hipGetLastError();
        grid = (cus / 8) * 8;
        if (grid > 256) grid = 256;
        if (grid < 8) { grid = -1; return; }
    }
    if (grid < 0) return;
    if (hipMemsetAsync((char*)d_ws + WS_CTL, 0, CTL_ZERO_BYTES, stream) != hipSuccess) return;
    Args a{};
    for (int i = 0; i < 23; ++i) a.in[i] = (const float*)d_in[i];
    a.out = (float*)d_out; a.ws = (unsigned char*)d_ws;
    for (int li = 0; li < N_LAUNCHES; ++li) {
        a.ph_lo = (N_LAUNCHES == 1) ? 0 : li; a.ph_hi = (N_LAUNCHES == 1) ? NPHASES : li + 1;
        hipLaunchKernelGGL(fwd_kernel, dim3(grid), dim3(NTHREADS), LDS_BYTES, stream, a);
        if (hipPeekAtLastError() != hipSuccess) { fprintf(stderr, "kernel_launch: launch %d failed\n", li); break; }
    }
}
```

```cpp
#include <hip/hip_runtime.h>
#include <cstdio>
#include <cstdint>

#ifndef MK_N_LAUNCHES
#define MK_N_LAUNCHES 1
#endif

#define GAS __attribute__((address_space(1)))
#define LAS __attribute__((address_space(3)))
typedef unsigned short bf16;
typedef short bf16x8 __attribute__((ext_vector_type(8)));
typedef float f32x4 __attribute__((ext_vector_type(4)));
typedef float f32x2 __attribute__((ext_vector_type(2)));
typedef unsigned u32x4 __attribute__((ext_vector_type(4)));
typedef unsigned u32x2 __attribute__((ext_vector_type(2)));

constexpr int D = 1024, NB = 8, SEQ = 4096, NTOK = NB * SEQ, DEPTH = 2, INC = 9216, NE = 32, TOPK = 4, FF = 1024, CHUNK = 128;
constexpr int Z_U = 0, Z_V = 1024, Z_P = 2048, Z_X = 3072, Z_B = 4096, Z_C = 5120, Z_GA = 6144, Z_GB = 7168, Z_GC = 8192;
constexpr float RMS_EPS = 1e-5f;
constexpr int NWAVES = 8, NTHREADS = NWAVES * 64;
constexpr int NPHASES = 2 + 8 * DEPTH;
constexpr int N_LAUNCHES = MK_N_LAUNCHES;
static_assert(N_LAUNCHES == 1 || N_LAUNCHES == NPHASES, "MK_N_LAUNCHES must be 1 or NPHASES");

constexpr size_t MiB = 1u << 20;
constexpr size_t WS_CTL = 0, CTL_ZERO_BYTES = 1 * MiB;
constexpr int CW_BAR = 4096;
constexpr int CW_CNT = 8192;
constexpr int CW_QZ = 8192 + 512;
constexpr int CW_CVCTR = 8192 + 320;
constexpr int CW_P0CTR = 8192 + 256;
constexpr size_t WS_VSS = 256 * 1024;
constexpr size_t WS_MODS = 512 * 1024;
constexpr size_t WS_RWT = 1 * MiB;
constexpr size_t WS_RBIAS = 3 * MiB;
constexpr size_t WS_LIST = 4 * MiB;
constexpr size_t WS_WLIST = 8 * MiB;
constexpr size_t WS_WTPOOL = 12 * MiB;
constexpr size_t WS_WTA = 16 * MiB, WS_WTC = 20 * MiB, WS_WTO = 24 * MiB;
constexpr size_t WS_WTIN = 28 * MiB;
constexpr size_t WS_WTGU = 64 * MiB;
constexpr size_t WS_WTDN = 320 * MiB;
constexpr size_t WS_H = 448 * MiB;
constexpr size_t WS_VT = 512 * MiB;
constexpr size_t WS_AIN = 576 * MiB, WS_CIN = 640 * MiB, WS_PIN = 704 * MiB;
constexpr size_t WS_MIX = 768 * MiB;
constexpr size_t WS_XRES = 832 * MiB;
constexpr size_t WS_WIMG = 960 * MiB;
constexpr size_t WS_Z = 1088 * MiB;
constexpr size_t WS_ACT = WS_Z;
constexpr size_t WS_YB = WS_Z + 288 * MiB;
constexpr size_t WS_END = 1664 * MiB;

constexpr int RING_BYTES = 131072;
constexpr int LDS_BYTES = 147456;
constexpr int LDSCTL_OFF = LDS_BYTES - 1024;

#define RLX_AGENT __ATOMIC_RELAXED, __HIP_MEMORY_SCOPE_AGENT
typedef __bf16 bf16x2_t __attribute__((ext_vector_type(2)));
__device__ __forceinline__ unsigned cvt_pk_bf16(float lo, float hi) { const f32x2 v = {lo, hi}; const bf16x2_t r = __builtin_convertvector(v, bf16x2_t); return __builtin_bit_cast(unsigned, r); }
__device__ __forceinline__ float bflo(unsigned u) { return __uint_as_float(u << 16); }
__device__ __forceinline__ float bfhi(unsigned u) { return __uint_as_float(u & 0xffff0000u); }
__device__ __forceinline__ float wave_sum(float v) {
#pragma unroll
    for (int o = 1; o < 64; o <<= 1) v += __shfl_xor(v, o);
    return v;
}
__device__ __forceinline__ float sigmoidf_fast(float x) { return __builtin_amdgcn_rcpf(1.0f + __builtin_amdgcn_exp2f(-1.44269504089f * x)); }
__device__ __forceinline__ float gelu_tanh(float x) {
    const float t = x * (1.0f + 0.044715f * x * x);
    return x * __builtin_amdgcn_rcpf(1.0f + __builtin_amdgcn_exp2f(-2.30220818f * t));
}
__device__ __forceinline__ f32x4 unpack_lo4(u32x2 w) { return (f32x4){bflo(w.x), bfhi(w.x), bflo(w.y), bfhi(w.y)}; }

__device__ __forceinline__ int tid_of(int wave0) { int l; asm volatile("v_mbcnt_lo_u32_b32 %0, -1, 0\n\tv_mbcnt_hi_u32_b32 %0, -1, %0" : "=v"(l)); return wave0 * 64 + l; }
#define XB_TMO      128
#define XB_XCNT(j)  (256  + 64 * (j))
#define XB_XSUB(j)  (1280 + 64 * (j))
#define XB_XGEN(j)  (2304 + 64 * (j))
#define XB_TOP      3328
#define XB_TOPGEN   3392
#define XCD_BAR_WORDS 3456
#define XB_SPIN_CAP (1u << 18)
__device__ __forceinline__ unsigned xb_ld(unsigned* p)              { return __hip_atomic_load(p, __ATOMIC_RELAXED, __HIP_MEMORY_SCOPE_AGENT); }
__device__ __forceinline__ unsigned xb_add(unsigned* p, unsigned v) { return __hip_atomic_fetch_add(p, v, __ATOMIC_RELAXED, __HIP_MEMORY_SCOPE_AGENT); }
__device__ __forceinline__ unsigned xb_xcc_id() { return (unsigned)__builtin_amdgcn_s_getreg((3 << 11) | 20) & 0xFu; }
#define XB_SPIN(cond, bar) do { unsigned _sp = 0; while (cond) { __builtin_amdgcn_s_sleep(1); \
    if ((++_sp & 255u) == 0u) { if (xb_ld(&(bar)[XB_TMO])) break; if (_sp > XB_SPIN_CAP) { atomicAdd(&(bar)[XB_TMO], 1u); break; } } } } while (0)
struct XcdBarrier { unsigned* bar; unsigned x; volatile LAS unsigned* st; int wave0; };
__device__ __forceinline__ XcdBarrier xcd_barrier_post(unsigned* bar, volatile LAS unsigned* st, int wave0) {
    XcdBarrier b; b.bar = bar; b.x = xb_xcc_id(); b.st = st; b.wave0 = wave0;
    if (tid_of(wave0) == 0) (void)xb_add(&bar[XB_XCNT(b.x)], 1u);
    return b;
}
__device__ __forceinline__ void xcd_barrier_complete(unsigned* bar, unsigned x, unsigned& nloc, unsigned& nx) {
    const unsigned G = gridDim.x * gridDim.y * gridDim.z;
    unsigned sum, cnt, mine, sp = 0u;
    for (;;) {
        sum = 0u; cnt = 0u; mine = 0u;
#pragma unroll
        for (unsigned j = 0; j < 16; ++j) { const unsigned c = xb_ld(&bar[XB_XCNT(j)]); sum += c; cnt += (c > 0u) ? 1u : 0u; mine = (j == x) ? c : mine; }
        if (sum == G) break;
        __builtin_amdgcn_s_sleep(1);
        if ((++sp & 255u) == 0u) { if (xb_ld(&bar[XB_TMO])) break; if (sp > XB_SPIN_CAP) { atomicAdd(&bar[XB_TMO], 1u); break; } }
    }
    nloc = mine > 0u ? mine : 1u; nx = cnt > 0u ? cnt : 1u;
}
__device__ __forceinline__ void xcd_barrier(const XcdBarrier& b) {
    asm volatile("s_waitcnt vmcnt(0)" ::: "memory");
    __syncthreads();
    if (tid_of(b.wave0) == 0) {
        unsigned* bar = b.bar;
        __builtin_amdgcn_s_waitcnt(0);
        unsigned nloc = b.st[0], nx = b.st[1];
        if (nloc == 0u) { xcd_barrier_complete(bar, b.x, nloc, nx); b.st[0] = nloc; b.st[1] = nx; }
        const unsigned old = xb_add(&bar[XB_XSUB(b.x)], 1u);
        const unsigned gen = old / nloc;
        if (old + 1u == (gen + 1u) * nloc) {
            __builtin_amdgcn_fence(__ATOMIC_RELEASE, "agent");
            asm volatile("s_waitcnt vmcnt(0)" ::: "memory");
            const unsigned og = xb_add(&bar[XB_TOP], 1u);
            const unsigned tg = og / nx;
            if (og + 1u == (tg + 1u) * nx) xb_add(&bar[XB_TOPGEN], 1u);
            else XB_SPIN(xb_ld(&bar[XB_TOPGEN]) == tg, bar);
            __builtin_amdgcn_fence(__ATOMIC_ACQUIRE, "agent");
            xb_add(&bar[XB_XGEN(b.x)], 1u);
            asm volatile("s_waitcnt vmcnt(0)" ::: "memory");
        } else {
            XB_SPIN(xb_ld(&bar[XB_XGEN(b.x)]) == gen, bar);
            __builtin_amdgcn_fence(__ATOMIC_ACQUIRE, "agent");
            asm volatile("s_waitcnt vmcnt(0)" ::: "memory");
        }
    }
    __syncthreads();
}

namespace gm {
constexpr int BM = 256, BK = 64, HALF = 128, HTB = HALF * BK * 2;
constexpr unsigned PITCH = 2048u, HSTEP = 128u * PITCH, TSTEP = 256u * PITCH, KSTEP = 128u;
__device__ __forceinline__ int lds_byte(int r, int c) { const int st = (r >> 4) * 2 + (c >> 5), rr = r & 15, cc = c & 31, ob = rr * 64 + cc * 2; return st * 1024 + (ob ^ (((ob >> 9) & 1) << 5)); }
__device__ __forceinline__ void stage_rc(int b, int& R, int& C) { const int st = b / 1024, sb = b % 1024, swz = sb ^ (((sb >> 9) & 1) << 5); R = (st >> 1) * 16 + swz / 64; C = (st & 1) * 32 + (swz % 64) / 2; }
__device__ __forceinline__ int perm32(int rho) { const int n = rho >> 4, i = rho & 15; return 8 * (i >> 2) + 4 * n + (i & 3); }

struct Unit { const char* A; const char* B; int nt, kind, pm, pn, aux; };

__device__ __forceinline__ void tile_map(int L, int nM, int nN, int& pm, int& pn) {
    const int nwg = nM * nN; int wgid = L;
    { const int q = nwg / 8, r = nwg % 8, xcd = wgid % 8, off = wgid / 8; wgid = (xcd < r ? xcd * (q + 1) : r * (q + 1) + (xcd - r) * q) + off; }
    constexpr int WGM = 2; const int nig = WGM * nN, gid = wgid / nig, fm = gid * WGM, gsz = (nM - fm) < WGM ? (nM - fm) : WGM;
    pm = fm + ((wgid % nig) % gsz); pn = (wgid % nig) / gsz;
}

template <class Epi, class Sched, bool GATHER, bool DYN = false>
__device__ __forceinline__ void gemm_phase(LAS unsigned char* lds, const Sched& S, const Epi& E, int wave0) {
    int tid_ = tid_of(wave0); asm volatile("" : "+v"(tid_));
    const int tid = tid_, wid = __builtin_amdgcn_readfirstlane(tid >> 6), lane = tid & 63, wr = wid >> 2, wc = wid & 3, fr = lane & 15, fq = lane >> 4;
    unsigned voffB[2], cvA[2][2], nvA[2][2]; int rA[2]; unsigned cC[2];
#pragma unroll
    for (int i = 0; i < 2; ++i) { int R, C; stage_rc(tid * 16 + i * 8192, R, C); const int Rb = (R & ~31) + perm32(R & 31);
        voffB[i] = (unsigned)Rb * PITCH + (unsigned)C * 2u; rA[i] = R; cC[i] = (unsigned)C * 2u;
        cvA[0][i] = (unsigned)R * PITCH + cC[i]; cvA[1][i] = cvA[0][i] + HSTEP; nvA[0][i] = cvA[0][i]; nvA[1][i] = cvA[1][i]; }
    const unsigned ldsw = (unsigned)wid * 1024u;
    const int aoff = lds_byte(wr * 64 + fr, fq * 8), boff = lds_byte(wc * 32 + fr, fq * 8);
#define GM_SA(b, h) (((b) * 2 + (h)) * HTB)
#define GM_SB(b, h) ((4 + (b) * 2 + (h)) * HTB)
#define GM_STAGE(bufoff, gbase, voff) do { _Pragma("unroll") for (int _i = 0; _i < 2; ++_i) \
        __builtin_amdgcn_global_load_lds((const unsigned*)((const char*)(gbase) + (voff)[_i]), (LAS unsigned*)(lds + (bufoff) + ldsw + _i * 8192), 16, 0, 0); } while (0)
#define GM_LDA(dst, b, h) do { _Pragma("unroll") for (int m = 0; m < 4; ++m) _Pragma("unroll") for (int k = 0; k < 2; ++k) dst[m][k] = *(const LAS bf16x8*)(lds + GM_SA(b, h) + aoff + m * 2048 + k * 1024); } while (0)
#define GM_LDB(dst, b, h) do { _Pragma("unroll") for (int n = 0; n < 2; ++n) _Pragma("unroll") for (int k = 0; k < 2; ++k) dst[n][k] = *(const LAS bf16x8*)(lds + GM_SB(b, h) + boff + n * 2048 + k * 1024); } while (0)
#define GM_MMA(ai, bj, At, Bt) do { __builtin_amdgcn_s_setprio(1); _Pragma("unroll") for (int m = 0; m < 4; ++m) _Pragma("unroll") for (int n = 0; n < 2; ++n) _Pragma("unroll") for (int k = 0; k < 2; ++k) \
        acc[ai][bj][m][n] = __builtin_amdgcn_mfma_f32_16x16x32_bf16(Bt[n][k], At[m][k], acc[ai][bj][m][n], 0, 0, 0); __builtin_amdgcn_s_setprio(0); } while (0)
#define GM_WAIT_V(n) asm volatile("s_waitcnt vmcnt(" #n ")" ::: "memory")
#define GM_WAIT_VE() asm volatile("s_waitcnt vmcnt(%0)" :: "n"(8 + Epi::MIN_VMEM) : "memory")
#define GM_WAIT_L(n) asm volatile("s_waitcnt lgkmcnt(" #n ")" ::: "memory")
#define GM_BAR __builtin_amdgcn_s_barrier()
#define GM_SCHED __builtin_amdgcn_sched_barrier(0)
    Unit cur, nxt; int ui = 0;
    volatile LAS int* dq = (volatile LAS int*)(lds + LDSCTL_OFF + 128);
    unsigned dtok = 0u;
    if constexpr (DYN) {
        __syncthreads();
        if (tid == 0) { unsigned* q = S.draw_ptr(); dq[0] = (int)__hip_atomic_fetch_add(q, 1u, RLX_AGENT); dq[1] = (int)__hip_atomic_fetch_add(q, 1u, RLX_AGENT); }
        __syncthreads();
        if (!S.next(__builtin_amdgcn_readfirstlane(dq[0]), cur)) return;
    } else {
        if (!S.next(0, cur)) return;
    }
    f32x4 acc[2][2][4][2];
#pragma unroll
    for (int a = 0; a < 2; ++a)
#pragma unroll
        for (int b = 0; b < 2; ++b)
#pragma unroll
            for (int m = 0; m < 4; ++m)
#pragma unroll
                for (int n = 0; n < 2; ++n) acc[a][b][m][n] = (f32x4){0.f, 0.f, 0.f, 0.f};
    bf16x8 At[4][2], B0[2][2], B1[2][2];
    const char* cA = cur.A; const char* cB = cur.B;
    if constexpr (GATHER) {
#pragma unroll
        for (int h = 0; h < 2; ++h)
#pragma unroll
            for (int i = 0; i < 2; ++i) cvA[h][i] = S.row_off(cur, h * HALF + rA[i]) + cC[i];
    }
    GM_STAGE(GM_SB(0, 0), cB, voffB); GM_STAGE(GM_SB(0, 1), cB + HSTEP, voffB); GM_STAGE(GM_SA(0, 0), cA, cvA[0]); GM_STAGE(GM_SA(0, 1), cA, cvA[1]);
    if (wr == 1) GM_BAR;
    GM_WAIT_V(2); GM_BAR;
    GM_STAGE(GM_SB(1, 0), cB + KSTEP, voffB); GM_STAGE(GM_SA(1, 0), cA + KSTEP, cvA[0]); GM_STAGE(GM_SB(1, 1), cB + HSTEP + KSTEP, voffB);
    GM_WAIT_V(6); GM_BAR;
    for (;;) {
        bool has_next;
        if constexpr (DYN) {
            has_next = S.next(__builtin_amdgcn_readfirstlane(dq[(ui + 1) & 1]), nxt);
            if (tid == 0) { unsigned* q = S.draw_ptr(); const unsigned one = 1u; asm volatile("global_atomic_add %0, %1, %2, off sc0" : "=v"(dtok) : "v"(q), "v"(one) : "memory"); }
        } else has_next = S.next(ui + 1, nxt);
        const char* nA = has_next ? nxt.A : cA; const char* nB = has_next ? nxt.B : cB;
        if constexpr (GATHER) {
            if (has_next) {
#pragma unroll
                for (int h = 0; h < 2; ++h)
#pragma unroll
                    for (int i = 0; i < 2; ++i) nvA[h][i] = S.row_off(nxt, h * HALF + rA[i]) + cC[i];
            } else {
#pragma unroll
                for (int h = 0; h < 2; ++h)
#pragma unroll
                    for (int i = 0; i < 2; ++i) nvA[h][i] = cvA[h][i];
            }
        }
        const int nt = cur.nt;
        for (int t = 0; t < nt; t += 2) {
            const bool last = (t == nt - 2);
            if constexpr (DYN) { if (last && tid == 0) dq[ui & 1] = (int)dtok; }
            const char* a1 = cA + (size_t)(t + 1) * KSTEP;
            const char* a2 = last ? nA : cA + (size_t)(t + 2) * KSTEP; const char* b2 = last ? nB : cB + (size_t)(t + 2) * KSTEP;
            const char* a3 = a2 + KSTEP; const char* b3 = b2 + KSTEP;
            unsigned o0[2], o1[2];
            if constexpr (GATHER) { o0[0] = last ? nvA[0][0] : cvA[0][0]; o0[1] = last ? nvA[0][1] : cvA[0][1]; o1[0] = last ? nvA[1][0] : cvA[1][0]; o1[1] = last ? nvA[1][1] : cvA[1][1]; }
            else { o0[0] = cvA[0][0]; o0[1] = cvA[0][1]; o1[0] = cvA[1][0]; o1[1] = cvA[1][1]; }
            GM_LDB(B0, 0, 0); GM_LDB(B1, 0, 1); GM_SCHED; GM_LDA(At, 0, 0); GM_STAGE(GM_SA(1, 1), a1, cvA[1]);
            GM_WAIT_V(8); GM_WAIT_L(0); GM_BAR; GM_MMA(0, 0, At, B0); GM_MMA(0, 1, At, B1); GM_BAR; GM_SCHED;
            GM_LDA(At, 0, 1); GM_STAGE(GM_SB(0, 0), b2, voffB); GM_STAGE(GM_SB(0, 1), b2 + HSTEP, voffB); GM_STAGE(GM_SA(0, 0), a2, o0);
            GM_WAIT_V(8); GM_WAIT_L(0); GM_BAR; GM_MMA(1, 0, At, B0); GM_MMA(1, 1, At, B1); GM_BAR; GM_SCHED;
            GM_LDB(B0, 1, 0); GM_LDB(B1, 1, 1); GM_SCHED; GM_LDA(At, 1, 0); GM_STAGE(GM_SA(0, 1), a2, o1);
            GM_WAIT_V(8); GM_WAIT_L(0); GM_BAR; GM_MMA(0, 0, At, B0); GM_MMA(0, 1, At, B1); GM_BAR; GM_SCHED;
            GM_LDA(At, 1, 1); GM_STAGE(GM_SB(1, 0), b3, voffB); GM_STAGE(GM_SB(1, 1), b3 + HSTEP, voffB); GM_STAGE(GM_SA(1, 0), a3, o0);
            GM_WAIT_V(8); GM_WAIT_L(0); GM_BAR; GM_MMA(1, 0, At, B0); GM_MMA(1, 1, At, B1); GM_BAR; GM_SCHED;
        }
        if (wr == 0) GM_BAR;
        E(acc, cur, wr, wc, fr, fq);
        if (!has_next) break;
#pragma unroll
        for (int a = 0; a < 2; ++a)
#pragma unroll
            for (int b = 0; b < 2; ++b)
#pragma unroll
                for (int m = 0; m < 4; ++m)
#pragma unroll
                    for (int n = 0; n < 2; ++n) acc[a][b][m][n] = (f32x4){0.f, 0.f, 0.f, 0.f};
        cur = nxt; cA = nA; cB = nB; ++ui;
        if constexpr (GATHER) {
#pragma unroll
            for (int h = 0; h < 2; ++h)
#pragma unroll
                for (int i = 0; i < 2; ++i) cvA[h][i] = nvA[h][i];
        }
        if (wr == 1) GM_BAR;
    }
    GM_WAIT_V(0);
    GM_BAR;
#undef GM_SA
#undef GM_SB
#undef GM_STAGE
#undef GM_LDA
#undef GM_LDB
#undef GM_MMA
#undef GM_WAIT_V
#undef GM_WAIT_VE
#undef GM_WAIT_L
#undef GM_BAR
#undef GM_SCHED
}
}

struct Args { const float* in[23]; float* out; unsigned char* ws; int ph_lo, ph_hi; };
struct Frame {
    LAS unsigned char* lds;
    unsigned* ctl;
    unsigned char* ws;
    int tid, lane, wave, G, bid, wave0;
    const Args* a;
};
#define FIN(i) (F.a->in[i])
#define FRESH_IDS(F) do { int t_ = tid_of((F).wave0); asm volatile("" : "+v"(t_)); (F).tid = t_; (F).lane = t_ & 63; (F).wave = __builtin_amdgcn_readfirstlane(t_ >> 6); } while (0)
#define WSP(T, off) ((T*)(F.ws + (off)))

template <class T> __device__ __forceinline__ T ldg(const void* base, unsigned off) { return *(const T*)((const char*)base + off); }
template <class T> __device__ __forceinline__ void stg(void* base, unsigned off, T v) { *(T*)((char*)base + off) = v; }
typedef f32x4 Acc[2][2][4][2];

struct EpiZ {
    static constexpr int MIN_VMEM = 16;
    bf16* Z; bf16* VT; float* vss;
    __device__ __forceinline__ void operator()(const Acc& acc, const gm::Unit& u, int wr, int wc, int fr, int fq) const {
        asm volatile("" : "+v"(fr), "+v"(fq));
        if (u.kind == 1) {
            bf16* base = VT + (size_t)((u.pn - 4) * 256) * NTOK + u.pm * 256; const unsigned lo = ((unsigned)(wr * 64 + fr) * NTOK + wc * 32 + 8 * fq) * 2u;
            float ss[2][8];
#pragma unroll
            for (int bj = 0; bj < 2; ++bj)
#pragma unroll
                for (int j = 0; j < 8; ++j) ss[bj][j] = 0.f;
#pragma unroll
            for (int ai = 0; ai < 2; ++ai)
#pragma unroll
                for (int m = 0; m < 4; ++m) {
#pragma unroll
                    for (int bj = 0; bj < 2; ++bj) { float v[8];
#pragma unroll
                        for (int j = 0; j < 8; ++j) { v[j] = gelu_tanh(acc[ai][bj][m][j >> 2][j & 3]); ss[bj][j] += v[j] * v[j]; }
                        u32x4 w; w.x = cvt_pk_bf16(v[0], v[1]); w.y = cvt_pk_bf16(v[2], v[3]); w.z = cvt_pk_bf16(v[4], v[5]); w.w = cvt_pk_bf16(v[6], v[7]);
                        stg<u32x4>(base, lo + (unsigned)((ai * 128 + m * 16) * NTOK + bj * 128) * 2u, w); }
                    asm volatile("" ::: "memory"); __builtin_amdgcn_sched_barrier(0); }
            float* vb = vss + u.pm * 256; const unsigned vo = (unsigned)(wc * 32 + 8 * fq) * 4u;
#pragma unroll
            for (int bj = 0; bj < 2; ++bj)
#pragma unroll
                for (int j = 0; j < 8; ++j) { float sv = ss[bj][j]; sv += __shfl_xor(sv, 1); sv += __shfl_xor(sv, 2); sv += __shfl_xor(sv, 4); sv += __shfl_xor(sv, 8); ss[bj][j] = sv; }
            if (fr == 0) {
#pragma unroll
                for (int bj = 0; bj < 2; ++bj)
#pragma unroll
                    for (int j = 0; j < 8; ++j) atomicAdd((float*)((char*)vb + vo + (bj * 128 + j) * 4), ss[bj][j]); }
        } else if (u.kind == 4) {
            const int j = u.pn < 16 ? u.pn - 12 : u.pn - 16;
            bf16* base = Z + (size_t)(u.pm * 256) * INC + Z_X + 128 * j; const unsigned lo = ((unsigned)(wr * 64 + fr) * INC + wc * 32 + 8 * fq) * 2u;
#pragma unroll
            for (int ai = 0; ai < 2; ++ai)
#pragma unroll
                for (int m = 0; m < 4; ++m) { const f32x4 o0 = acc[ai][0][m][0] * acc[ai][1][m][0], o1 = acc[ai][0][m][1] * acc[ai][1][m][1];
                    u32x4 w; w.x = cvt_pk_bf16(o0[0], o0[1]); w.y = cvt_pk_bf16(o0[2], o0[3]); w.z = cvt_pk_bf16(o1[0], o1[1]); w.w = cvt_pk_bf16(o1[2], o1[3]);
                    stg<u32x4>(base, lo + (unsigned)((ai * 128 + m * 16) * INC) * 2u, w); }
        } else if (u.kind == 0) rowmajor<0>(acc, u, wr, wc, fr, fq);
        else if (u.kind == 3) rowmajor<3>(acc, u, wr, wc, fr, fq);
        else rowmajor<2>(acc, u, wr, wc, fr, fq);
    }
    template <int KIND> __device__ __forceinline__ void rowmajor(const Acc& acc, const gm::Unit& u, int wr, int wc, int fr, int fq) const {
        bf16* base = Z + (size_t)(u.pm * 256) * INC + u.pn * 256; const unsigned lo = ((unsigned)(wr * 64 + fr) * INC + wc * 32 + 8 * fq) * 2u;
#pragma unroll
        for (int ai = 0; ai < 2; ++ai)
#pragma unroll
            for (int m = 0; m < 4; ++m) {
#pragma unroll
                for (int bj = 0; bj < 2; ++bj) { float v[8];
#pragma unroll
                    for (int j = 0; j < 8; ++j) { const float a = acc[ai][bj][m][j >> 2][j & 3]; v[j] = KIND == 0 ? gelu_tanh(a) : (KIND == 3 ? sigmoidf_fast(a) : a); }
                    u32x4 w; w.x = cvt_pk_bf16(v[0], v[1]); w.y = cvt_pk_bf16(v[2], v[3]); w.z = cvt_pk_bf16(v[4], v[5]); w.w = cvt_pk_bf16(v[6], v[7]);
                    stg<u32x4>(base, lo + (unsigned)((ai * 128 + m * 16) * INC + bj * 128) * 2u, w); }
                asm volatile("" ::: "memory"); __builtin_amdgcn_sched_barrier(0); }
    }
};
struct SchedZ {
    int G, c; const char* H; const char* W; unsigned* q;
    __device__ __forceinline__ unsigned* draw_ptr() const { return q + 16 * (c & 7); }
    __device__ __forceinline__ bool next(int j, gm::Unit& u) const {
        const int L = 8 * j + (c & 7); if (j < 0 || L >= 128 * 36) return false;
        int pm, pn; gm::tile_map(L, 128, 36, pm, pn);
        u.pm = pm; u.pn = pn; u.nt = 16; u.aux = 0;
        if (pn >= 4 && pn < 8) { u.A = W + (size_t)pn * gm::TSTEP; u.B = H + (size_t)pm * gm::TSTEP; u.kind = 1; }
        else { u.A = H + (size_t)pm * gm::TSTEP; u.B = W + (size_t)pn * gm::TSTEP; u.kind = pn < 4 ? 0 : (pn >= 24 ? 3 : (((pn >= 12 && pn < 16) || (pn >= 20 && pn < 24)) ? 4 : 2)); }
        return true;
    }
    __device__ __forceinline__ unsigned row_off(const gm::Unit&, int) const { return 0u; }
};

struct EpiMix {
    static constexpr int MIN_VMEM = 16;
    const bf16* Z; bf16* MIX; const float* pscale;
    __device__ __forceinline__ void operator()(const Acc& acc, const gm::Unit& u, int wr, int wc, int fr, int fq) const {
        asm volatile("" : "+v"(fr), "+v"(fq));
        if (u.kind == 0) body<0>(acc, u, wr, wc, fr, fq); else if (u.kind == 1) body<1>(acc, u, wr, wc, fr, fq); else body<2>(acc, u, wr, wc, fr, fq);
    }
    template <int KIND> __device__ __forceinline__ void body(const Acc& acc, const gm::Unit& u, int wr, int wc, int fr, int fq) const {
        const int lr = wr * 64 + fr, lc = wc * 32 + 8 * fq;
        const bf16* zb = Z + (size_t)(u.pm * 256) * INC + (KIND == 0 ? Z_GA : (KIND == 1 ? Z_GC : Z_GB)) + u.pn * 256; const unsigned zo = ((unsigned)lr * INC + lc) * 2u;
        bf16* xb = MIX + (size_t)(u.pm * 256) * D + u.pn * 256; const unsigned xo = ((unsigned)lr * D + lc) * 2u;
        f32x4 ps[2][2];
#pragma unroll
        for (int bj = 0; bj < 2; ++bj)
#pragma unroll
            for (int n = 0; n < 2; ++n) ps[bj][n] = KIND == 2 ? ldg<f32x4>(pscale + u.pn * 256, (unsigned)(lc + bj * 128 + 4 * n) * 4u) : (f32x4){1.f, 1.f, 1.f, 1.f};
#pragma unroll
        for (int ai = 0; ai < 2; ++ai)
#pragma unroll
          for (int mp = 0; mp < 2; ++mp) {
            u32x4 gw[2][2], mw[2][2];
#pragma unroll
            for (int mm = 0; mm < 2; ++mm)
#pragma unroll
                for (int bj = 0; bj < 2; ++bj) { const unsigned ro = (unsigned)(ai * 128 + (2 * mp + mm) * 16);
                    gw[mm][bj] = ldg<u32x4>(zb, zo + (ro * INC + bj * 128) * 2u);
                    if (KIND != 0) mw[mm][bj] = ldg<u32x4>(xb, xo + (ro * D + bj * 128) * 2u); else mw[mm][bj] = (u32x4){0u, 0u, 0u, 0u}; }
#pragma unroll
            for (int mm = 0; mm < 2; ++mm)
#pragma unroll
                for (int bj = 0; bj < 2; ++bj) { const int m = 2 * mp + mm; const unsigned ro = (unsigned)(ai * 128 + m * 16); const u32x4 g = gw[mm][bj], q = mw[mm][bj];
                    f32x4 g0 = {bflo(g.x), bfhi(g.x), bflo(g.y), bfhi(g.y)}, g1 = {bflo(g.z), bfhi(g.z), bflo(g.w), bfhi(g.w)};
                    if (KIND == 2) { g0 *= ps[bj][0]; g1 *= ps[bj][1]; }
                    const f32x4 o0 = g0 * acc[ai][bj][m][0] + (f32x4){bflo(q.x), bfhi(q.x), bflo(q.y), bfhi(q.y)}, o1 = g1 * acc[ai][bj][m][1] + (f32x4){bflo(q.z), bfhi(q.z), bflo(q.w), bfhi(q.w)};
                    u32x4 w; w.x = cvt_pk_bf16(o0[0], o0[1]); w.y = cvt_pk_bf16(o0[2], o0[3]); w.z = cvt_pk_bf16(o1[0], o1[1]); w.w = cvt_pk_bf16(o1[2], o1[3]);
                    stg<u32x4>(xb, xo + (ro * D + bj * 128) * 2u, w); }
            asm volatile("" ::: "memory");
          }
    }
};
struct SchedMix {
    int G, c; const char *AIN, *CIN, *PIN, *WA, *WC, *WP;
    __device__ __forceinline__ bool next(int i, gm::Unit& u) const {
        const int rnd = i / 3, ty = i - rnd * 3; const int L = rnd * G + c; if (L >= 128 * 4) return false;
        int pm, pn; gm::tile_map(L, 128, 4, pm, pn);
        u.pm = pm; u.pn = pn; u.kind = ty; u.aux = 0;
        if (ty == 0) { u.A = AIN + (size_t)pm * gm::TSTEP; u.B = WA + (size_t)pn * gm::TSTEP; u.nt = 16; }
        else if (ty == 1) { u.A = CIN + (size_t)pm * gm::TSTEP; u.B = WC + (size_t)pn * gm::TSTEP; u.nt = 16; }
        else { u.A = PIN + (size_t)pm * gm::TSTEP + pn * 512; u.B = WP + (size_t)pn * gm::TSTEP + pn * 512; u.nt = 4; }
        return true;
    }
    __device__ __forceinline__ unsigned row_off(const gm::Unit&, int) const { return 0u; }
};

template <bool XF32> struct EpiOut {
    static constexpr bool CHAIN = false;
    const void* xin; bf16* xout; const float* g1;
    __device__ __forceinline__ void operator()(const Acc& acc, const gm::Unit& u, int wr, int wc, int fr, int fq) const {
        asm volatile("" : "+v"(fr), "+v"(fq));
        const int lr = wr * 64 + fr, lc = wc * 32 + 8 * fq; const int b = u.pm / 16;
        bf16* ob = xout + (size_t)(u.pm * 256) * D + u.pn * 256; const unsigned xo = ((unsigned)lr * D + lc) * 2u;
        f32x4 gv[2][2];
#pragma unroll
        for (int bj = 0; bj < 2; ++bj)
#pragma unroll
            for (int n = 0; n < 2; ++n) gv[bj][n] = ldg<f32x4>(g1 + (size_t)b * 6 * D + u.pn * 256, (unsigned)(lc + bj * 128 + 4 * n) * 4u);
        if constexpr (XF32) {
            const float* ib = (const float*)xin + (size_t)(u.pm * 256) * D + u.pn * 256;
#pragma unroll
            for (int ai = 0; ai < 2; ++ai)
#pragma unroll
                for (int mp = 0; mp < 2; ++mp) {
                    f32x4 xv[2][2][2];
#pragma unroll
                    for (int mm = 0; mm < 2; ++mm)
#pragma unroll
                        for (int bj = 0; bj < 2; ++bj) { const unsigned o = 2u * xo + ((unsigned)(ai * 128 + (2 * mp + mm) * 16) * D + bj * 128) * 4u; xv[mm][bj][0] = ldg<f32x4>(ib, o); xv[mm][bj][1] = ldg<f32x4>(ib, o + 16u); }
#pragma unroll
                    for (int mm = 0; mm < 2; ++mm)
#pragma unroll
                        for (int bj = 0; bj < 2; ++bj) { const int m = 2 * mp + mm; const f32x4 o0 = xv[mm][bj][0] + gv[bj][0] * acc[ai][bj][m][0], o1 = xv[mm][bj][1] + gv[bj][1] * acc[ai][bj][m][1];
                            u32x4 w; w.x = cvt_pk_bf16(o0[0], o0[1]); w.y = cvt_pk_bf16(o0[2], o0[3]); w.z = cvt_pk_bf16(o1[0], o1[1]); w.w = cvt_pk_bf16(o1[2], o1[3]);
                            stg<u32x4>(ob, xo + ((unsigned)(ai * 128 + m * 16) * D + bj * 128) * 2u, w); }
                    asm volatile("" ::: "memory");
                }
        } else {
            const bf16* ib = (const bf16*)xin + (size_t)(u.pm * 256) * D + u.pn * 256;
#pragma unroll
            for (int ai = 0; ai < 2; ++ai) {
                u32x4 xv[4][2];
#pragma unroll
                for (int m = 0; m < 4; ++m)
#pragma unroll
                    for (int bj = 0; bj < 2; ++bj) xv[m][bj] = ldg<u32x4>(ib, xo + ((unsigned)(ai * 128 + m * 16) * D + bj * 128) * 2u);
#pragma unroll
                for (int m = 0; m < 4; ++m)
#pragma unroll
                    for (int bj = 0; bj < 2; ++bj) { const u32x4 q = xv[m][bj];
                        const f32x4 o0 = (f32x4){bflo(q.x), bfhi(q.x), bflo(q.y), bfhi(q.y)} + gv[bj][0] * acc[ai][bj][m][0], o1 = (f32x4){bflo(q.z), bfhi(q.z), bflo(q.w), bfhi(q.w)} + gv[bj][1] * acc[ai][bj][m][1];
                        u32x4 w; w.x = cvt_pk_bf16(o0[0], o0[1]); w.y = cvt_pk_bf16(o0[2], o0[3]); w.z = cvt_pk_bf16(o1[0], o1[1]); w.w = cvt_pk_bf16(o1[2], o1[3]);
                        stg<u32x4>(ob, xo + ((unsigned)(ai * 128 + m * 16) * D + bj * 128) * 2u, w); }
                asm volatile("" ::: "memory");
            }
        }
    }
};
struct SchedOut {
    int G, c; const char *MIXP, *WO;
    __device__ __forceinline__ bool next(int i, gm::Unit& u) const {
        const int L = i * G + c; if (L >= 128 * 4) return false;
        int pm, pn; gm::tile_map(L, 128, 4, pm, pn);
        u.pm = pm; u.pn = pn; u.kind = 0; u.aux = 0; u.nt = 16; u.A = MIXP + (size_t)pm * gm::TSTEP; u.B = WO + (size_t)pn * gm::TSTEP;
        return true;
    }
    __device__ __forceinline__ unsigned row_off(const gm::Unit&, int) const { return 0u; }
};

struct SchedMoe {
    int NG, r, x, npn; const LAS int* tb;
    const char* Abase; const char* Wbase; unsigned wstride;
    const int* LIST; bool gather;
    __device__ __forceinline__ bool next(int i, gm::Unit& u) const {
        const int j = i * NG + r; int mt = j / npn; const int pn = j - mt * npn;
#define TB(i) __builtin_amdgcn_readfirstlane(tb[i])
        int e = x; int T = TB(e);
        if (mt >= T) { mt -= T; e += 8; T = TB(e);
            if (mt >= T) { mt -= T; e += 8; T = TB(e);
                if (mt >= T) { mt -= T; e += 8; T = TB(e); if (mt >= T) return false; } } }
        u.aux = e; u.pn = pn; u.nt = 16; u.kind = TB(64 + e) - 256 * mt;
        const int arow = TB(32 + e) + 256 * mt;
        if (gather) { u.A = Abase; u.pm = arow; u.B = Wbase + (size_t)e * wstride + (size_t)pn * gm::TSTEP; }
        else { u.A = Abase + (size_t)arow * gm::PITCH; u.pm = 256 * mt; u.B = Wbase + (size_t)e * wstride + (size_t)pn * gm::TSTEP; }
        return true;
    }
    __device__ __forceinline__ unsigned row_off(const gm::Unit& u, int rr) const {
        const int mt256 = u.pm - TB(32 + u.aux);
        int slot = LIST[(size_t)u.aux * NTOK + mt256 + rr]; slot = (rr < u.kind) ? slot : 0;
        return (unsigned)(slot >> 2) * gm::PITCH;
    }
};
struct EpiGU {
    static constexpr int MIN_VMEM = 8;
    bf16* ACT; const float* bgu;
    __device__ __forceinline__ void operator()(const Acc& acc, const gm::Unit& u, int wr, int wc, int fr, int fq) const {
        asm volatile("" : "+v"(fr), "+v"(fq));
        const int e = u.aux, lc = wc * 32 + 8 * fq;
        bf16* ab = ACT + (size_t)u.pm * FF + u.pn * 128; const unsigned ao = ((unsigned)(wr * 64 + fr) * FF + lc) * 2u;
        const float* bb = bgu + (size_t)e * 2 * FF + u.pn * 128;
        f32x4 bg[2], bu[2];
#pragma unroll
        for (int n = 0; n < 2; ++n) { bg[n] = ldg<f32x4>(bb, (unsigned)(lc + 4 * n) * 4u); bu[n] = ldg<f32x4>(bb + FF, (unsigned)(lc + 4 * n) * 4u); }
#pragma unroll
        for (int ai = 0; ai < 2; ++ai)
#pragma unroll
            for (int m = 0; m < 4; ++m) { float o[8];
#pragma unroll
                for (int j = 0; j < 8; ++j) { float g = acc[ai][0][m][j >> 2][j & 3] + bg[j >> 2][j & 3], up = acc[ai][1][m][j >> 2][j & 3] + bu[j >> 2][j & 3];
                    g = fminf(g, 7.0f); up = fminf(fmaxf(up, -7.0f), 7.0f);
                    const float glu = g * __builtin_amdgcn_rcpf(1.0f + __builtin_amdgcn_exp2f(-1.702f * 1.44269504089f * g));
                    o[j] = (up + 1.0f) * glu; }
                u32x4 w; w.x = cvt_pk_bf16(o[0], o[1]); w.y = cvt_pk_bf16(o[2], o[3]); w.z = cvt_pk_bf16(o[4], o[5]); w.w = cvt_pk_bf16(o[6], o[7]);
                stg<u32x4>(ab, ao + (unsigned)((ai * 128 + m * 16) * FF) * 2u, w);
                asm volatile("" ::: "memory"); }
    }
};
struct EpiDown {
    static constexpr int MIN_VMEM = 16;
    bf16* YB; const float* bdn; const int* LIST; const float* WL;
    __device__ __forceinline__ void operator()(const Acc& acc, const gm::Unit& u, int wr, int wc, int fr, int fq) const {
        asm volatile("" : "+v"(fr), "+v"(fq));
        const int e = u.aux, lc = wc * 32 + 8 * fq, nvalid = u.kind, lr = wr * 64 + fr;
        const int* lb = LIST + (size_t)e * NTOK + u.pm; const float* wb = WL + (size_t)e * NTOK + u.pm;
        bf16* yb = YB + u.pn * 256; const float* bb = bdn + (size_t)e * D + u.pn * 256;
        f32x4 bd[2][2];
#pragma unroll
        for (int bj = 0; bj < 2; ++bj)
#pragma unroll
            for (int n = 0; n < 2; ++n) bd[bj][n] = ldg<f32x4>(bb, (unsigned)(lc + bj * 128 + 4 * n) * 4u);
        int slots[2][4]; float wts[2][4];
#pragma unroll
        for (int ai = 0; ai < 2; ++ai)
#pragma unroll
            for (int m = 0; m < 4; ++m) { const unsigned r = (unsigned)(lr + ai * 128 + m * 16); slots[ai][m] = ldg<int>(lb, r * 4u); wts[ai][m] = ldg<float>(wb, r * 4u); }
#pragma unroll
        for (int ai = 0; ai < 2; ++ai)
#pragma unroll
            for (int m = 0; m < 4; ++m) { const int r = lr + ai * 128 + m * 16;
                const unsigned slot = (r < nvalid) ? (unsigned)slots[ai][m] : (unsigned)(NTOK * TOPK); const float w = (r < nvalid) ? wts[ai][m] : 0.f;
#pragma unroll
                for (int bj = 0; bj < 2; ++bj) { const f32x4 y0 = (acc[ai][bj][m][0] + bd[bj][0]) * w, y1 = (acc[ai][bj][m][1] + bd[bj][1]) * w;
                    u32x4 o; o.x = cvt_pk_bf16(y0[0], y0[1]); o.y = cvt_pk_bf16(y0[2], y0[3]); o.z = cvt_pk_bf16(y1[0], y1[1]); o.w = cvt_pk_bf16(y1[2], y1[3]);
                    stg<u32x4>(yb, (slot * D + lc + bj * 128) * 2u, o); }
                asm volatile("" ::: "memory"); }
    }
};

__device__ __forceinline__ void tt_load(f32x4 (&tv)[16], const float* W, int N, int k0, int n0, int lane) {
#pragma unroll
    for (int i = 0; i < 16; ++i) tv[i] = ldg<f32x4>(W + (size_t)k0 * N + n0, ((unsigned)(i * 4 + (lane >> 4)) * (unsigned)N + 4u * (lane & 15)) * 4u);
}
__device__ __forceinline__ void tt_store(const f32x4 (&tv)[16], int k0, int n0, bf16* WT, int drow0, int dcol0, LAS float* scr, int lane) {
#pragma unroll
    for (int i = 0; i < 16; ++i) { const int kk = i * 4 + (lane >> 4); LAS float* p = scr + kk * 65 + 4 * (lane & 15); p[0] = tv[i].x; p[1] = tv[i].y; p[2] = tv[i].z; p[3] = tv[i].w; }
    asm volatile("s_waitcnt lgkmcnt(0)" ::: "memory");
    const int c = lane & 7;
#pragma unroll
    for (int j = 0; j < 8; ++j) { const int n = (lane >> 3) + 8 * j; const LAS float* s = scr + (8 * c) * 65 + n;
        u32x4 o; o.x = cvt_pk_bf16(s[0 * 65], s[1 * 65]); o.y = cvt_pk_bf16(s[2 * 65], s[3 * 65]); o.z = cvt_pk_bf16(s[4 * 65], s[5 * 65]); o.w = cvt_pk_bf16(s[6 * 65], s[7 * 65]);
        stg<u32x4>(WT + (size_t)(drow0 + n0) * 1024 + dcol0 + k0, ((unsigned)n * 1024u + 8u * c) * 2u, o);
        if (j & 1) __builtin_amdgcn_sched_barrier(0); }
    asm volatile("s_waitcnt lgkmcnt(0)" ::: "memory");
}
struct P0Item { const float* W; bf16* WT; int N, k0, n0, drow0, dcol0; };
__device__ __forceinline__ P0Item p0_decode(Frame& F, int it) {
    constexpr int I_GU = 16 * 32, I_DN = 16 * 16, I_IN = 16 * 144, I_SQ = 16 * 16, I_PL = 4 * 4;
    constexpr int N_GU = DEPTH * NE * I_GU, N_DN = DEPTH * NE * I_DN, N_IN = DEPTH * I_IN, N_SQ = DEPTH * I_SQ;
    P0Item t; t.dcol0 = 0; t.drow0 = 0;
    int r = it;
    if (r < N_GU) { const int mat = r / I_GU, q = r % I_GU, kb = q / 32, nb = q % 32, n0 = 64 * nb, half = n0 / FF, f0 = n0 % FF;
        t.W = FIN(18) + (size_t)mat * D * 2 * FF; t.N = 2 * FF; t.k0 = 64 * kb; t.n0 = n0; t.WT = WSP(bf16, WS_WTGU) + (size_t)mat * 2 * FF * D; t.drow0 = (f0 / 128) * 256 + 128 * half + (f0 % 128) - n0; return t; }
    r -= N_GU;
    if (r < N_DN) { const int mat = r / I_DN, q = r % I_DN, kb = q / 16, nb = q % 16;
        t.W = FIN(20) + (size_t)mat * FF * D; t.N = D; t.k0 = 64 * kb; t.n0 = 64 * nb; t.WT = WSP(bf16, WS_WTDN) + (size_t)mat * D * FF; return t; }
    r -= N_DN;
    if (r < N_IN) { const int mat = r / I_IN, q = r % I_IN, kb = q / 144, nb = q % 144;
        const int n0 = 64 * nb; int dr = n0;
        if (n0 >= Z_X && n0 < Z_X + D) { const int f = n0 - Z_X, j = f >> 7; dr = (j < 4 ? 12 + j : 16 + j) * 256 + (f & 127); }
        else if (n0 >= Z_C && n0 < Z_C + D) { const int f = n0 - Z_C, j = f >> 7; dr = (j < 4 ? 12 + j : 16 + j) * 256 + 128 + (f & 127); }
        t.W = FIN(5) + (size_t)mat * D * INC; t.N = INC; t.k0 = 64 * kb; t.n0 = n0; t.WT = WSP(bf16, WS_WTIN) + (size_t)mat * INC * D; t.drow0 = dr - n0; return t; }
    r -= N_IN;
    if (r < 3 * N_SQ) { const int which = r / N_SQ, q2 = r % N_SQ, mat = q2 / I_SQ, q = q2 % I_SQ, kb = q / 16, nb = q % 16;
        t.W = (which == 0 ? FIN(9) : (which == 1 ? FIN(13) : FIN(14))) + (size_t)mat * D * D;
        t.WT = WSP(bf16, which == 0 ? WS_WTA : (which == 1 ? WS_WTC : WS_WTO)) + (size_t)mat * D * D;
        t.N = D; t.k0 = 64 * kb; t.n0 = 64 * nb; return t; }
    r -= 3 * N_SQ;
    { const int mat = r / I_PL, q = r % I_PL, kb = q / 4, nb = q % 4, l = mat / 4, g = mat % 4;
        t.W = FIN(10) + (size_t)mat * 256 * 256; t.N = 256; t.k0 = 64 * kb; t.n0 = 64 * nb; t.WT = WSP(bf16, WS_WTPOOL) + (size_t)l * D * D; t.drow0 = g * 256; t.dcol0 = g * 256; }
    return t;
}
template <int MODE>
__device__ __forceinline__ void convert_items(Frame& F, unsigned* ctr, int l) {
    constexpr int I_GU = 16 * 32, I_DN = 16 * 16, I_IN = 16 * 144, I_SQ = 16 * 16, I_PL = 4 * 4;
    constexpr int N_GU = DEPTH * NE * I_GU, N_DN = DEPTH * NE * I_DN, N_IN = DEPTH * I_IN, N_SQ = DEPTH * I_SQ, N_PL = DEPTH * 4 * I_PL;
    constexpr int NV = MODE == 0 ? N_IN + 3 * N_SQ + N_PL : (N_GU + N_DN) / DEPTH;
    static_assert(NV % 8 == 0 && (N_GU / DEPTH) % 8 == 0, "chunks of eight (a chunk is whole or absent, and of one kind)");
    FRESH_IDS(F);
    LAS float* scr = (LAS float*)(F.lds + F.wave * 16640);
    LAS int* nbs = (LAS int*)(F.lds + LDSCTL_OFF + 64);
#define CV_ITEM(v) (MODE == 0 ? N_GU + N_DN + (v) : ((v) < N_GU / DEPTH ? l * (N_GU / DEPTH) + (v) : N_GU + l * (N_DN / DEPTH) + (v) - N_GU / DEPTH))
    __syncthreads();
    if (F.tid == 0) { nbs[0] = (int)__hip_atomic_fetch_add(ctr, 8u, RLX_AGENT); nbs[1] = (int)__hip_atomic_fetch_add(ctr, 8u, RLX_AGENT); }
    __syncthreads();
    int cur = __builtin_amdgcn_readfirstlane(nbs[0]), nxt = __builtin_amdgcn_readfirstlane(nbs[1]);
    f32x4 ta[16], tb[16];
    if (cur < NV) { const P0Item t = p0_decode(F, CV_ITEM(cur + F.wave)); tt_load(ta, t.W, t.N, t.k0, t.n0, F.lane); }
#define P0_STEP(TC, TN, slot) { int nn = 0; if (F.tid == 0) nn = (int)__hip_atomic_fetch_add(ctr, 8u, RLX_AGENT); \
        if (nxt < NV) { const P0Item t = p0_decode(F, CV_ITEM(nxt + F.wave)); tt_load(TN, t.W, t.N, t.k0, t.n0, F.lane); } \
        { const P0Item t = p0_decode(F, CV_ITEM(cur + F.wave)); tt_store(TC, t.k0, t.n0, t.WT, t.drow0, t.dcol0, scr, F.lane); } \
        if (F.tid == 0) nbs[slot] = nn; \
        __syncthreads(); \
        cur = nxt; nxt = __builtin_amdgcn_readfirstlane(nbs[slot]); }
    while (cur < NV) {
        P0_STEP(ta, tb, 0)
        if (cur >= NV) break;
        P0_STEP(tb, ta, 1)
    }
#undef P0_STEP
#undef CV_ITEM
    __syncthreads();
}
__device__ __forceinline__ void p0_prologue(Frame& F) {
    FRESH_IDS(F);
    float* mods = WSP(float, WS_MODS);
    {
        LAS float* sil = (LAS float*)(F.lds + 65536);
        LAS f32x4* part = (LAS f32x4*)F.lds;
        for (int i = F.tid; i < NB * D; i += NTHREADS) { const float cv = FIN(1)[i]; sil[i] = cv * __builtin_amdgcn_rcpf(1.0f + __builtin_amdgcn_exp2f(-1.44269504089f * cv)); }
        __syncthreads();
        for (int cb = F.bid; cb < 256; cb += F.G) {
            const int l = cb >> 7, colq = F.lane % 12, rsub = F.lane / 12, cbase = (cb & 127) * 48, k0 = F.wave * 128;
            const float* aw = FIN(3) + (size_t)l * D * 6 * D + cbase;
            f32x4 a[NB];
#pragma unroll
            for (int b = 0; b < NB; ++b) a[b] = (f32x4){0.f, 0.f, 0.f, 0.f};
#pragma unroll
            for (int jb = 0; jb < 2; ++jb) { f32x4 w[13]; int kk[13];
#pragma unroll
                for (int j = 0; j < 13; ++j) { const int k = k0 + 5 * (13 * jb + j) + rsub; kk[j] = k < k0 + 128 ? k : k0 + 127; w[j] = ldg<f32x4>(aw, ((unsigned)kk[j] * (6u * D) + 4u * colq) * 4u);
                    if (!(rsub < 5 && k < k0 + 128)) w[j] = (f32x4){0.f, 0.f, 0.f, 0.f}; }
#pragma unroll
                for (int j = 0; j < 13; ++j) {
#pragma unroll
                    for (int b = 0; b < NB; ++b) a[b] += w[j] * sil[b * D + kk[j]];
                    __builtin_amdgcn_sched_barrier(0); } }
#pragma unroll
            for (int b = 0; b < NB; ++b) part[(F.wave * 64 + F.lane) * NB + b] = a[b];
            __syncthreads();
            if (F.tid < 96) { const int b = F.tid / 12, cq = F.tid % 12;
                f32x4 sum = ldg<f32x4>(FIN(4) + (size_t)l * 6 * D + cbase, (unsigned)(4 * cq) * 4u);
#pragma unroll
                for (int w = 0; w < 8; ++w) {
#pragma unroll
                    for (int rs = 0; rs < 5; ++rs) sum += part[(w * 64 + cq + 12 * rs) * NB + b];
                    __builtin_amdgcn_sched_barrier(0); }
                stg<f32x4>(mods + (size_t)l * NB * 6 * D + cbase, ((unsigned)b * (6u * D) + 4u * cq) * 4u, sum); }
            __syncthreads();
        }
    }
    {
        const int gt = F.bid * NTHREADS + F.tid, NGT = F.G * NTHREADS;
        for (int p = gt; p < DEPTH * 8 * CHUNK * 16; p += NGT) { const int kc = p & 15, t = (p >> 4) & 127, hh = p >> 11;
            const float* wrow = FIN(7) + (size_t)hh * CHUNK * CHUNK + t * CHUNK + 8 * kc;
            const f32x4 a = *(const f32x4*)wrow, c = *(const f32x4*)(wrow + 4); float v[8] = {a.x, a.y, a.z, a.w, c.x, c.y, c.z, c.w};
#pragma unroll
            for (int j = 0; j < 8; ++j) v[j] = (8 * kc + j <= t) ? v[j] : 0.f;
            u32x4 w; w.x = cvt_pk_bf16(v[0], v[1]); w.y = cvt_pk_bf16(v[2], v[3]); w.z = cvt_pk_bf16(v[4], v[5]); w.w = cvt_pk_bf16(v[6], v[7]);
            *(u32x4*)(F.ws + WS_WIMG + (size_t)hh * 32768 + t * 256 + ((kc ^ (t & 15)) << 4)) = w; }
    }
    convert_items<0>(F, F.ctl + CW_P0CTR, 0);
}

struct RowBuf { f32x4 x[4]; u32x2 xb[4]; u32x2 y[4][4]; };
template <bool HASY>
__device__ __forceinline__ void row_load(RowBuf& R, const void* xin, const bf16* yb, int row, int lane) {
    if (HASY) {
#pragma unroll
        for (int j = 0; j < 4; ++j) R.xb[j] = *(const u32x2*)((const bf16*)xin + (size_t)row * D + 256 * j + 4 * lane);
#pragma unroll
        for (int j = 0; j < 4; ++j)
#pragma unroll
            for (int k = 0; k < TOPK; ++k) R.y[j][k] = *(const u32x2*)(yb + ((size_t)row * TOPK + k) * D + 256 * j + 4 * lane);
    } else {
#pragma unroll
        for (int j = 0; j < 4; ++j) R.x[j] = *(const f32x4*)((const float*)xin + (size_t)row * D + 256 * j + 4 * lane);
    }
}
template <int MODE, bool HASY>
__device__ __forceinline__ void norm_rows(Frame& F, const void* xin, const bf16* yb, const float* g2, bf16* xst, const float* gn, const float* sc, const float* sh, bf16* hout, float* fout) {
    FRESH_IDS(F);
    const int gw = F.bid * NWAVES + F.wave, NGW = F.G * NWAVES, lane = F.lane;
    f32x4 gnv[4], g2v[4], scv[4], shv[4]; int bcur = -1;
#pragma unroll
    for (int j = 0; j < 4; ++j) gnv[j] = *(const f32x4*)(gn + 256 * j + 4 * lane);
    RowBuf R0, R1;
    int row = gw;
    if (row < NTOK) row_load<HASY>(R0, xin, yb, row, lane);
#define NORM_PROCESS(R, row_) do { const int b = (row_) / SEQ; const size_t ro = (size_t)(row_) * D; \
        if (b != bcur) { bcur = b; _Pragma("unroll") for (int j = 0; j < 4; ++j) { const int col = 256 * j + 4 * lane; \
            if (HASY) g2v[j] = *(const f32x4*)(g2 + (size_t)b * 6 * D + col); \
            if (MODE == 0) { scv[j] = *(const f32x4*)(sc + (size_t)b * 6 * D + col); shv[j] = *(const f32x4*)(sh + (size_t)b * 6 * D + col); } } } \
        f32x4 v[4]; float s = 0.f; \
        _Pragma("unroll") for (int j = 0; j < 4; ++j) { \
            if (HASY) { f32x4 ys = unpack_lo4((R).y[j][0]); _Pragma("unroll") for (int k = 1; k < TOPK; ++k) ys += unpack_lo4((R).y[j][k]); v[j] = unpack_lo4((R).xb[j]) + g2v[j] * ys; } \
            else v[j] = (R).x[j]; \
            s += (v[j].x * v[j].x + v[j].y * v[j].y) + (v[j].z * v[j].z + v[j].w * v[j].w); } \
        if (xst) { _Pragma("unroll") for (int j = 0; j < 4; ++j) { u32x2 w; w.x = cvt_pk_bf16(v[j].x, v[j].y); w.y = cvt_pk_bf16(v[j].z, v[j].w); *(u32x2*)(xst + ro + 256 * j + 4 * lane) = w; } } \
        const float rstd = 1.0f / sqrtf(wave_sum(s) * (1.0f / D) + RMS_EPS); \
        _Pragma("unroll") for (int j = 0; j < 4; ++j) { const int col = 256 * j + 4 * lane; \
            if (MODE == 0) { const f32x4 o = v[j] * rstd * gnv[j] * (scv[j] + 1.0f) + shv[j]; u32x2 w; w.x = cvt_pk_bf16(o.x, o.y); w.y = cvt_pk_bf16(o.z, o.w); *(u32x2*)(hout + ro + col) = w; } \
            else { *(f32x4*)(fout + ro + col) = v[j] * rstd * gnv[j]; } } } while (0)
    while (row < NTOK) {
        const int r1 = row + NGW;
        if (r1 < NTOK) row_load<HASY>(R1, xin, yb, r1, lane);
        NORM_PROCESS(R0, row);
        if (r1 >= NTOK) break;
        const int r2 = r1 + NGW;
        if (r2 < NTOK) row_load<HASY>(R0, xin, yb, r2, lane);
        NORM_PROCESS(R1, r1);
        row = r2;
    }
#undef NORM_PROCESS
}

__device__ __forceinline__ void router_prep(Frame& F) {
    FRESH_IDS(F);
    const float* mods = WSP(float, WS_MODS); bf16* rwh = WSP(bf16, WS_RWT); bf16* rwl = WSP(bf16, WS_RWT + 1 * MiB); float* rb = WSP(float, WS_RBIAS);
    const int gt = F.bid * NTHREADS + F.tid, NGT = F.G * NTHREADS;
    for (int i = gt; i < DEPTH * NB * NE * D; i += NGT) { const int k = i % D, e = (i / D) % NE, b = (i / (D * NE)) % NB, l = i / (D * NE * NB);
        const float w = FIN(15)[l * D + k] * (1.0f + mods[((size_t)l * NB + b) * 6 * D + 4 * D + k]) * FIN(16)[((size_t)l * D + k) * NE + e];
        const unsigned hi = cvt_pk_bf16(w, 0.f) & 0xffffu, lo = cvt_pk_bf16(w - __uint_as_float(hi << 16), 0.f) & 0xffffu;
        rwh[i] = (bf16)hi; rwl[i] = (bf16)lo; }
    const int gw = F.bid * NWAVES + F.wave, NGW = F.G * NWAVES;
    for (int o = gw; o < DEPTH * NB * NE; o += NGW) { const int e = o % NE, b = (o / NE) % NB, l = o / (NE * NB); float s = 0.f;
        for (int k = F.lane; k < D; k += 64) s += mods[((size_t)l * NB + b) * 6 * D + 3 * D + k] * FIN(16)[((size_t)l * D + k) * NE + e];
        s = wave_sum(s); if (F.lane == 0) rb[o] = s + FIN(17)[l * NE + e]; }
}

__device__ __forceinline__ void mixer_prep(Frame& F, int l) {
    FRESH_IDS(F);
    const bf16* Z = WSP(bf16, WS_Z); const bf16* VT = WSP(bf16, WS_VT); const float* vss = WSP(float, WS_VSS) + (size_t)l * NTOK;
    bf16* AIN = WSP(bf16, WS_AIN); bf16* CIN = WSP(bf16, WS_CIN); bf16* PIN = WSP(bf16, WS_PIN);
    const float* convw = FIN(12) + (size_t)l * 3 * D; const float* gng = FIN(6) + (size_t)l * D; const char* wimg = (const char*)(F.ws + WS_WIMG) + (size_t)l * 8 * 32768; const float* bs = FIN(8) + (size_t)l * 8 * CHUNK;
    LAS unsigned char* Abuf = F.lds; LAS unsigned char* Bimg = F.lds + 65536; LAS float* rs = (LAS float*)(F.lds + 98304);
    for (int chunk = F.bid; chunk < NTOK / CHUNK; chunk += F.G) {
        const int tok0 = chunk * CHUNK, pos0 = tok0 % SEQ;
        FRESH_IDS(F);
        int tid = F.tid, lane = F.lane, wave = F.wave;
        {
            const int cg = (wave & 1) * 64 + lane, rsq = wave >> 1, t0 = 32 * rsq; const unsigned c0b = 16u * (unsigned)cg;
            float w0[8], w1[8], w2[8];
#pragma unroll
            for (int j = 0; j < 8; ++j) { w0[j] = ldg<float>(convw, 2 * c0b + 4 * j); w1[j] = ldg<float>(convw + D, 2 * c0b + 4 * j); w2[j] = ldg<float>(convw + 2 * D, 2 * c0b + 4 * j); }
            float p2[8], p1[8];
#pragma unroll
            for (int j = 0; j < 8; ++j) { p2[j] = 0.f; p1[j] = 0.f; }
            if (pos0 + t0 >= 2) {
#pragma unroll
                for (int q = 0; q < 2; ++q) { const bf16* zr = Z + (size_t)(tok0 + t0 - 2 + q) * INC; const u32x4 xv = ldg<u32x4>(zr + Z_X, c0b);
                    const unsigned xa[4] = {xv.x, xv.y, xv.z, xv.w};
#pragma unroll
                    for (int j = 0; j < 4; ++j) { const float a = bflo(xa[j]), bq = bfhi(xa[j]);
                        if (q == 0) { p2[2 * j] = a; p2[2 * j + 1] = bq; } else { p1[2 * j] = a; p1[2 * j + 1] = bq; } } }
            }
            const int pwin = 2 << (cg >> 5);
            float sw[8];
#pragma unroll
            for (int j = 0; j < 8; ++j) sw[j] = 0.f;
            for (int q = 1; q < 16; ++q) { if (q < pwin && pos0 + t0 - q >= 0) { const u32x4 pv = ldg<u32x4>(Z + (size_t)(tok0 + t0 - q) * INC + Z_P, c0b); const unsigned pa[4] = {pv.x, pv.y, pv.z, pv.w};
#pragma unroll
                    for (int j = 0; j < 4; ++j) { sw[2 * j] += bflo(pa[j]); sw[2 * j + 1] += bfhi(pa[j]); } } }
#pragma unroll 1
            for (int tb = t0; tb < t0 + 32; tb += 4) {
                u32x4 xv4[4], bv4[4], pv4[4], qv4[4];
#pragma unroll
                for (int r = 0; r < 4; ++r) { const bf16* zr = Z + (size_t)(tok0 + tb + r) * INC; const int pos = pos0 + tb + r;
                    xv4[r] = ldg<u32x4>(zr + Z_X, c0b); bv4[r] = ldg<u32x4>(zr + Z_B, c0b); pv4[r] = ldg<u32x4>(zr + Z_P, c0b);
                    const int back = (pos - (pwin - 1) >= 0) ? (pwin - 1) : 0;
                    qv4[r] = ldg<u32x4>(zr + Z_P - (ptrdiff_t)back * INC, c0b); }
#pragma unroll
                for (int r = 0; r < 4; ++r) { const int t = tb + r, pos = pos0 + t;
                    const unsigned xa[4] = {xv4[r].x, xv4[r].y, xv4[r].z, xv4[r].w}, ba[4] = {bv4[r].x, bv4[r].y, bv4[r].z, bv4[r].w},
                                   pa[4] = {pv4[r].x, pv4[r].y, pv4[r].z, pv4[r].w}, qa[4] = {qv4[r].x, qv4[r].y, qv4[r].z, qv4[r].w};
                    float zc[8], o[8], pf[8];
#pragma unroll
                    for (int j = 0; j < 4; ++j) { zc[2 * j] = bflo(xa[j]); zc[2 * j + 1] = bfhi(xa[j]); pf[2 * j] = bflo(pa[j]); pf[2 * j + 1] = bfhi(pa[j]); }
#pragma unroll
                    for (int j = 0; j < 8; ++j) { const float cvv = w0[j] * p2[j] + w1[j] * p1[j] + w2[j] * zc[j]; const float bb = (j & 1) ? bfhi(ba[j >> 1]) : bflo(ba[j >> 1]); o[j] = bb * cvv; p2[j] = p1[j]; p1[j] = zc[j]; }
                    u32x4 w; w.x = cvt_pk_bf16(o[0], o[1]); w.y = cvt_pk_bf16(o[2], o[3]); w.z = cvt_pk_bf16(o[4], o[5]); w.w = cvt_pk_bf16(o[6], o[7]);
                    stg<u32x4>(CIN + (size_t)(tok0 + t) * D, c0b, w);
                    const float inv = 1.0f / (float)((pos + 1) < pwin ? (pos + 1) : pwin);
#pragma unroll
                    for (int j = 0; j < 8; ++j) { sw[j] += pf[j]; o[j] = sw[j] * inv - pf[j]; }
                    w.x = cvt_pk_bf16(o[0], o[1]); w.y = cvt_pk_bf16(o[2], o[3]); w.z = cvt_pk_bf16(o[4], o[5]); w.w = cvt_pk_bf16(o[6], o[7]);
                    stg<u32x4>(PIN + (size_t)(tok0 + t) * D, c0b, w);
                    const float qm = (pos - (pwin - 1) >= 0) ? 1.0f : 0.0f;
#pragma unroll
                    for (int j = 0; j < 4; ++j) { sw[2 * j] -= qm * bflo(qa[j]); sw[2 * j + 1] -= qm * bfhi(qa[j]); } }
            }
        }
        FRESH_IDS(F); tid = F.tid; lane = F.lane; wave = F.wave;
        if (tid < CHUNK) rs[tid] = 1.0f / sqrtf(vss[tok0 + tid] * (1.0f / D) + RMS_EPS);
        u32x4 gvv[4];
        const int tq = tid >> 4, kc = tid & 15;
        const unsigned voff = ((unsigned)tq * NTOK + 8u * kc) * 2u;
#define GM_PREFETCH(h_) do { const char* wih = wimg + (size_t)(h_) * 32768 + (unsigned)tid * 16u; const bf16* vth = VT + (size_t)(h_) * CHUNK * NTOK + tok0; \
            _Pragma("unroll") for (int i = 0; i < 4; ++i) __builtin_amdgcn_global_load_lds((const unsigned*)(wih + i * 8192), (LAS unsigned*)(Abuf + ((h_) & 1) * 32768 + i * 8192 + wave * 1024), 16, 0, 0); \
            asm volatile("" ::: "memory");     \
            _Pragma("unroll") for (int i = 0; i < 4; ++i) gvv[i] = ldg<u32x4>(vth + (size_t)32 * i * NTOK, voff); } while (0)
        const int wr = wave >> 1, wc = wave & 1, fr = lane & 15, fq = lane >> 4;
        u32x4 uwA[2][2], uwB[2][2]; f32x4 ggA[4], ggB[4]; float btA[2], btB[2];
#define GM_EPI_LOAD(h_, UW, GG, BT) do { const unsigned coff_ = (unsigned)((h_) * CHUNK + 64 * wc + 16 * fq); \
            _Pragma("unroll") for (int n = 0; n < 4; ++n) GG[n] = ldg<f32x4>(gng, (coff_ + 4 * n) * 4u); \
            _Pragma("unroll") for (int m = 0; m < 2; ++m) { const int t = 32 * wr + 16 * m + fr; BT[m] = ldg<float>(bs, (unsigned)((h_) * CHUNK + t) * 4u); \
                _Pragma("unroll") for (int n = 0; n < 2; ++n) UW[m][n] = ldg<u32x4>(Z + (size_t)tok0 * INC + Z_U, ((unsigned)t * INC + coff_ + 8 * n) * 2u); } } while (0)
#define GM_HEAD(h, UW, GG, BT, UWN, GGN, BTN) do { \
            const LAS unsigned char* Aimg = Abuf + ((h) & 1) * 32768; \
            _Pragma("unroll") for (int i = 0; i < 4; ++i) { const int t = tq + 32 * i; const u32x4 g = gvv[i]; \
                u32x4 w; w.x = cvt_pk_bf16(bflo(g.x) * rsv[0], bfhi(g.x) * rsv[1]); w.y = cvt_pk_bf16(bflo(g.y) * rsv[2], bfhi(g.y) * rsv[3]); \
                w.z = cvt_pk_bf16(bflo(g.z) * rsv[4], bfhi(g.z) * rsv[5]); w.w = cvt_pk_bf16(bflo(g.w) * rsv[6], bfhi(g.w) * rsv[7]); \
                const int tp = (t & ~60) | ((t & 12) << 2) | ((t & 48) >> 2); *(LAS u32x4*)(Bimg + tp * 256 + ((kc ^ (tp & 15)) << 4)) = w; }     \
            __syncthreads(); \
            if ((h) + 1 < 8) { GM_PREFETCH((h) + 1); GM_EPI_LOAD((h) + 1, UWN, GGN, BTN); } \
            const unsigned coff = (unsigned)((h) * CHUNK + 64 * wc + 16 * fq);     \
            f32x4 acc[2][4]; \
            _Pragma("unroll") for (int m = 0; m < 2; ++m) _Pragma("unroll") for (int n = 0; n < 4; ++n) acc[m][n] = (f32x4){0.f, 0.f, 0.f, 0.f}; \
            for (int kk = 0; kk <= wr; ++kk) { \
                bf16x8 a[2], bq[4]; \
                _Pragma("unroll") for (int m = 0; m < 2; ++m) { const int row = 32 * wr + 16 * m + fr; a[m] = *(const LAS bf16x8*)(Aimg + row * 256 + (((4 * kk + fq) ^ (row & 15)) << 4)); } \
                _Pragma("unroll") for (int n = 0; n < 4; ++n) { const int row = 64 * wc + 16 * n + fr; bq[n] = *(const LAS bf16x8*)(Bimg + row * 256 + (((4 * kk + fq) ^ (row & 15)) << 4)); } \
                _Pragma("unroll") for (int m = 0; m < 2; ++m) _Pragma("unroll") for (int n = 0; n < 4; ++n) acc[m][n] = __builtin_amdgcn_mfma_f32_16x16x32_bf16(bq[n], a[m], acc[m][n], 0, 0, 0); \
            } \
            _Pragma("unroll") for (int m = 0; m < 2; ++m) { const int t = 32 * wr + 16 * m + fr; \
                _Pragma("unroll") for (int n = 0; n < 2; ++n) { const u32x4 uq = UW[m][n]; \
                    const f32x4 u0 = {bflo(uq.x), bfhi(uq.x), bflo(uq.y), bfhi(uq.y)}, u1 = {bflo(uq.z), bfhi(uq.z), bflo(uq.w), bfhi(uq.w)}; \
                    const f32x4 o0 = u0 * (acc[m][2 * n] * GG[2 * n] + BT[m]), o1 = u1 * (acc[m][2 * n + 1] * GG[2 * n + 1] + BT[m]); \
                    u32x4 w; w.x = cvt_pk_bf16(o0.x, o0.y); w.y = cvt_pk_bf16(o0.z, o0.w); w.z = cvt_pk_bf16(o1.x, o1.y); w.w = cvt_pk_bf16(o1.z, o1.w); \
                    stg<u32x4>(AIN + (size_t)tok0 * D, ((unsigned)t * D + coff + 8 * n) * 2u, w); } } \
            __syncthreads(); } while (0)
        GM_PREFETCH(0); GM_EPI_LOAD(0, uwA, ggA, btA);
        __syncthreads();
        float rsv[8];
#pragma unroll
        for (int j = 0; j < 8; ++j) rsv[j] = rs[8 * kc + j];
#pragma unroll 1
        for (int h = 0; h < 8; h += 2) {
            GM_HEAD(h, uwA, ggA, btA, uwB, ggB, btB);
            GM_HEAD(h + 1, uwB, ggB, btB, uwA, ggA, btA);
        }
#undef GM_HEAD
#undef GM_EPI_LOAD
#undef GM_PREFETCH
    }
}

__device__ __forceinline__ void router_phase(Frame& F, int l) {
    FRESH_IDS(F);
    const bf16* X = WSP(bf16, WS_XRES); const float* mods = WSP(float, WS_MODS) + (size_t)l * NB * 6 * D; const float* g2n = FIN(15) + (size_t)l * D;
    const bf16* rwh = WSP(bf16, WS_RWT) + (size_t)l * NB * NE * D; const float* rbias = WSP(float, WS_RBIAS) + (size_t)l * NB * NE;
    bf16* H = WSP(bf16, WS_H); int* LIST = WSP(int, WS_LIST); float* WL = WSP(float, WS_WLIST); unsigned* cnt = F.ctl + CW_CNT + l * NE;
    LAS float* lg = (LAS float*)(F.lds) + F.wave * (16 * 33);
    LAS float* rsd = (LAS float*)(F.lds + 17408) + F.wave * 16;
    LAS int* te = (LAS int*)(F.lds + 18432);
    LAS float* tw = (LAS float*)(F.lds + 20480);
    LAS unsigned* hist = (LAS unsigned*)(F.lds + 22528);
    LAS unsigned* base = (LAS unsigned*)(F.lds + 22656);
    const int lane = F.lane, tid = F.tid, q = lane >> 4, r = lane & 15;
    if (tid < 32) hist[tid] = 0u;
    __syncthreads();
    for (int tile = F.bid; tile < NTOK / 128; tile += F.G) {
        const int tok0 = tile * 128 + F.wave * 16, b = tok0 / SEQ;
        u32x4 xr[32];
#pragma unroll
        for (int J = 0; J < 32; ++J) xr[J] = ldg<u32x4>(X + (size_t)tok0 * D, ((unsigned)r * D + 8u * q + 32u * J) * 2u);
        {
            const char* wsrc = (const char*)(rwh + (size_t)b * NE * D);
#pragma unroll
            for (int i = 0; i < 16; ++i) { const int idx = F.wave * 16 + i, hl = idx >> 6, row = (idx >> 1) & 31, hf = idx & 1;
                __builtin_amdgcn_global_load_lds((const unsigned*)(wsrc + (size_t)hl * MiB + row * 2048 + hf * 1024 + lane * 16), (LAS unsigned*)(F.lds + hl * 66048 + row * 2064 + hf * 1024), 16, 0, 0); }
            asm volatile("s_waitcnt vmcnt(0)" ::: "memory");
            __syncthreads();
        }
        const LAS unsigned char* wl = F.lds + r * 2064 + 16 * q;
        f32x4 acc0 = {0.f, 0.f, 0.f, 0.f}, acc1 = {0.f, 0.f, 0.f, 0.f}; float ss = 0.f;
#pragma unroll
        for (int J = 0; J < 32; ++J) {
            const bf16x8 h0 = *(const LAS bf16x8*)(wl + 64 * J), h1 = *(const LAS bf16x8*)(wl + 16 * 2064 + 64 * J), l0 = *(const LAS bf16x8*)(wl + 66048 + 64 * J), l1 = *(const LAS bf16x8*)(wl + 66048 + 16 * 2064 + 64 * J);
            const u32x4 xw = xr[J]; const bf16x8 xf = __builtin_bit_cast(bf16x8, xw);
            const f32x4 x0 = {bflo(xw.x), bfhi(xw.x), bflo(xw.y), bfhi(xw.y)}, x1 = {bflo(xw.z), bfhi(xw.z), bflo(xw.w), bfhi(xw.w)};
            ss += ((x0.x * x0.x + x0.y * x0.y) + (x0.z * x0.z + x0.w * x0.w)) + ((x1.x * x1.x + x1.y * x1.y) + (x1.z * x1.z + x1.w * x1.w));
            acc0 = __builtin_amdgcn_mfma_f32_16x16x32_bf16(xf, h0, acc0, 0, 0, 0); acc1 = __builtin_amdgcn_mfma_f32_16x16x32_bf16(xf, h1, acc1, 0, 0, 0);
            acc0 = __builtin_amdgcn_mfma_f32_16x16x32_bf16(xf, l0, acc0, 0, 0, 0); acc1 = __builtin_amdgcn_mfma_f32_16x16x32_bf16(xf, l1, acc1, 0, 0, 0);
            if ((J & 3) == 3) __builtin_amdgcn_sched_barrier(0); }
        ss += __shfl_xor(ss, 16); ss += __shfl_xor(ss, 32);
        __syncthreads();
        if (tid < 32) hist[tid] = 0u;
        const float rstd = 1.0f / sqrtf(ss * (1.0f / D) + RMS_EPS);
#pragma unroll
        for (int g = 0; g < 4; ++g) { lg[(4 * q + g) * 33 + r] = acc0[g]; lg[(4 * q + g) * 33 + 16 + r] = acc1[g]; }
        if (lane < 16) rsd[lane] = rstd;
        __syncthreads();
        if (lane < 16) {
            float v[NE]; const float rsv = rsd[lane];
#pragma unroll
            for (int e = 0; e < NE; ++e) v[e] = lg[lane * 33 + e] * rsv + rbias[b * NE + e];
            float tv[TOPK]; int ti[TOPK];
#pragma unroll
            for (int k = 0; k < TOPK; ++k) { float best = v[0]; int bi = 0;
#pragma unroll
                for (int e = 1; e < NE; ++e) { if (v[e] > best) { best = v[e]; bi = e; } }
                tv[k] = best; ti[k] = bi;
#pragma unroll
                for (int e = 0; e < NE; ++e) v[e] = (e == bi) ? -3.0e38f : v[e]; }
            float p[TOPK], ps = 0.f;
#pragma unroll
            for (int k = 0; k < TOPK; ++k) { p[k] = __expf(tv[k] - tv[0]); ps += p[k]; }
            const float inv = 1.0f / ps;
#pragma unroll
            for (int k = 0; k < TOPK; ++k) { te[(F.wave * 16 + lane) * 4 + k] = ti[k]; tw[(F.wave * 16 + lane) * 4 + k] = p[k] * inv; }
        }
        {
            f32x4 gmul[4], gadd[4];
#pragma unroll
            for (int j = 0; j < 4; ++j) { const int col = 256 * j + 4 * lane; const f32x4 g = *(const f32x4*)(g2n + col), scv = *(const f32x4*)(mods + (size_t)b * 6 * D + 4 * D + col);
                gmul[j] = g * (scv + 1.0f); gadd[j] = *(const f32x4*)(mods + (size_t)b * 6 * D + 3 * D + col); }
            u32x2 xa0[4], xa1[4];
#pragma unroll
            for (int j = 0; j < 4; ++j) xa0[j] = *(const u32x2*)(X + (size_t)tok0 * D + 256 * j + 4 * lane);
#pragma unroll
            for (int i = 0; i < 16; i += 2) {
#pragma unroll
                for (int j = 0; j < 4; ++j) xa1[j] = *(const u32x2*)(X + (size_t)(tok0 + i + 1) * D + 256 * j + 4 * lane);
                { const float rsv = rsd[i];
#pragma unroll
                  for (int j = 0; j < 4; ++j) { const f32x4 o = unpack_lo4(xa0[j]) * rsv * gmul[j] + gadd[j]; u32x2 w; w.x = cvt_pk_bf16(o.x, o.y); w.y = cvt_pk_bf16(o.z, o.w); *(u32x2*)(H + (size_t)(tok0 + i) * D + 256 * j + 4 * lane) = w; } }
                if (i + 2 < 16) {
#pragma unroll
                    for (int j = 0; j < 4; ++j) xa0[j] = *(const u32x2*)(X + (size_t)(tok0 + i + 2) * D + 256 * j + 4 * lane); }
                { const float rsv = rsd[i + 1];
#pragma unroll
                  for (int j = 0; j < 4; ++j) { const f32x4 o = unpack_lo4(xa1[j]) * rsv * gmul[j] + gadd[j]; u32x2 w; w.x = cvt_pk_bf16(o.x, o.y); w.y = cvt_pk_bf16(o.z, o.w); *(u32x2*)(H + (size_t)(tok0 + i + 1) * D + 256 * j + 4 * lane) = w; } }
            }
        }
        __syncthreads();
        const int t = tid >> 2, k = tid & 3, e = te[t * 4 + k];
        const unsigned rl = __hip_atomic_fetch_add(&hist[e], 1u, __ATOMIC_RELAXED, __HIP_MEMORY_SCOPE_WORKGROUP);
        __syncthreads();
        if (tid < 32) base[tid] = __hip_atomic_fetch_add(cnt + tid, hist[tid], RLX_AGENT);
        __syncthreads();
        const unsigned pos = base[e] + rl;
        LIST[(size_t)e * NTOK + pos] = (tile * 128 + t) * 4 + k; WL[(size_t)e * NTOK + pos] = tw[t * 4 + k];
        __syncthreads();
        if (tid < 32) hist[tid] = 0u;
        __syncthreads();
    }
}

__device__ __forceinline__ void moe_tables(Frame& F, int l) {
    FRESH_IDS(F);
    LAS int* tb = (LAS int*)(F.lds + LDSCTL_OFF + 256);
    __syncthreads();
    if (F.tid == 0) { int ps = 0; for (int e = 0; e < NE; ++e) { const int c = (int)__hip_atomic_load(F.ctl + CW_CNT + l * NE + e, RLX_AGENT); const int T = (c + 255) >> 8; tb[e] = T; tb[32 + e] = ps; tb[64 + e] = c; ps += T * 256; } }
    __syncthreads();
}

__global__ void __launch_bounds__(NTHREADS, 2) fwd_kernel(Args args) {
    extern __shared__ __attribute__((aligned(16))) unsigned char lds_raw[];
    Frame F;
    F.lds = (LAS unsigned char*)lds_raw; F.ws = args.ws; F.ctl = (unsigned*)(args.ws + WS_CTL);
    F.tid = threadIdx.x; F.lane = F.tid & 63; F.wave = __builtin_amdgcn_readfirstlane(F.tid >> 6); F.wave0 = F.wave; F.G = gridDim.x; F.bid = blockIdx.x;
    F.a = &args;
    for (int u = F.tid; u < 256; u += NTHREADS) ((LAS unsigned*)(F.lds + LDSCTL_OFF))[u] = 0u;
    __syncthreads();
    XcdBarrier bar; bar.bar = F.ctl + CW_BAR; bar.x = 0; bar.st = nullptr; bar.wave0 = F.wave0;
    if (N_LAUNCHES == 1) bar = xcd_barrier_post(F.ctl + CW_BAR, (volatile LAS unsigned*)(F.lds + LDSCTL_OFF + 16), F.wave0);
    const int lo = args.ph_lo, hi = args.ph_hi;
#ifdef ONLY_PH
#define IN(k) ((((k) < 2 ? (k) : 2 + ((k) - 2) % 8) == ONLY_PH) && lo <= (k) && (k) < hi)
#else
#define IN(k) (lo <= (k) && (k) < hi)
#endif
#ifdef DIAG_A
#define STAMP(k) do { if (blockIdx.x == 0 && threadIdx.x == 0) ((LAS unsigned long long*)(F.lds + LDSCTL_OFF + 704))[k] = __builtin_amdgcn_s_memrealtime(); } while (0)
#else
#define STAMP(k) do { } while (0)
#endif
#define SEAM(k) do { if (IN(k) && IN((k) + 1)) xcd_barrier(bar); } while (0)

    if (IN(0)) { STAMP(0); p0_prologue(F); } SEAM(0);
    if (IN(1)) {
        STAMP(1);
        const float* mods = WSP(float, WS_MODS);
        norm_rows<0, false>(F, FIN(0), nullptr, nullptr, nullptr, FIN(2), mods + D, mods, WSP(bf16, WS_H), nullptr);
        router_prep(F);
    } SEAM(1);

    for (int l = 0; l < DEPTH; ++l) {
        const int pb = 2 + 8 * l;
        const float* mods = WSP(float, WS_MODS) + (size_t)l * NB * 6 * D;
        if (IN(pb + 0)) { STAMP(pb + 0);
            SchedZ S{F.G, F.bid, (const char*)WSP(bf16, WS_H), (const char*)(WSP(bf16, WS_WTIN) + (size_t)l * INC * D), F.ctl + CW_QZ + l * 128};
            EpiZ E{WSP(bf16, WS_Z), WSP(bf16, WS_VT), WSP(float, WS_VSS) + (size_t)l * NTOK};
            if (((F.bid >> 3) & 3) == 3) convert_items<1>(F, F.ctl + CW_CVCTR + 32 * l, l);
            gm::gemm_phase<EpiZ, SchedZ, false, true>(F.lds, S, E, F.wave0);
        } SEAM(pb + 0);
        if (IN(pb + 1)) { STAMP(pb + 1); mixer_prep(F, l); } SEAM(pb + 1);
        if (IN(pb + 2)) { STAMP(pb + 2);
            SchedMix S{F.G, F.bid, (const char*)WSP(bf16, WS_AIN), (const char*)WSP(bf16, WS_CIN), (const char*)WSP(bf16, WS_PIN),
                       (const char*)(WSP(bf16, WS_WTA) + (size_t)l * D * D), (const char*)(WSP(bf16, WS_WTC) + (size_t)l * D * D), (const char*)(WSP(bf16, WS_WTPOOL) + (size_t)l * D * D)};
            EpiMix E{WSP(bf16, WS_Z), WSP(bf16, WS_MIX), FIN(11) + (size_t)l * D};
            gm::gemm_phase<EpiMix, SchedMix, false>(F.lds, S, E, F.wave0);
        } SEAM(pb + 2);
        if (IN(pb + 3)) { STAMP(pb + 3);
            SchedOut S{F.G, F.bid, (const char*)WSP(bf16, WS_MIX), (const char*)(WSP(bf16, WS_WTO) + (size_t)l * D * D)};
            if (l == 0) { EpiOut<true> E{FIN(0), WSP(bf16, WS_XRES), mods + 2 * D}; gm::gemm_phase<EpiOut<true>, SchedOut, false>(F.lds, S, E, F.wave0); }
            else { EpiOut<false> E{WSP(bf16, WS_XRES), WSP(bf16, WS_XRES), mods + 2 * D}; gm::gemm_phase<EpiOut<false>, SchedOut, false>(F.lds, S, E, F.wave0); }
        } SEAM(pb + 3);
        if (IN(pb + 4)) { STAMP(pb + 4); router_phase(F, l); } SEAM(pb + 4);
        if (IN(pb + 5)) { STAMP(pb + 5);
            moe_tables(F, l);
            SchedMoe S{F.G / 8, F.bid / 8, F.bid % 8, 8, (const LAS int*)(F.lds + LDSCTL_OFF + 256), (const char*)WSP(bf16, WS_H), (const char*)(WSP(bf16, WS_WTGU) + (size_t)l * NE * 2 * FF * D), (unsigned)(2 * FF * D * 2), WSP(int, WS_LIST), true};
            EpiGU E{WSP(bf16, WS_ACT), FIN(19) + (size_t)l * NE * 2 * FF};
            gm::gemm_phase<EpiGU, SchedMoe, true>(F.lds, S, E, F.wave0);
        } SEAM(pb + 5);
        if (IN(pb + 6)) { STAMP(pb + 6);
            moe_tables(F, l);
            SchedMoe S{F.G / 8, F.bid / 8, F.bid % 8, 4, (const LAS int*)(F.lds + LDSCTL_OFF + 256), (const char*)WSP(bf16, WS_ACT), (const char*)(WSP(bf16, WS_WTDN) + (size_t)l * NE * D * FF), (unsigned)(D * FF * 2), WSP(int, WS_LIST), false};
            EpiDown E{WSP(bf16, WS_YB), FIN(21) + (size_t)l * NE * D, WSP(int, WS_LIST), WSP(float, WS_WLIST)};
            gm::gemm_phase<EpiDown, SchedMoe, false>(F.lds, S, E, F.wave0);
        } SEAM(pb + 6);
        if (IN(pb + 7)) { STAMP(pb + 7);
            if (l + 1 < DEPTH) { const float* m2 = WSP(float, WS_MODS) + (size_t)(l + 1) * NB * 6 * D;
                norm_rows<0, true>(F, WSP(bf16, WS_XRES), WSP(bf16, WS_YB), mods + 5 * D, WSP(bf16, WS_XRES), FIN(2) + (size_t)(l + 1) * D, m2 + D, m2, WSP(bf16, WS_H), nullptr); }
            else norm_rows<1, true>(F, WSP(bf16, WS_XRES), WSP(bf16, WS_YB), mods + 5 * D, nullptr, FIN(22), nullptr, nullptr, nullptr, F.a->out);
        } SEAM(pb + 7);
    }
#undef IN
#undef SEAM
}

extern "C" void kernel_launch(void* const* d_in, const int* in_sizes, int n_in, void* d_out, int out_size, void* d_ws, size_t ws_size, hipStream_t stream) {
    static int grid = 0;
    if (grid == 0) {
        if (n_in != 23 || out_size != NTOK * D || ws_size < WS_END) { fprintf(stderr, "kernel_launch: unexpected shapes (n_in %d out %d ws %zu)\n", n_in, out_size, ws_size); grid = -1; return; }
        int dev = 0, cus = 0, per_cu = 0;
        if (hipGetDevice(&dev) != hipSuccess || hipDeviceGetAttribute(&cus, hipDeviceAttributeMultiprocessorCount, dev) != hipSuccess) { grid = -1; return; }
        if (hipFuncSetAttribute((const void*)fwd_kernel, hipFuncAttributeMaxDynamicSharedMemorySize, LDS_BYTES) != hipSuccess) { fprintf(stderr, "kernel_launch: hipFuncSetAttribute failed\n"); grid = -1; return; }
        if (hipOccupancyMaxActiveBlocksPerMultiprocessor(&per_cu, (const void*)fwd_kernel, NTHREADS, LDS_BYTES) != hipSuccess || per_cu < 1) fprintf(stderr, "kernel_launch: occupancy query reports %d\n", per_cu);
        (void)hipGetLastError();
        grid = (cus / 8) * 8;
        if (grid > 256) grid = 256;
        if (grid < 8) { grid = -1; return; }
    }
    if (grid < 0) return;
    if (hipMemsetAsync((char*)d_ws + WS_CTL, 0, CTL_ZERO_BYTES, stream) != hipSuccess) return;
    Args a{};
    for (int i = 0; i < 23; ++i) a.in[i] = (const float*)d_in[i];
    a.out = (float*)d_out; a.ws = (unsigned char*)d_ws;
    for (int li = 0; li < N_LAUNCHES; ++li) {
        a.ph_lo = (N_LAUNCHES == 1) ? 0 : li; a.ph_hi = (N_LAUNCHES == 1) ? NPHASES : li + 1;
        hipLaunchKernelGGL(fwd_kernel, dim3(grid), dim3(NTHREADS), LDS_BYTES, stream, a);
        if (hipPeekAtLastError() != hipSuccess) { fprintf(stderr, "kernel_launch: launch %d failed\n", li); break; }
    }
}
```

```cpp
#include <hip/hip_runtime.h>
#include <cstdio>
#include <cstdint>

#ifndef MK_N_LAUNCHES
#define MK_N_LAUNCHES 1
#endif

#define GAS __attribute__((address_space(1)))
#define LAS __attribute__((address_space(3)))
typedef unsigned short bf16;
typedef short bf16x8 __attribute__((ext_vector_type(8)));
typedef float f32x4 __attribute__((ext_vector_type(4)));
typedef float f32x2 __attribute__((ext_vector_type(2)));
typedef unsigned u32x4 __attribute__((ext_vector_type(4)));
typedef unsigned u32x2 __attribute__((ext_vector_type(2)));

constexpr int D = 1024, NB = 8, SEQ = 4096, NTOK = NB * SEQ, DEPTH = 2, INC = 9216, NE = 32, TOPK = 4, FF = 1024, CHUNK = 128;
constexpr int Z_U = 0, Z_V = 1024, Z_P = 2048, Z_X = 3072, Z_B = 4096, Z_C = 5120, Z_GA = 6144, Z_GB = 7168, Z_GC = 8192;
constexpr float RMS_EPS = 1e-5f;
constexpr int NWAVES = 8, NTHREADS = NWAVES * 64;
constexpr int NPHASES = 2 + 8 * DEPTH;
constexpr int N_LAUNCHES = MK_N_LAUNCHES;
static_assert(N_LAUNCHES == 1 || N_LAUNCHES == NPHASES, "MK_N_LAUNCHES must be 1 or NPHASES");

constexpr size_t MiB = 1u << 20;
constexpr size_t WS_CTL = 0, CTL_ZERO_BYTES = 1 * MiB;
constexpr int CW_BAR = 4096;
constexpr int CW_CNT = 8192;
constexpr int CW_QZ = 8192 + 512;
constexpr int CW_CVCTR = 8192 + 320;
constexpr int CW_P0CTR = 8192 + 256;
constexpr size_t WS_VSS = 256 * 1024;
constexpr size_t WS_MODS = 512 * 1024;
constexpr size_t WS_RWT = 1 * MiB;
constexpr size_t WS_RBIAS = 3 * MiB;
constexpr size_t WS_LIST = 4 * MiB;
constexpr size_t WS_WLIST = 8 * MiB;
constexpr size_t WS_WTPOOL = 12 * MiB;
constexpr size_t WS_WTA = 16 * MiB, WS_WTC = 20 * MiB, WS_WTO = 24 * MiB;
constexpr size_t WS_WTIN = 28 * MiB;
constexpr size_t WS_WTGU = 64 * MiB;
constexpr size_t WS_WTDN = 320 * MiB;
constexpr size_t WS_H = 448 * MiB;
constexpr size_t WS_VT = 512 * MiB;
constexpr size_t WS_AIN = 576 * MiB, WS_CIN = 640 * MiB, WS_PIN = 704 * MiB;
constexpr size_t WS_MIX = 768 * MiB;
constexpr size_t WS_XRES = 832 * MiB;
constexpr size_t WS_WIMG = 960 * MiB;
constexpr size_t WS_Z = 1088 * MiB;
constexpr size_t WS_ACT = WS_Z;
constexpr size_t WS_YB = WS_Z + 288 * MiB;
constexpr size_t WS_END = 1664 * MiB;

constexpr int RING_BYTES = 131072;
constexpr int LDS_BYTES = 147456;
constexpr int LDSCTL_OFF = LDS_BYTES - 1024;

#define RLX_AGENT __ATOMIC_RELAXED, __HIP_MEMORY_SCOPE_AGENT
typedef __bf16 bf16x2_t __attribute__((ext_vector_type(2)));
__device__ __forceinline__ unsigned cvt_pk_bf16(float lo, float hi) { const f32x2 v = {lo, hi}; const bf16x2_t r = __builtin_convertvector(v, bf16x2_t); return __builtin_bit_cast(unsigned, r); }
__device__ __forceinline__ float bflo(unsigned u) { return __uint_as_float(u << 16); }
__device__ __forceinline__ float bfhi(unsigned u) { return __uint_as_float(u & 0xffff0000u); }
__device__ __forceinline__ float wave_sum(float v) {
#pragma unroll
    for (int o = 1; o < 64; o <<= 1) v += __shfl_xor(v, o);
    return v;
}
__device__ __forceinline__ float sigmoidf_fast(float x) { return __builtin_amdgcn_rcpf(1.0f + __builtin_amdgcn_exp2f(-1.44269504089f * x)); }
__device__ __forceinline__ float gelu_tanh(float x) {
    const float t = x * (1.0f + 0.044715f * x * x);
    return x * __builtin_amdgcn_rcpf(1.0f + __builtin_amdgcn_exp2f(-2.30220818f * t));
}
__device__ __forceinline__ f32x4 unpack_lo4(u32x2 w) { return (f32x4){bflo(w.x), bfhi(w.x), bflo(w.y), bfhi(w.y)}; }

__device__ __forceinline__ int tid_of(int wave0) { int l; asm volatile("v_mbcnt_lo_u32_b32 %0, -1, 0\n\tv_mbcnt_hi_u32_b32 %0, -1, %0" : "=v"(l)); return wave0 * 64 + l; }
#define XB_TMO      128
#define XB_XCNT(j)  (256  + 64 * (j))
#define XB_XSUB(j)  (1280 + 64 * (j))
#define XB_XGEN(j)  (2304 + 64 * (j))
#define XB_TOP      3328
#define XB_TOPGEN   3392
#define XCD_BAR_WORDS 3456
#define XB_SPIN_CAP (1u << 18)
__device__ __forceinline__ unsigned xb_ld(unsigned* p)              { return __hip_atomic_load(p, __ATOMIC_RELAXED, __HIP_MEMORY_SCOPE_AGENT); }
__device__ __forceinline__ unsigned xb_add(unsigned* p, unsigned v) { return __hip_atomic_fetch_add(p, v, __ATOMIC_RELAXED, __HIP_MEMORY_SCOPE_AGENT); }
__device__ __forceinline__ unsigned xb_xcc_id() { return (unsigned)__builtin_amdgcn_s_getreg((3 << 11) | 20) & 0xFu; }
#define XB_SPIN(cond, bar) do { unsigned _sp = 0; while (cond) { __builtin_amdgcn_s_sleep(1); \
    if ((++_sp & 255u) == 0u) { if (xb_ld(&(bar)[XB_TMO])) break; if (_sp > XB_SPIN_CAP) { atomicAdd(&(bar)[XB_TMO], 1u); break; } } } } while (0)
struct XcdBarrier { unsigned* bar; unsigned x; volatile LAS unsigned* st; int wave0; };
__device__ __forceinline__ XcdBarrier xcd_barrier_post(unsigned* bar, volatile LAS unsigned* st, int wave0) {
    XcdBarrier b; b.bar = bar; b.x = xb_xcc_id(); b.st = st; b.wave0 = wave0;
    if (tid_of(wave0) == 0) (void)xb_add(&bar[XB_XCNT(b.x)], 1u);
    return b;
}
__device__ __forceinline__ void xcd_barrier_complete(unsigned* bar, unsigned x, unsigned& nloc, unsigned& nx) {
    const unsigned G = gridDim.x * gridDim.y * gridDim.z;
    unsigned sum, cnt, mine, sp = 0u;
    for (;;) {
        sum = 0u; cnt = 0u; mine = 0u;
#pragma unroll
        for (unsigned j = 0; j < 16; ++j) { const unsigned c = xb_ld(&bar[XB_XCNT(j)]); sum += c; cnt += (c > 0u) ? 1u : 0u; mine = (j == x) ? c : mine; }
        if (sum == G) break;
        __builtin_amdgcn_s_sleep(1);
        if ((++sp & 255u) == 0u) { if (xb_ld(&bar[XB_TMO])) break; if (sp > XB_SPIN_CAP) { atomicAdd(&bar[XB_TMO], 1u); break; } }
    }
    nloc = mine > 0u ? mine : 1u; nx = cnt > 0u ? cnt : 1u;
}
__device__ __forceinline__ void xcd_barrier(const XcdBarrier& b) {
    asm volatile("s_waitcnt vmcnt(0)" ::: "memory");
    __syncthreads();
    if (tid_of(b.wave0) == 0) {
        unsigned* bar = b.bar;
        __builtin_amdgcn_s_waitcnt(0);
        unsigned nloc = b.st[0], nx = b.st[1];
        if (nloc == 0u) { xcd_barrier_complete(bar, b.x, nloc, nx); b.st[0] = nloc; b.st[1] = nx; }
        const unsigned old = xb_add(&bar[XB_XSUB(b.x)], 1u);
        const unsigned gen = old / nloc;
        if (old + 1u == (gen + 1u) * nloc) {
            __builtin_amdgcn_fence(__ATOMIC_RELEASE, "agent");
            asm volatile("s_waitcnt vmcnt(0)" ::: "memory");
            const unsigned og = xb_add(&bar[XB_TOP], 1u);
            const unsigned tg = og / nx;
            if (og + 1u == (tg + 1u) * nx) xb_add(&bar[XB_TOPGEN], 1u);
            else XB_SPIN(xb_ld(&bar[XB_TOPGEN]) == tg, bar);
            __builtin_amdgcn_fence(__ATOMIC_ACQUIRE, "agent");
            xb_add(&bar[XB_XGEN(b.x)], 1u);
            asm volatile("s_waitcnt vmcnt(0)" ::: "memory");
        } else {
            XB_SPIN(xb_ld(&bar[XB_XGEN(b.x)]) == gen, bar);
            __builtin_amdgcn_fence(__ATOMIC_ACQUIRE, "agent");
            asm volatile("s_waitcnt vmcnt(0)" ::: "memory");
        }
    }
    __syncthreads();
}

namespace gm {
constexpr int BM = 256, BK = 64, HALF = 128, HTB = HALF * BK * 2;
constexpr unsigned PITCH = 2048u, HSTEP = 128u * PITCH, TSTEP = 256u * PITCH, KSTEP = 128u;
__device__ __forceinline__ int lds_byte(int r, int c) { const int st = (r >> 4) * 2 + (c >> 5), rr = r & 15, cc = c & 31, ob = rr * 64 + cc * 2; return st * 1024 + (ob ^ (((ob >> 9) & 1) << 5)); }
__device__ __forceinline__ void stage_rc(int b, int& R, int& C) { const int st = b / 1024, sb = b % 1024, swz = sb ^ (((sb >> 9) & 1) << 5); R = (st >> 1) * 16 + swz / 64; C = (st & 1) * 32 + (swz % 64) / 2; }
__device__ __forceinline__ int perm32(int rho) { const int n = rho >> 4, i = rho & 15; return 8 * (i >> 2) + 4 * n + (i & 3); }

struct Unit { const char* A; const char* B; int nt, kind, pm, pn, aux; };

__device__ __forceinline__ void tile_map(int L, int nM, int nN, int& pm, int& pn) {
    const int nwg = nM * nN; int wgid = L;
    { const int q = nwg / 8, r = nwg % 8, xcd = wgid % 8, off = wgid / 8; wgid = (xcd < r ? xcd * (q + 1) : r * (q + 1) + (xcd - r) * q) + off; }
    constexpr int WGM = 2; const int nig = WGM * nN, gid = wgid / nig, fm = gid * WGM, gsz = (nM - fm) < WGM ? (nM - fm) : WGM;
    pm = fm + ((wgid % nig) % gsz); pn = (wgid % nig) / gsz;
}

template <class Epi, class Sched, bool GATHER, bool DYN = false>
__device__ __forceinline__ void gemm_phase(LAS unsigned char* lds, const Sched& S, const Epi& E, int wave0) {
    int tid_ = tid_of(wave0); asm volatile("" : "+v"(tid_));
    const int tid = tid_, wid = __builtin_amdgcn_readfirstlane(tid >> 6), lane = tid & 63, wr = wid >> 2, wc = wid & 3, fr = lane & 15, fq = lane >> 4;
    unsigned voffB[2], cvA[2][2], nvA[2][2]; int rA[2]; unsigned cC[2];
#pragma unroll
    for (int i = 0; i < 2; ++i) { int R, C; stage_rc(tid * 16 + i * 8192, R, C); const int Rb = (R & ~31) + perm32(R & 31);
        voffB[i] = (unsigned)Rb * PITCH + (unsigned)C * 2u; rA[i] = R; cC[i] = (unsigned)C * 2u;
        cvA[0][i] = (unsigned)R * PITCH + cC[i]; cvA[1][i] = cvA[0][i] + HSTEP; nvA[0][i] = cvA[0][i]; nvA[1][i] = cvA[1][i]; }
    const unsigned ldsw = (unsigned)wid * 1024u;
    const int aoff = lds_byte(wr * 64 + fr, fq * 8), boff = lds_byte(wc * 32 + fr, fq * 8);
#define GM_SA(b, h) (((b) * 2 + (h)) * HTB)
#define GM_SB(b, h) ((4 + (b) * 2 + (h)) * HTB)
#define GM_STAGE(bufoff, gbase, voff) do { _Pragma("unroll") for (int _i = 0; _i < 2; ++_i) \
        __builtin_amdgcn_global_load_lds((const unsigned*)((const char*)(gbase) + (voff)[_i]), (LAS unsigned*)(lds + (bufoff) + ldsw + _i * 8192), 16, 0, 0); } while (0)
#define GM_LDA(dst, b, h) do { _Pragma("unroll") for (int m = 0; m < 4; ++m) _Pragma("unroll") for (int k = 0; k < 2; ++k) dst[m][k] = *(const LAS bf16x8*)(lds + GM_SA(b, h) + aoff + m * 2048 + k * 1024); } while (0)
#define GM_LDB(dst, b, h) do { _Pragma("unroll") for (int n = 0; n < 2; ++n) _Pragma("unroll") for (int k = 0; k < 2; ++k) dst[n][k] = *(const LAS bf16x8*)(lds + GM_SB(b, h) + boff + n * 2048 + k * 1024); } while (0)
#define GM_MMA(ai, bj, At, Bt) do { __builtin_amdgcn_s_setprio(1); _Pragma("unroll") for (int m = 0; m < 4; ++m) _Pragma("unroll") for (int n = 0; n < 2; ++n) _Pragma("unroll") for (int k = 0; k < 2; ++k) \
        acc[ai][bj][m][n] = __builtin_amdgcn_mfma_f32_16x16x32_bf16(Bt[n][k], At[m][k], acc[ai][bj][m][n], 0, 0, 0); __builtin_amdgcn_s_setprio(0); } while (0)
#define GM_WAIT_V(n) asm volatile("s_waitcnt vmcnt(" #n ")" ::: "memory")
#define GM_WAIT_VE() asm volatile("s_waitcnt vmcnt(%0)" :: "n"(8 + Epi::MIN_VMEM) : "memory")
#define GM_WAIT_L(n) asm volatile("s_waitcnt lgkmcnt(" #n ")" ::: "memory")
#define GM_BAR __builtin_amdgcn_s_barrier()
#define GM_SCHED __builtin_amdgcn_sched_barrier(0)
    Unit cur, nxt; int ui = 0;
    volatile LAS int* dq = (volatile LAS int*)(lds + LDSCTL_OFF + 128);
    unsigned dtok = 0u;
    if constexpr (DYN) {
        __syncthreads();
        if (tid == 0) { unsigned* q = S.draw_ptr(); dq[0] = (int)__hip_atomic_fetch_add(q, 1u, RLX_AGENT); dq[1] = (int)__hip_atomic_fetch_add(q, 1u, RLX_AGENT); }
        __syncthreads();
        if (!S.next(__builtin_amdgcn_readfirstlane(dq[0]), cur)) return;
    } else {
        if (!S.next(0, cur)) return;
    }
    f32x4 acc[2][2][4][2];
#pragma unroll
    for (int a = 0; a < 2; ++a)
#pragma unroll
        for (int b = 0; b < 2; ++b)
#pragma unroll
            for (int m = 0; m < 4; ++m)
#pragma unroll
                for (int n = 0; n < 2; ++n) acc[a][b][m][n] = (f32x4){0.f, 0.f, 0.f, 0.f};
    bf16x8 At[4][2], B0[2][2], B1[2][2];
    const char* cA = cur.A; const char* cB = cur.B;
    if constexpr (GATHER) {
#pragma unroll
        for (int h = 0; h < 2; ++h)
#pragma unroll
            for (int i = 0; i < 2; ++i) cvA[h][i] = S.row_off(cur, h * HALF + rA[i]) + cC[i];
    }
    GM_STAGE(GM_SB(0, 0), cB, voffB); GM_STAGE(GM_SB(0, 1), cB + HSTEP, voffB); GM_STAGE(GM_SA(0, 0), cA, cvA[0]); GM_STAGE(GM_SA(0, 1), cA, cvA[1]);
    if (wr == 1) GM_BAR;
    GM_WAIT_V(2); GM_BAR;
    GM_STAGE(GM_SB(1, 0), cB + KSTEP, voffB); GM_STAGE(GM_SA(1, 0), cA + KSTEP, cvA[0]); GM_STAGE(GM_SB(1, 1), cB + HSTEP + KSTEP, voffB);
    GM_WAIT_V(6); GM_BAR;
    for (;;) {
        bool has_next;
        if constexpr (DYN) {
            has_next = S.next(__builtin_amdgcn_readfirstlane(dq[(ui + 1) & 1]), nxt);
            if (tid == 0) { unsigned* q = S.draw_ptr(); const unsigned one = 1u; asm volatile("global_atomic_add %0, %1, %2, off sc0" : "=v"(dtok) : "v"(q), "v"(one) : "memory"); }
        } else has_next = S.next(ui + 1, nxt);
        const char* nA = has_next ? nxt.A : cA; const char* nB = has_next ? nxt.B : cB;
        if constexpr (GATHER) {
            if (has_next) {
#pragma unroll
                for (int h = 0; h < 2; ++h)
#pragma unroll
                    for (int i = 0; i < 2; ++i) nvA[h][i] = S.row_off(nxt, h * HALF + rA[i]) + cC[i];
            } else {
#pragma unroll
                for (int h = 0; h < 2; ++h)
#pragma unroll
                    for (int i = 0; i < 2; ++i) nvA[h][i] = cvA[h][i];
            }
        }
        const int nt = cur.nt;
        for (int t = 0; t < nt; t += 2) {
            const bool last = (t == nt - 2);
            if constexpr (DYN) { if (last && tid == 0) dq[ui & 1] = (int)dtok; }
            const char* a1 = cA + (size_t)(t + 1) * KSTEP;
            const char* a2 = last ? nA : cA + (size_t)(t + 2) * KSTEP; const char* b2 = last ? nB : cB + (size_t)(t + 2) * KSTEP;
            const char* a3 = a2 + KSTEP; const char* b3 = b2 + KSTEP;
            unsigned o0[2], o1[2];
            if constexpr (GATHER) { o0[0] = last ? nvA[0][0] : cvA[0][0]; o0[1] = last ? nvA[0][1] : cvA[0][1]; o1[0] = last ? nvA[1][0] : cvA[1][0]; o1[1] = last ? nvA[1][1] : cvA[1][1]; }
            else { o0[0] = cvA[0][0]; o0[1] = cvA[0][1]; o1[0] = cvA[1][0]; o1[1] = cvA[1][1]; }
            GM_LDB(B0, 0, 0); GM_LDB(B1, 0, 1); GM_SCHED; GM_LDA(At, 0, 0); GM_STAGE(GM_SA(1, 1), a1, cvA[1]);
            GM_WAIT_V(8); GM_WAIT_L(0); GM_BAR; GM_MMA(0, 0, At, B0); GM_MMA(0, 1, At, B1); GM_BAR; GM_SCHED;
            GM_LDA(At, 0, 1); GM_STAGE(GM_SB(0, 0), b2, voffB); GM_STAGE(GM_SB(0, 1), b2 + HSTEP, voffB); GM_STAGE(GM_SA(0, 0), a2, o0);
            GM_WAIT_V(8); GM_WAIT_L(0); GM_BAR; GM_MMA(1, 0, At, B0); GM_MMA(1, 1, At, B1); GM_BAR; GM_SCHED;
            GM_LDB(B0, 1, 0); GM_LDB(B1, 1, 1); GM_SCHED; GM_LDA(At, 1, 0); GM_STAGE(GM_SA(0, 1), a2, o1);
            GM_WAIT_V(8); GM_WAIT_L(0); GM_BAR; GM_MMA(0, 0, At, B0); GM_MMA(0, 1, At, B1); GM_BAR; GM_SCHED;
            GM_LDA(At, 1, 1); GM_STAGE(GM_SB(1, 0), b3, voffB); GM_STAGE(GM_SB(1, 1), b3 + HSTEP, voffB); GM_STAGE(GM_SA(1, 0), a3, o0);
            GM_WAIT_V(8); GM_WAIT_L(0); GM_BAR; GM_MMA(1, 0, At, B0); GM_MMA(1, 1, At, B1); GM_BAR; GM_SCHED;
        }
        if (wr == 0) GM_BAR;
        E(acc, cur, wr, wc, fr, fq);
        if (!has_next) break;
#pragma unroll
        for (int a = 0; a < 2; ++a)
#pragma unroll
            for (int b = 0; b < 2; ++b)
#pragma unroll
                for (int m = 0; m < 4; ++m)
#pragma unroll
                    for (int n = 0; n < 2; ++n) acc[a][b][m][n] = (f32x4){0.f, 0.f, 0.f, 0.f};
        cur = nxt; cA = nA; cB = nB; ++ui;
        if constexpr (GATHER) {
#pragma unroll
            for (int h = 0; h < 2; ++h)
#pragma unroll
                for (int i = 0; i < 2; ++i) cvA[h][i] = nvA[h][i];
        }
        if (wr == 1) GM_BAR;
    }
    GM_WAIT_V(0);
    GM_BAR;
#undef GM_SA
#undef GM_SB
#undef GM_STAGE
#undef GM_LDA
#undef GM_LDB
#undef GM_MMA
#undef GM_WAIT_V
#undef GM_WAIT_VE
#undef GM_WAIT_L
#undef GM_BAR
#undef GM_SCHED
}
}

struct Args { const float* in[23]; float* out; unsigned char* ws; int ph_lo, ph_hi; };
struct Frame {
    LAS unsigned char* lds;
    unsigned* ctl;
    unsigned char* ws;
    int tid, lane, wave, G, bid, wave0;
    const Args* a;
};
#define FIN(i) (F.a->in[i])
#define FRESH_IDS(F) do { int t_ = tid_of((F).wave0); asm volatile("" : "+v"(t_)); (F).tid = t_; (F).lane = t_ & 63; (F).wave = __builtin_amdgcn_readfirstlane(t_ >> 6); } while (0)
#define WSP(T, off) ((T*)(F.ws + (off)))

template <class T> __device__ __forceinline__ T ldg(const void* base, unsigned off) { return *(const T*)((const char*)base + off); }
template <class T> __device__ __forceinline__ void stg(void* base, unsigned off, T v) { *(T*)((char*)base + off) = v; }
typedef f32x4 Acc[2][2][4][2];

struct EpiZ {
    static constexpr int MIN_VMEM = 16;
    bf16* Z; bf16* VT; float* vss;
    __device__ __forceinline__ void operator()(const Acc& acc, const gm::Unit& u, int wr, int wc, int fr, int fq) const {
        asm volatile("" : "+v"(fr), "+v"(fq));
        if (u.kind == 1) {
            bf16* base = VT + (size_t)((u.pn - 4) * 256) * NTOK + u.pm * 256; const unsigned lo = ((unsigned)(wr * 64 + fr) * NTOK + wc * 32 + 8 * fq) * 2u;
            float ss[2][8];
#pragma unroll
            for (int bj = 0; bj < 2; ++bj)
#pragma unroll
                for (int j = 0; j < 8; ++j) ss[bj][j] = 0.f;
#pragma unroll
            for (int ai = 0; ai < 2; ++ai)
#pragma unroll
                for (int m = 0; m < 4; ++m) {
#pragma unroll
                    for (int bj = 0; bj < 2; ++bj) { float v[8];
#pragma unroll
                        for (int j = 0; j < 8; ++j) { v[j] = gelu_tanh(acc[ai][bj][m][j >> 2][j & 3]); ss[bj][j] += v[j] * v[j]; }
                        u32x4 w; w.x = cvt_pk_bf16(v[0], v[1]); w.y = cvt_pk_bf16(v[2], v[3]); w.z = cvt_pk_bf16(v[4], v[5]); w.w = cvt_pk_bf16(v[6], v[7]);
                        stg<u32x4>(base, lo + (unsigned)((ai * 128 + m * 16) * NTOK + bj * 128) * 2u, w); }
                    asm volatile("" ::: "memory"); __builtin_amdgcn_sched_barrier(0); }
            float* vb = vss + u.pm * 256; const unsigned vo = (unsigned)(wc * 32 + 8 * fq) * 4u;
#pragma unroll
            for (int bj = 0; bj < 2; ++bj)
#pragma unroll
                for (int j = 0; j < 8; ++j) { float sv = ss[bj][j]; sv += __shfl_xor(sv, 1); sv += __shfl_xor(sv, 2); sv += __shfl_xor(sv, 4); sv += __shfl_xor(sv, 8); ss[bj][j] = sv; }
            if (fr == 0) {
#pragma unroll
                for (int bj = 0; bj < 2; ++bj)
#pragma unroll
                    for (int j = 0; j < 8; ++j) atomicAdd((float*)((char*)vb + vo + (bj * 128 + j) * 4), ss[bj][j]); }
        } else if (u.kind == 4) {
            const int j = u.pn < 16 ? u.pn - 12 : u.pn - 16;
            bf16* base = Z + (size_t)(u.pm * 256) * INC + Z_X + 128 * j; const unsigned lo = ((unsigned)(wr * 64 + fr) * INC + wc * 32 + 8 * fq) * 2u;
#pragma unroll
            for (int ai = 0; ai < 2; ++ai)
#pragma unroll
                for (int m = 0; m < 4; ++m) { const f32x4 o0 = acc[ai][0][m][0] * acc[ai][1][m][0], o1 = acc[ai][0][m][1] * acc[ai][1][m][1];
                    u32x4 w; w.x = cvt_pk_bf16(o0[0], o0[1]); w.y = cvt_pk_bf16(o0[2], o0[3]); w.z = cvt_pk_bf16(o1[0], o1[1]); w.w = cvt_pk_bf16(o1[2], o1[3]);
                    stg<u32x4>(base, lo + (unsigned)((ai * 128 + m * 16) * INC) * 2u, w); }
        } else if (u.kind == 0) rowmajor<0>(acc, u, wr, wc, fr, fq);
        else if (u.kind == 3) rowmajor<3>(acc, u, wr, wc, fr, fq);
        else rowmajor<2>(acc, u, wr, wc, fr, fq);
    }
    template <int KIND> __device__ __forceinline__ void rowmajor(const Acc& acc, const gm::Unit& u, int wr, int wc, int fr, int fq) const {
        bf16* base = Z + (size_t)(u.pm * 256) * INC + u.pn * 256; const unsigned lo = ((unsigned)(wr * 64 + fr) * INC + wc * 32 + 8 * fq) * 2u;
#pragma unroll
        for (int ai = 0; ai < 2; ++ai)
#pragma unroll
            for (int m = 0; m < 4; ++m) {
#pragma unroll
                for (int bj = 0; bj < 2; ++bj) { float v[8];
#pragma unroll
                    for (int j = 0; j < 8; ++j) { const float a = acc[ai][bj][m][j >> 2][j & 3]; v[j] = KIND == 0 ? gelu_tanh(a) : (KIND == 3 ? sigmoidf_fast(a) : a); }
                    u32x4 w; w.x = cvt_pk_bf16(v[0], v[1]); w.y = cvt_pk_bf16(v[2], v[3]); w.z = cvt_pk_bf16(v[4], v[5]); w.w = cvt_pk_bf16(v[6], v[7]);
                    stg<u32x4>(base, lo + (unsigned)((ai * 128 + m * 16) * INC + bj * 128) * 2u, w); }
                asm volatile("" ::: "memory"); __builtin_amdgcn_sched_barrier(0); }
    }
};
struct SchedZ {
    int G, c; const char* H; const char* W; unsigned* q;
    __device__ __forceinline__ unsigned* draw_ptr() const { return q + 16 * (c & 7); }
    __device__ __forceinline__ bool next(int j, gm::Unit& u) const {
        const int L = 8 * j + (c & 7); if (j < 0 || L >= 128 * 36) return false;
        int pm, pn; gm::tile_map(L, 128, 36, pm, pn);
        u.pm = pm; u.pn = pn; u.nt = 16; u.aux = 0;
        if (pn >= 4 && pn < 8) { u.A = W + (size_t)pn * gm::TSTEP; u.B = H + (size_t)pm * gm::TSTEP; u.kind = 1; }
        else { u.A = H + (size_t)pm * gm::TSTEP; u.B = W + (size_t)pn * gm::TSTEP; u.kind = pn < 4 ? 0 : (pn >= 24 ? 3 : (((pn >= 12 && pn < 16) || (pn >= 20 && pn < 24)) ? 4 : 2)); }
        return true;
    }
    __device__ __forceinline__ unsigned row_off(const gm::Unit&, int) const { return 0u; }
};

struct EpiMix {
    static constexpr int MIN_VMEM = 16;
    const bf16* Z; bf16* MIX; const float* pscale;
    __device__ __forceinline__ void operator()(const Acc& acc, const gm::Unit& u, int wr, int wc, int fr, int fq) const {
        asm volatile("" : "+v"(fr), "+v"(fq));
        if (u.kind == 0) body<0>(acc, u, wr, wc, fr, fq); else if (u.kind == 1) body<1>(acc, u, wr, wc, fr, fq); else body<2>(acc, u, wr, wc, fr, fq);
    }
    template <int KIND> __device__ __forceinline__ void body(const Acc& acc, const gm::Unit& u, int wr, int wc, int fr, int fq) const {
        const int lr = wr * 64 + fr, lc = wc * 32 + 8 * fq;
        const bf16* zb = Z + (size_t)(u.pm * 256) * INC + (KIND == 0 ? Z_GA : (KIND == 1 ? Z_GC : Z_GB)) + u.pn * 256; const unsigned zo = ((unsigned)lr * INC + lc) * 2u;
        bf16* xb = MIX + (size_t)(u.pm * 256) * D + u.pn * 256; const unsigned xo = ((unsigned)lr * D + lc) * 2u;
        f32x4 ps[2][2];
#pragma unroll
        for (int bj = 0; bj < 2; ++bj)
#pragma unroll
            for (int n = 0; n < 2; ++n) ps[bj][n] = KIND == 2 ? ldg<f32x4>(pscale + u.pn * 256, (unsigned)(lc + bj * 128 + 4 * n) * 4u) : (f32x4){1.f, 1.f, 1.f, 1.f};
#pragma unroll
        for (int ai = 0; ai < 2; ++ai)
#pragma unroll
          for (int mp = 0; mp < 2; ++mp) {
            u32x4 gw[2][2], mw[2][2];
#pragma unroll
            for (int mm = 0; mm < 2; ++mm)
#pragma unroll
                for (int bj = 0; bj < 2; ++bj) { const unsigned ro = (unsigned)(ai * 128 + (2 * mp + mm) * 16);
                    gw[mm][bj] = ldg<u32x4>(zb, zo + (ro * INC + bj * 128) * 2u);
                    if (KIND != 0) mw[mm][bj] = ldg<u32x4>(xb, xo + (ro * D + bj * 128) * 2u); else mw[mm][bj] = (u32x4){0u, 0u, 0u, 0u}; }
#pragma unroll
            for (int mm = 0; mm < 2; ++mm)
#pragma unroll
                for (int bj = 0; bj < 2; ++bj) { const int m = 2 * mp + mm; const unsigned ro = (unsigned)(ai * 128 + m * 16); const u32x4 g = gw[mm][bj], q = mw[mm][bj];
                    f32x4 g0 = {bflo(g.x), bfhi(g.x), bflo(g.y), bfhi(g.y)}, g1 = {bflo(g.z), bfhi(g.z), bflo(g.w), bfhi(g.w)};
                    if (KIND == 2) { g0 *= ps[bj][0]; g1 *= ps[bj][1]; }
                    const f32x4 o0 = g0 * acc[ai][bj][m][0] + (f32x4){bflo(q.x), bfhi(q.x), bflo(q.y), bfhi(q.y)}, o1 = g1 * acc[ai][bj][m][1] + (f32x4){bflo(q.z), bfhi(q.z), bflo(q.w), bfhi(q.w)};
                    u32x4 w; w.x = cvt_pk_bf16(o0[0], o0[1]); w.y = cvt_pk_bf16(o0[2], o0[3]); w.z = cvt_pk_bf16(o1[0], o1[1]); w.w = cvt_pk_bf16(o1[2], o1[3]);
                    stg<u32x4>(xb, xo + (ro * D + bj * 128) * 2u, w); }
            asm volatile("" ::: "memory");
          }
    }
};
struct SchedMix {
    int G, c; const char *AIN, *CIN, *PIN, *WA, *WC, *WP;
    __device__ __forceinline__ bool next(int i, gm::Unit& u) const {
        const int rnd = i / 3, ty = i - rnd * 3; const int L = rnd * G + c; if (L >= 128 * 4) return false;
        int pm, pn; gm::tile_map(L, 128, 4, pm, pn);
        u.pm = pm; u.pn = pn; u.kind = ty; u.aux = 0;
        if (ty == 0) { u.A = AIN + (size_t)pm * gm::TSTEP; u.B = WA + (size_t)pn * gm::TSTEP; u.nt = 16; }
        else if (ty == 1) { u.A = CIN + (size_t)pm * gm::TSTEP; u.B = WC + (size_t)pn * gm::TSTEP; u.nt = 16; }
        else { u.A = PIN + (size_t)pm * gm::TSTEP + pn * 512; u.B = WP + (size_t)pn * gm::TSTEP + pn * 512; u.nt = 4; }
        return true;
    }
    __device__ __forceinline__ unsigned row_off(const gm::Unit&, int) const { return 0u; }
};

template <bool XF32> struct EpiOut {
    static constexpr bool CHAIN = false;
    const void* xin; bf16* xout; const float* g1;
    __device__ __forceinline__ void operator()(const Acc& acc, const gm::Unit& u, int wr, int wc, int fr, int fq) const {
        asm volatile("" : "+v"(fr), "+v"(fq));
        const int lr = wr * 64 + fr, lc = wc * 32 + 8 * fq; const int b = u.pm / 16;
        bf16* ob = xout + (size_t)(u.pm * 256) * D + u.pn * 256; const unsigned xo = ((unsigned)lr * D + lc) * 2u;
        f32x4 gv[2][2];
#pragma unroll
        for (int bj = 0; bj < 2; ++bj)
#pragma unroll
            for (int n = 0; n < 2; ++n) gv[bj][n] = ldg<f32x4>(g1 + (size_t)b * 6 * D + u.pn * 256, (unsigned)(lc + bj * 128 + 4 * n) * 4u);
        if constexpr (XF32) {
            const float* ib = (const float*)xin + (size_t)(u.pm * 256) * D + u.pn * 256;
#pragma unroll
            for (int ai = 0; ai < 2; ++ai)
#pragma unroll
                for (int mp = 0; mp < 2; ++mp) {
                    f32x4 xv[2][2][2];
#pragma unroll
                    for (int mm = 0; mm < 2; ++mm)
#pragma unroll
                        for (int bj = 0; bj < 2; ++bj) { const unsigned o = 2u * xo + ((unsigned)(ai * 128 + (2 * mp + mm) * 16) * D + bj * 128) * 4u; xv[mm][bj][0] = ldg<f32x4>(ib, o); xv[mm][bj][1] = ldg<f32x4>(ib, o + 16u); }
#pragma unroll
                    for (int mm = 0; mm < 2; ++mm)
#pragma unroll
                        for (int bj = 0; bj < 2; ++bj) { const int m = 2 * mp + mm; const f32x4 o0 = xv[mm][bj][0] + gv[bj][0] * acc[ai][bj][m][0], o1 = xv[mm][bj][1] + gv[bj][1] * acc[ai][bj][m][1];
                            u32x4 w; w.x = cvt_pk_bf16(o0[0], o0[1]); w.y = cvt_pk_bf16(o0[2], o0[3]); w.z = cvt_pk_bf16(o1[0], o1[1]); w.w = cvt_pk_bf16(o1[2], o1[3]);
                            stg<u32x4>(ob, xo + ((unsigned)(ai * 128 + m * 16) * D + bj * 128) * 2u, w); }
                    asm volatile("" ::: "memory");
                }
        } else {
            const bf16* ib = (const bf16*)xin + (size_t)(u.pm * 256) * D + u.pn * 256;
#pragma unroll
            for (int ai = 0; ai < 2; ++ai) {
                u32x4 xv[4][2];
#pragma unroll
                for (int m = 0; m < 4; ++m)
#pragma unroll
                    for (int bj = 0; bj < 2; ++bj) xv[m][bj] = ldg<u32x4>(ib, xo + ((unsigned)(ai * 128 + m * 16) * D + bj * 128) * 2u);
#pragma unroll
                for (int m = 0; m < 4; ++m)
#pragma unroll
                    for (int bj = 0; bj < 2; ++bj) { const u32x4 q = xv[m][bj];
                        const f32x4 o0 = (f32x4){bflo(q.x), bfhi(q.x), bflo(q.y), bfhi(q.y)} + gv[bj][0] * acc[ai][bj][m][0], o1 = (f32x4){bflo(q.z), bfhi(q.z), bflo(q.w), bfhi(q.w)} + gv[bj][1] * acc[ai][bj][m][1];
                        u32x4 w; w.x = cvt_pk_bf16(o0[0], o0[1]); w.y = cvt_pk_bf16(o0[2], o0[3]); w.z = cvt_pk_bf16(o1[0], o1[1]); w.w = cvt_pk_bf16(o1[2], o1[3]);
                        stg<u32x4>(ob, xo + ((unsigned)(ai * 128 + m * 16) * D + bj * 128) * 2u, w); }
                asm volatile("" ::: "memory");
            }
        }
    }
};
struct SchedOut {
    int G, c; const char *MIXP, *WO;
    __device__ __forceinline__ bool next(int i, gm::Unit& u) const {
        const int L = i * G + c; if (L >= 128 * 4) return false;
        int pm, pn; gm::tile_map(L, 128, 4, pm, pn);
        u.pm = pm; u.pn = pn; u.kind = 0; u.aux = 0; u.nt = 16; u.A = MIXP + (size_t)pm * gm::TSTEP; u.B = WO + (size_t)pn * gm::TSTEP;
        return true;
    }
    __device__ __forceinline__ unsigned row_off(const gm::Unit&, int) const { return 0u; }
};

struct SchedMoe {
    int NG, r, x, npn; const LAS int* tb;
    const char* Abase; const char* Wbase; unsigned wstride;
    const int* LIST; bool gather;
    __device__ __forceinline__ bool next(int i, gm::Unit& u) const {
        const int j = i * NG + r; int mt = j / npn; const int pn = j - mt * npn;
#define TB(i) __builtin_amdgcn_readfirstlane(tb[i])
        int e = x; int T = TB(e);
        if (mt >= T) { mt -= T; e += 8; T = TB(e);
            if (mt >= T) { mt -= T; e += 8; T = TB(e);
                if (mt >= T) { mt -= T; e += 8; T = TB(e); if (mt >= T) return false; } } }
        u.aux = e; u.pn = pn; u.nt = 16; u.kind = TB(64 + e) - 256 * mt;
        const int arow = TB(32 + e) + 256 * mt;
        if (gather) { u.A = Abase; u.pm = arow; u.B = Wbase + (size_t)e * wstride + (size_t)pn * gm::TSTEP; }
        else { u.A = Abase + (size_t)arow * gm::PITCH; u.pm = 256 * mt; u.B = Wbase + (size_t)e * wstride + (size_t)pn * gm::TSTEP; }
        return true;
    }
    __device__ __forceinline__ unsigned row_off(const gm::Unit& u, int rr) const {
        const int mt256 = u.pm - TB(32 + u.aux);
        int slot = LIST[(size_t)u.aux * NTOK + mt256 + rr]; slot = (rr < u.kind) ? slot : 0;
        return (unsigned)(slot >> 2) * gm::PITCH;
    }
};
struct EpiGU {
    static constexpr int MIN_VMEM = 8;
    bf16* ACT; const float* bgu;
    __device__ __forceinline__ void operator()(const Acc& acc, const gm::Unit& u, int wr, int wc, int fr, int fq) const {
        asm volatile("" : "+v"(fr), "+v"(fq));
        const int e = u.aux, lc = wc * 32 + 8 * fq;
        bf16* ab = ACT + (size_t)u.pm * FF + u.pn * 128; const unsigned ao = ((unsigned)(wr * 64 + fr) * FF + lc) * 2u;
        const float* bb = bgu + (size_t)e * 2 * FF + u.pn * 128;
        f32x4 bg[2], bu[2];
#pragma unroll
        for (int n = 0; n < 2; ++n) { bg[n] = ldg<f32x4>(bb, (unsigned)(lc + 4 * n) * 4u); bu[n] = ldg<f32x4>(bb + FF, (unsigned)(lc + 4 * n) * 4u); }
#pragma unroll
        for (int ai = 0; ai < 2; ++ai)
#pragma unroll
            for (int m = 0; m < 4; ++m) { float o[8];
#pragma unroll
                for (int j = 0; j < 8; ++j) { float g = acc[ai][0][m][j >> 2][j & 3] + bg[j >> 2][j & 3], up = acc[ai][1][m][j >> 2][j & 3] + bu[j >> 2][j & 3];
                    g = fminf(g, 7.0f); up = fminf(fmaxf(up, -7.0f), 7.0f);
                    const float glu = g * __builtin_amdgcn_rcpf(1.0f + __builtin_amdgcn_exp2f(-1.702f * 1.44269504089f * g));
                    o[j] = (up + 1.0f) * glu; }
                u32x4 w; w.x = cvt_pk_bf16(o[0], o[1]); w.y = cvt_pk_bf16(o[2], o[3]); w.z = cvt_pk_bf16(o[4], o[5]); w.w = cvt_pk_bf16(o[6], o[7]);
                stg<u32x4>(ab, ao + (unsigned)((ai * 128 + m * 16) * FF) * 2u, w);
                asm volatile("" ::: "memory"); }
    }
};
struct EpiDown {
    static constexpr int MIN_VMEM = 16;
    bf16* YB; const float* bdn; const int* LIST; const float* WL;
    __device__ __forceinline__ void operator()(const Acc& acc, const gm::Unit& u, int wr, int wc, int fr, int fq) const {
        asm volatile("" : "+v"(fr), "+v"(fq));
        const int e = u.aux, lc = wc * 32 + 8 * fq, nvalid = u.kind, lr = wr * 64 + fr;
        const int* lb = LIST + (size_t)e * NTOK + u.pm; const float* wb = WL + (size_t)e * NTOK + u.pm;
        bf16* yb = YB + u.pn * 256; const float* bb = bdn + (size_t)e * D + u.pn * 256;
        f32x4 bd[2][2];
#pragma unroll
        for (int bj = 0; bj < 2; ++bj)
#pragma unroll
            for (int n = 0; n < 2; ++n) bd[bj][n] = ldg<f32x4>(bb, (unsigned)(lc + bj * 128 + 4 * n) * 4u);
        int slots[2][4]; float wts[2][4];
#pragma unroll
        for (int ai = 0; ai < 2; ++ai)
#pragma unroll
            for (int m = 0; m < 4; ++m) { const unsigned r = (unsigned)(lr + ai * 128 + m * 16); slots[ai][m] = ldg<int>(lb, r * 4u); wts[ai][m] = ldg<float>(wb, r * 4u); }
#pragma unroll
        for (int ai = 0; ai < 2; ++ai)
#pragma unroll
            for (int m = 0; m < 4; ++m) { const int r = lr + ai * 128 + m * 16;
                const unsigned slot = (r < nvalid) ? (unsigned)slots[ai][m] : (unsigned)(NTOK * TOPK); const float w = (r < nvalid) ? wts[ai][m] : 0.f;
#pragma unroll
                for (int bj = 0; bj < 2; ++bj) { const f32x4 y0 = (acc[ai][bj][m][0] + bd[bj][0]) * w, y1 = (acc[ai][bj][m][1] + bd[bj][1]) * w;
                    u32x4 o; o.x = cvt_pk_bf16(y0[0], y0[1]); o.y = cvt_pk_bf16(y0[2], y0[3]); o.z = cvt_pk_bf16(y1[0], y1[1]); o.w = cvt_pk_bf16(y1[2], y1[3]);
                    stg<u32x4>(yb, (slot * D + lc + bj * 128) * 2u, o); }
                asm volatile("" ::: "memory"); }
    }
};

__device__ __forceinline__ void tt_load(f32x4 (&tv)[16], const float* W, int N, int k0, int n0, int lane) {
#pragma unroll
    for (int i = 0; i < 16; ++i) tv[i] = ldg<f32x4>(W + (size_t)k0 * N + n0, ((unsigned)(i * 4 + (lane >> 4)) * (unsigned)N + 4u * (lane & 15)) * 4u);
}
__device__ __forceinline__ void tt_store(const f32x4 (&tv)[16], int k0, int n0, bf16* WT, int drow0, int dcol0, LAS float* scr, int lane) {
#pragma unroll
    for (int i = 0; i < 16; ++i) { const int kk = i * 4 + (lane >> 4); LAS float* p = scr + kk * 65 + 4 * (lane & 15); p[0] = tv[i].x; p[1] = tv[i].y; p[2] = tv[i].z; p[3] = tv[i].w; }
    asm volatile("s_waitcnt lgkmcnt(0)" ::: "memory");
    const int c = lane & 7;
#pragma unroll
    for (int j = 0; j < 8; ++j) { const int n = (lane >> 3) + 8 * j; const LAS float* s = scr + (8 * c) * 65 + n;
        u32x4 o; o.x = cvt_pk_bf16(s[0 * 65], s[1 * 65]); o.y = cvt_pk_bf16(s[2 * 65], s[3 * 65]); o.z = cvt_pk_bf16(s[4 * 65], s[5 * 65]); o.w = cvt_pk_bf16(s[6 * 65], s[7 * 65]);
        stg<u32x4>(WT + (size_t)(drow0 + n0) * 1024 + dcol0 + k0, ((unsigned)n * 1024u + 8u * c) * 2u, o);
        if (j & 1) __builtin_amdgcn_sched_barrier(0); }
    asm volatile("s_waitcnt lgkmcnt(0)" ::: "memory");
}
struct P0Item { const float* W; bf16* WT; int N, k0, n0, drow0, dcol0; };
__device__ __forceinline__ P0Item p0_decode(Frame& F, int it) {
    constexpr int I_GU = 16 * 32, I_DN = 16 * 16, I_IN = 16 * 144, I_SQ = 16 * 16, I_PL = 4 * 4;
    constexpr int N_GU = DEPTH * NE * I_GU, N_DN = DEPTH * NE * I_DN, N_IN = DEPTH * I_IN, N_SQ = DEPTH * I_SQ;
    P0Item t; t.dcol0 = 0; t.drow0 = 0;
    int r = it;
    if (r < N_GU) { const int mat = r / I_GU, q = r % I_GU, kb = q / 32, nb = q % 32, n0 = 64 * nb, half = n0 / FF, f0 = n0 % FF;
        t.W = FIN(18) + (size_t)mat * D * 2 * FF; t.N = 2 * FF; t.k0 = 64 * kb; t.n0 = n0; t.WT = WSP(bf16, WS_WTGU) + (size_t)mat * 2 * FF * D; t.drow0 = (f0 / 128) * 256 + 128 * half + (f0 % 128) - n0; return t; }
    r -= N_GU;
    if (r < N_DN) { const int mat = r / I_DN, q = r % I_DN, kb = q / 16, nb = q % 16;
        t.W = FIN(20) + (size_t)mat * FF * D; t.N = D; t.k0 = 64 * kb; t.n0 = 64 * nb; t.WT = WSP(bf16, WS_WTDN) + (size_t)mat * D * FF; return t; }
    r -= N_DN;
    if (r < N_IN) { const int mat = r / I_IN, q = r % I_IN, kb = q / 144, nb = q % 144;
        const int n0 = 64 * nb; int dr = n0;
        if (n0 >= Z_X && n0 < Z_X + D) { const int f = n0 - Z_X, j = f >> 7; dr = (j < 4 ? 12 + j : 16 + j) * 256 + (f & 127); }
        else if (n0 >= Z_C && n0 < Z_C + D) { const int f = n0 - Z_C, j = f >> 7; dr = (j < 4 ? 12 + j : 16 + j) * 256 + 128 + (f & 127); }
        t.W = FIN(5) + (size_t)mat * D * INC; t.N = INC; t.k0 = 64 * kb; t.n0 = n0; t.WT = WSP(bf16, WS_WTIN) + (size_t)mat * INC * D; t.drow0 = dr - n0; return t; }
    r -= N_IN;
    if (r < 3 * N_SQ) { const int which = r / N_SQ, q2 = r % N_SQ, mat = q2 / I_SQ, q = q2 % I_SQ, kb = q / 16, nb = q % 16;
        t.W = (which == 0 ? FIN(9) : (which == 1 ? FIN(13) : FIN(14))) + (size_t)mat * D * D;
        t.WT = WSP(bf16, which == 0 ? WS_WTA : (which == 1 ? WS_WTC : WS_WTO)) + (size_t)mat * D * D;
        t.N = D; t.k0 = 64 * kb; t.n0 = 64 * nb; return t; }
    r -= 3 * N_SQ;
    { const int mat = r / I_PL, q = r % I_PL, kb = q / 4, nb = q % 4, l = mat / 4, g = mat % 4;
        t.W = FIN(10) + (size_t)mat * 256 * 256; t.N = 256; t.k0 = 64 * kb; t.n0 = 64 * nb; t.WT = WSP(bf16, WS_WTPOOL) + (size_t)l * D * D; t.drow0 = g * 256; t.dcol0 = g * 256; }
    return t;
}
template <int MODE>
__device__ __forceinline__ void convert_items(Frame& F, unsigned* ctr, int l) {
    constexpr int I_GU = 16 * 32, I_DN = 16 * 16, I_IN = 16 * 144, I_SQ = 16 * 16, I_PL = 4 * 4;
    constexpr int N_GU = DEPTH * NE * I_GU, N_DN = DEPTH * NE * I_DN, N_IN = DEPTH * I_IN, N_SQ = DEPTH * I_SQ, N_PL = DEPTH * 4 * I_PL;
    constexpr int NV = MODE == 0 ? N_IN + 3 * N_SQ + N_PL : (N_GU + N_DN) / DEPTH;
    static_assert(NV % 8 == 0 && (N_GU / DEPTH) % 8 == 0, "chunks of eight (a chunk is whole or absent, and of one kind)");
    FRESH_IDS(F);
    LAS float* scr = (LAS float*)(F.lds + F.wave * 16640);
    LAS int* nbs = (LAS int*)(F.lds + LDSCTL_OFF + 64);
#define CV_ITEM(v) (MODE == 0 ? N_GU + N_DN + (v) : ((v) < N_GU / DEPTH ? l * (N_GU / DEPTH) + (v) : N_GU + l * (N_DN / DEPTH) + (v) - N_GU / DEPTH))
    __syncthreads();
    if (F.tid == 0) { nbs[0] = (int)__hip_atomic_fetch_add(ctr, 8u, RLX_AGENT); nbs[1] = (int)__hip_atomic_fetch_add(ctr, 8u, RLX_AGENT); }
    __syncthreads();
    int cur = __builtin_amdgcn_readfirstlane(nbs[0]), nxt = __builtin_amdgcn_readfirstlane(nbs[1]);
    f32x4 ta[16], tb[16];
    if (cur < NV) { const P0Item t = p0_decode(F, CV_ITEM(cur + F.wave)); tt_load(ta, t.W, t.N, t.k0, t.n0, F.lane); }
#define P0_STEP(TC, TN, slot) { int nn = 0; if (F.tid == 0) nn = (int)__hip_atomic_fetch_add(ctr, 8u, RLX_AGENT); \
        if (nxt < NV) { const P0Item t = p0_decode(F, CV_ITEM(nxt + F.wave)); tt_load(TN, t.W, t.N, t.k0, t.n0, F.lane); } \
        { const P0Item t = p0_decode(F, CV_ITEM(cur + F.wave)); tt_store(TC, t.k0, t.n0, t.WT, t.drow0, t.dcol0, scr, F.lane); } \
        if (F.tid == 0) nbs[slot] = nn; \
        __syncthreads(); \
        cur = nxt; nxt = __builtin_amdgcn_readfirstlane(nbs[slot]); }
    while (cur < NV) {
        P0_STEP(ta, tb, 0)
        if (cur >= NV) break;
        P0_STEP(tb, ta, 1)
    }
#undef P0_STEP
#undef CV_ITEM
    __syncthreads();
}
__device__ __forceinline__ void p0_prologue(Frame& F) {
    FRESH_IDS(F);
    float* mods = WSP(float, WS_MODS);
    {
        LAS float* sil = (LAS float*)(F.lds + 65536);
        LAS f32x4* part = (LAS f32x4*)F.lds;
        for (int i = F.tid; i < NB * D; i += NTHREADS) { const float cv = FIN(1)[i]; sil[i] = cv * __builtin_amdgcn_rcpf(1.0f + __builtin_amdgcn_exp2f(-1.44269504089f * cv)); }
        __syncthreads();
        for (int cb = F.bid; cb < 256; cb += F.G) {
            const int l = cb >> 7, colq = F.lane % 12, rsub = F.lane / 12, cbase = (cb & 127) * 48, k0 = F.wave * 128;
            const float* aw = FIN(3) + (size_t)l * D * 6 * D + cbase;
            f32x4 a[NB];
#pragma unroll
            for (int b = 0; b < NB; ++b) a[b] = (f32x4){0.f, 0.f, 0.f, 0.f};
#pragma unroll
            for (int jb = 0; jb < 2; ++jb) { f32x4 w[13]; int kk[13];
#pragma unroll
                for (int j = 0; j < 13; ++j) { const int k = k0 + 5 * (13 * jb + j) + rsub; kk[j] = k < k0 + 128 ? k : k0 + 127; w[j] = ldg<f32x4>(aw, ((unsigned)kk[j] * (6u * D) + 4u * colq) * 4u);
                    if (!(rsub < 5 && k < k0 + 128)) w[j] = (f32x4){0.f, 0.f, 0.f, 0.f}; }
#pragma unroll
                for (int j = 0; j < 13; ++j) {
#pragma unroll
                    for (int b = 0; b < NB; ++b) a[b] += w[j] * sil[b * D + kk[j]];
                    __builtin_amdgcn_sched_barrier(0); } }
#pragma unroll
            for (int b = 0; b < NB; ++b) part[(F.wave * 64 + F.lane) * NB + b] = a[b];
            __syncthreads();
            if (F.tid < 96) { const int b = F.tid / 12, cq = F.tid % 12;
                f32x4 sum = ldg<f32x4>(FIN(4) + (size_t)l * 6 * D + cbase, (unsigned)(4 * cq) * 4u);
#pragma unroll
                for (int w = 0; w < 8; ++w) {
#pragma unroll
                    for (int rs = 0; rs < 5; ++rs) sum += part[(w * 64 + cq + 12 * rs) * NB + b];
                    __builtin_amdgcn_sched_barrier(0); }
                stg<f32x4>(mods + (size_t)l * NB * 6 * D + cbase, ((unsigned)b * (6u * D) + 4u * cq) * 4u, sum); }
            __syncthreads();
        }
    }
    {
        const int gt = F.bid * NTHREADS + F.tid, NGT = F.G * NTHREADS;
        for (int p = gt; p < DEPTH * 8 * CHUNK * 16; p += NGT) { const int kc = p & 15, t = (p >> 4) & 127, hh = p >> 11;
            const float* wrow = FIN(7) + (size_t)hh * CHUNK * CHUNK + t * CHUNK + 8 * kc;
            const f32x4 a = *(const f32x4*)wrow, c = *(const f32x4*)(wrow + 4); float v[8] = {a.x, a.y, a.z, a.w, c.x, c.y, c.z, c.w};
#pragma unroll
            for (int j = 0; j < 8; ++j) v[j] = (8 * kc + j <= t) ? v[j] : 0.f;
            u32x4 w; w.x = cvt_pk_bf16(v[0], v[1]); w.y = cvt_pk_bf16(v[2], v[3]); w.z = cvt_pk_bf16(v[4], v[5]); w.w = cvt_pk_bf16(v[6], v[7]);
            *(u32x4*)(F.ws + WS_WIMG + (size_t)hh * 32768 + t * 256 + ((kc ^ (t & 15)) << 4)) = w; }
    }
    convert_items<0>(F, F.ctl + CW_P0CTR, 0);
}

#define NCOL(j) (512 * ((j) >> 1) + 8 * lane + 4 * ((j) & 1))
struct RowBuf { f32x4 x[4]; u32x4 xb[2]; u32x4 y[2][4]; };
template <bool HASY>
__device__ __forceinline__ void row_load(RowBuf& R, const void* xin, const bf16* yb, int row, int lane) {
    if (HASY) {
#pragma unroll
        for (int jj = 0; jj < 2; ++jj) R.xb[jj] = *(const u32x4*)((const bf16*)xin + (size_t)row * D + 512 * jj + 8 * lane);
#pragma unroll
        for (int jj = 0; jj < 2; ++jj)
#pragma unroll
            for (int k = 0; k < TOPK; ++k) R.y[jj][k] = *(const u32x4*)(yb + ((size_t)row * TOPK + k) * D + 512 * jj + 8 * lane);
    } else {
#pragma unroll
        for (int j = 0; j < 4; ++j) R.x[j] = *(const f32x4*)((const float*)xin + (size_t)row * D + NCOL(j));
    }
}
__device__ __forceinline__ f32x4 unpack_half4(u32x4 w, int half) { return half ? (f32x4){bflo(w.z), bfhi(w.z), bflo(w.w), bfhi(w.w)} : (f32x4){bflo(w.x), bfhi(w.x), bflo(w.y), bfhi(w.y)}; }
template <int MODE, bool HASY>
__device__ __forceinline__ void norm_rows(Frame& F, const void* xin, const bf16* yb, const float* g2, bf16* xst, const float* gn, const float* sc, const float* sh, bf16* hout, float* fout) {
    FRESH_IDS(F);
    const int gw = F.bid * NWAVES + F.wave, NGW = F.G * NWAVES, lane = F.lane;
    f32x4 gnv[4], g2v[4], scv[4], shv[4]; int bcur = -1;
#pragma unroll
    for (int j = 0; j < 4; ++j) gnv[j] = *(const f32x4*)(gn + NCOL(j));
    RowBuf R0, R1;
    int row = gw;
    if (row < NTOK) row_load<HASY>(R0, xin, yb, row, lane);
#define NORM_PROCESS(R, row_) do { const int b = (row_) / SEQ; const size_t ro = (size_t)(row_) * D; \
        if (b != bcur) { bcur = b; _Pragma("unroll") for (int j = 0; j < 4; ++j) { const int col = NCOL(j); \
            if (HASY) g2v[j] = *(const f32x4*)(g2 + (size_t)b * 6 * D + col); \
            if (MODE == 0) { scv[j] = *(const f32x4*)(sc + (size_t)b * 6 * D + col); shv[j] = *(const f32x4*)(sh + (size_t)b * 6 * D + col); } } } \
        f32x4 v[4]; float s = 0.f; \
        _Pragma("unroll") for (int j = 0; j < 4; ++j) { \
            if (HASY) { f32x4 ys = unpack_half4((R).y[j >> 1][0], j & 1); _Pragma("unroll") for (int k = 1; k < TOPK; ++k) ys += unpack_half4((R).y[j >> 1][k], j & 1); v[j] = unpack_half4((R).xb[j >> 1], j & 1) + g2v[j] * ys; } \
            else v[j] = (R).x[j]; \
            s += (v[j].x * v[j].x + v[j].y * v[j].y) + (v[j].z * v[j].z + v[j].w * v[j].w); } \
        if (xst) { _Pragma("unroll") for (int jj = 0; jj < 2; ++jj) { u32x4 w; w.x = cvt_pk_bf16(v[2 * jj].x, v[2 * jj].y); w.y = cvt_pk_bf16(v[2 * jj].z, v[2 * jj].w); w.z = cvt_pk_bf16(v[2 * jj + 1].x, v[2 * jj + 1].y); w.w = cvt_pk_bf16(v[2 * jj + 1].z, v[2 * jj + 1].w); \
            *(u32x4*)(xst + ro + 512 * jj + 8 * lane) = w; } } \
        const float rstd = 1.0f / sqrtf(wave_sum(s) * (1.0f / D) + RMS_EPS); \
        if (MODE == 0) { _Pragma("unroll") for (int jj = 0; jj < 2; ++jj) { \
            const f32x4 o0 = v[2 * jj] * rstd * gnv[2 * jj] * (scv[2 * jj] + 1.0f) + shv[2 * jj], o1 = v[2 * jj + 1] * rstd * gnv[2 * jj + 1] * (scv[2 * jj + 1] + 1.0f) + shv[2 * jj + 1]; \
            u32x4 w; w.x = cvt_pk_bf16(o0.x, o0.y); w.y = cvt_pk_bf16(o0.z, o0.w); w.z = cvt_pk_bf16(o1.x, o1.y); w.w = cvt_pk_bf16(o1.z, o1.w); *(u32x4*)(hout + ro + 512 * jj + 8 * lane) = w; } } \
        else { _Pragma("unroll") for (int j = 0; j < 4; ++j) *(f32x4*)(fout + ro + NCOL(j)) = v[j] * rstd * gnv[j]; } } while (0)
    while (row < NTOK) {
        const int r1 = row + NGW;
        if (r1 < NTOK) row_load<HASY>(R1, xin, yb, r1, lane);
        NORM_PROCESS(R0, row);
        if (r1 >= NTOK) break;
        const int r2 = r1 + NGW;
        if (r2 < NTOK) row_load<HASY>(R0, xin, yb, r2, lane);
        NORM_PROCESS(R1, r1);
        row = r2;
    }
#undef NORM_PROCESS
#undef NCOL
}

__device__ __forceinline__ void router_prep(Frame& F) {
    FRESH_IDS(F);
    const float* mods = WSP(float, WS_MODS); bf16* rwh = WSP(bf16, WS_RWT); bf16* rwl = WSP(bf16, WS_RWT + 1 * MiB); float* rb = WSP(float, WS_RBIAS);
    const int gt = F.bid * NTHREADS + F.tid, NGT = F.G * NTHREADS;
    for (int i = gt; i < DEPTH * NB * NE * D; i += NGT) { const int k = i % D, e = (i / D) % NE, b = (i / (D * NE)) % NB, l = i / (D * NE * NB);
        const float w = FIN(15)[l * D + k] * (1.0f + mods[((size_t)l * NB + b) * 6 * D + 4 * D + k]) * FIN(16)[((size_t)l * D + k) * NE + e];
        const unsigned hi = cvt_pk_bf16(w, 0.f) & 0xffffu, lo = cvt_pk_bf16(w - __uint_as_float(hi << 16), 0.f) & 0xffffu;
        rwh[i] = (bf16)hi; rwl[i] = (bf16)lo; }
    const int gw = F.bid * NWAVES + F.wave, NGW = F.G * NWAVES;
    for (int o = gw; o < DEPTH * NB * NE; o += NGW) { const int e = o % NE, b = (o / NE) % NB, l = o / (NE * NB); float s = 0.f;
        for (int k = F.lane; k < D; k += 64) s += mods[((size_t)l * NB + b) * 6 * D + 3 * D + k] * FIN(16)[((size_t)l * D + k) * NE + e];
        s = wave_sum(s); if (F.lane == 0) rb[o] = s + FIN(17)[l * NE + e]; }
}

__device__ __forceinline__ void mixer_prep(Frame& F, int l) {
    FRESH_IDS(F);
    const bf16* Z = WSP(bf16, WS_Z); const bf16* VT = WSP(bf16, WS_VT); const float* vss = WSP(float, WS_VSS) + (size_t)l * NTOK;
    bf16* AIN = WSP(bf16, WS_AIN); bf16* CIN = WSP(bf16, WS_CIN); bf16* PIN = WSP(bf16, WS_PIN);
    const float* convw = FIN(12) + (size_t)l * 3 * D; const float* gng = FIN(6) + (size_t)l * D; const char* wimg = (const char*)(F.ws + WS_WIMG) + (size_t)l * 8 * 32768; const float* bs = FIN(8) + (size_t)l * 8 * CHUNK;
    LAS unsigned char* Abuf = F.lds; LAS unsigned char* Bimg = F.lds + 65536; LAS float* rs = (LAS float*)(F.lds + 98304);
    for (int chunk = F.bid; chunk < NTOK / CHUNK; chunk += F.G) {
        const int tok0 = chunk * CHUNK, pos0 = tok0 % SEQ;
        FRESH_IDS(F);
        int tid = F.tid, lane = F.lane, wave = F.wave;
        {
            const int cg = (wave & 1) * 64 + lane, rsq = wave >> 1, t0 = 32 * rsq; const unsigned c0b = 16u * (unsigned)cg;
            float w0[8], w1[8], w2[8];
#pragma unroll
            for (int j = 0; j < 8; ++j) { w0[j] = ldg<float>(convw, 2 * c0b + 4 * j); w1[j] = ldg<float>(convw + D, 2 * c0b + 4 * j); w2[j] = ldg<float>(convw + 2 * D, 2 * c0b + 4 * j); }
            float p2[8], p1[8];
#pragma unroll
            for (int j = 0; j < 8; ++j) { p2[j] = 0.f; p1[j] = 0.f; }
            if (pos0 + t0 >= 2) {
#pragma unroll
                for (int q = 0; q < 2; ++q) { const bf16* zr = Z + (size_t)(tok0 + t0 - 2 + q) * INC; const u32x4 xv = ldg<u32x4>(zr + Z_X, c0b);
                    const unsigned xa[4] = {xv.x, xv.y, xv.z, xv.w};
#pragma unroll
                    for (int j = 0; j < 4; ++j) { const float a = bflo(xa[j]), bq = bfhi(xa[j]);
                        if (q == 0) { p2[2 * j] = a; p2[2 * j + 1] = bq; } else { p1[2 * j] = a; p1[2 * j + 1] = bq; } } }
            }
            const int pwin = 2 << (cg >> 5);
            float sw[8];
#pragma unroll
            for (int j = 0; j < 8; ++j) sw[j] = 0.f;
            for (int q = 1; q < 16; ++q) { if (q < pwin && pos0 + t0 - q >= 0) { const u32x4 pv = ldg<u32x4>(Z + (size_t)(tok0 + t0 - q) * INC + Z_P, c0b); const unsigned pa[4] = {pv.x, pv.y, pv.z, pv.w};
#pragma unroll
                    for (int j = 0; j < 4; ++j) { sw[2 * j] += bflo(pa[j]); sw[2 * j + 1] += bfhi(pa[j]); } } }
#pragma unroll 1
            for (int tb = t0; tb < t0 + 32; tb += 4) {
                u32x4 xv4[4], bv4[4], pv4[4], qv4[4];
#pragma unroll
                for (int r = 0; r < 4; ++r) { const bf16* zr = Z + (size_t)(tok0 + tb + r) * INC; const int pos = pos0 + tb + r;
                    xv4[r] = ldg<u32x4>(zr + Z_X, c0b); bv4[r] = ldg<u32x4>(zr + Z_B, c0b); pv4[r] = ldg<u32x4>(zr + Z_P, c0b);
                    const int back = (pos - (pwin - 1) >= 0) ? (pwin - 1) : 0;
                    qv4[r] = ldg<u32x4>(zr + Z_P - (ptrdiff_t)back * INC, c0b); }
#pragma unroll
                for (int r = 0; r < 4; ++r) { const int t = tb + r, pos = pos0 + t;
                    const unsigned xa[4] = {xv4[r].x, xv4[r].y, xv4[r].z, xv4[r].w}, ba[4] = {bv4[r].x, bv4[r].y, bv4[r].z, bv4[r].w},
                                   pa[4] = {pv4[r].x, pv4[r].y, pv4[r].z, pv4[r].w}, qa[4] = {qv4[r].x, qv4[r].y, qv4[r].z, qv4[r].w};
                    float zc[8], o[8], pf[8];
#pragma unroll
                    for (int j = 0; j < 4; ++j) { zc[2 * j] = bflo(xa[j]); zc[2 * j + 1] = bfhi(xa[j]); pf[2 * j] = bflo(pa[j]); pf[2 * j + 1] = bfhi(pa[j]); }
#pragma unroll
                    for (int j = 0; j < 8; ++j) { const float cvv = w0[j] * p2[j] + w1[j] * p1[j] + w2[j] * zc[j]; const float bb = (j & 1) ? bfhi(ba[j >> 1]) : bflo(ba[j >> 1]); o[j] = bb * cvv; p2[j] = p1[j]; p1[j] = zc[j]; }
                    u32x4 w; w.x = cvt_pk_bf16(o[0], o[1]); w.y = cvt_pk_bf16(o[2], o[3]); w.z = cvt_pk_bf16(o[4], o[5]); w.w = cvt_pk_bf16(o[6], o[7]);
                    stg<u32x4>(CIN + (size_t)(tok0 + t) * D, c0b, w);
                    const float inv = 1.0f / (float)((pos + 1) < pwin ? (pos + 1) : pwin);
#pragma unroll
                    for (int j = 0; j < 8; ++j) { sw[j] += pf[j]; o[j] = sw[j] * inv - pf[j]; }
                    w.x = cvt_pk_bf16(o[0], o[1]); w.y = cvt_pk_bf16(o[2], o[3]); w.z = cvt_pk_bf16(o[4], o[5]); w.w = cvt_pk_bf16(o[6], o[7]);
                    stg<u32x4>(PIN + (size_t)(tok0 + t) * D, c0b, w);
                    const float qm = (pos - (pwin - 1) >= 0) ? 1.0f : 0.0f;
#pragma unroll
                    for (int j = 0; j < 4; ++j) { sw[2 * j] -= qm * bflo(qa[j]); sw[2 * j + 1] -= qm * bfhi(qa[j]); } }
            }
        }
        FRESH_IDS(F); tid = F.tid; lane = F.lane; wave = F.wave;
        if (tid < CHUNK) rs[tid] = 1.0f / sqrtf(vss[tok0 + tid] * (1.0f / D) + RMS_EPS);
        u32x4 gvv[4];
        const int tq = tid >> 4, kc = tid & 15;
        const unsigned voff = ((unsigned)tq * NTOK + 8u * kc) * 2u;
#define GM_PREFETCH(h_) do { const char* wih = wimg + (size_t)(h_) * 32768 + (unsigned)tid * 16u; const bf16* vth = VT + (size_t)(h_) * CHUNK * NTOK + tok0; \
            _Pragma("unroll") for (int i = 0; i < 4; ++i) __builtin_amdgcn_global_load_lds((const unsigned*)(wih + i * 8192), (LAS unsigned*)(Abuf + ((h_) & 1) * 32768 + i * 8192 + wave * 1024), 16, 0, 0); \
            asm volatile("" ::: "memory");     \
            _Pragma("unroll") for (int i = 0; i < 4; ++i) gvv[i] = ldg<u32x4>(vth + (size_t)32 * i * NTOK, voff); } while (0)
        const int wr = wave >> 1, wc = wave & 1, fr = lane & 15, fq = lane >> 4;
        u32x4 uwA[2][2], uwB[2][2]; f32x4 ggA[4], ggB[4]; float btA[2], btB[2];
#define GM_EPI_LOAD(h_, UW, GG, BT) do { const unsigned coff_ = (unsigned)((h_) * CHUNK + 64 * wc + 16 * fq); \
            _Pragma("unroll") for (int n = 0; n < 4; ++n) GG[n] = ldg<f32x4>(gng, (coff_ + 4 * n) * 4u); \
            _Pragma("unroll") for (int m = 0; m < 2; ++m) { const int t = 32 * wr + 16 * m + fr; BT[m] = ldg<float>(bs, (unsigned)((h_) * CHUNK + t) * 4u); \
                _Pragma("unroll") for (int n = 0; n < 2; ++n) UW[m][n] = ldg<u32x4>(Z + (size_t)tok0 * INC + Z_U, ((unsigned)t * INC + coff_ + 8 * n) * 2u); } } while (0)
#define GM_HEAD(h, UW, GG, BT, UWN, GGN, BTN) do { \
            const LAS unsigned char* Aimg = Abuf + ((h) & 1) * 32768; \
            _Pragma("unroll") for (int i = 0; i < 4; ++i) { const int t = tq + 32 * i; const u32x4 g = gvv[i]; \
                u32x4 w; w.x = cvt_pk_bf16(bflo(g.x) * rsv[0], bfhi(g.x) * rsv[1]); w.y = cvt_pk_bf16(bflo(g.y) * rsv[2], bfhi(g.y) * rsv[3]); \
                w.z = cvt_pk_bf16(bflo(g.z) * rsv[4], bfhi(g.z) * rsv[5]); w.w = cvt_pk_bf16(bflo(g.w) * rsv[6], bfhi(g.w) * rsv[7]); \
                const int tp = (t & ~60) | ((t & 12) << 2) | ((t & 48) >> 2); *(LAS u32x4*)(Bimg + tp * 256 + ((kc ^ (tp & 15)) << 4)) = w; }     \
            __syncthreads(); \
            if ((h) + 1 < 8) { GM_PREFETCH((h) + 1); GM_EPI_LOAD((h) + 1, UWN, GGN, BTN); } \
            const unsigned coff = (unsigned)((h) * CHUNK + 64 * wc + 16 * fq);     \
            f32x4 acc[2][4]; \
            _Pragma("unroll") for (int m = 0; m < 2; ++m) _Pragma("unroll") for (int n = 0; n < 4; ++n) acc[m][n] = (f32x4){0.f, 0.f, 0.f, 0.f}; \
            for (int kk = 0; kk <= wr; ++kk) { \
                bf16x8 a[2], bq[4]; \
                _Pragma("unroll") for (int m = 0; m < 2; ++m) { const int row = 32 * wr + 16 * m + fr; a[m] = *(const LAS bf16x8*)(Aimg + row * 256 + (((4 * kk + fq) ^ (row & 15)) << 4)); } \
                _Pragma("unroll") for (int n = 0; n < 4; ++n) { const int row = 64 * wc + 16 * n + fr; bq[n] = *(const LAS bf16x8*)(Bimg + row * 256 + (((4 * kk + fq) ^ (row & 15)) << 4)); } \
                _Pragma("unroll") for (int m = 0; m < 2; ++m) _Pragma("unroll") for (int n = 0; n < 4; ++n) acc[m][n] = __builtin_amdgcn_mfma_f32_16x16x32_bf16(bq[n], a[m], acc[m][n], 0, 0, 0); \
            } \
            _Pragma("unroll") for (int m = 0; m < 2; ++m) { const int t = 32 * wr + 16 * m + fr; \
                _Pragma("unroll") for (int n = 0; n < 2; ++n) { const u32x4 uq = UW[m][n]; \
                    const f32x4 u0 = {bflo(uq.x), bfhi(uq.x), bflo(uq.y), bfhi(uq.y)}, u1 = {bflo(uq.z), bfhi(uq.z), bflo(uq.w), bfhi(uq.w)}; \
                    const f32x4 o0 = u0 * (acc[m][2 * n] * GG[2 * n] + BT[m]), o1 = u1 * (acc[m][2 * n + 1] * GG[2 * n + 1] + BT[m]); \
                    u32x4 w; w.x = cvt_pk_bf16(o0.x, o0.y); w.y = cvt_pk_bf16(o0.z, o0.w); w.z = cvt_pk_bf16(o1.x, o1.y); w.w = cvt_pk_bf16(o1.z, o1.w); \
                    stg<u32x4>(AIN + (size_t)tok0 * D, ((unsigned)t * D + coff + 8 * n) * 2u, w); } } \
            __syncthreads(); } while (0)
        GM_PREFETCH(0); GM_EPI_LOAD(0, uwA, ggA, btA);
        __syncthreads();
        float rsv[8];
#pragma unroll
        for (int j = 0; j < 8; ++j) rsv[j] = rs[8 * kc + j];
#pragma unroll 1
        for (int h = 0; h < 8; h += 2) {
            GM_HEAD(h, uwA, ggA, btA, uwB, ggB, btB);
            GM_HEAD(h + 1, uwB, ggB, btB, uwA, ggA, btA);
        }
#undef GM_HEAD
#undef GM_EPI_LOAD
#undef GM_PREFETCH
    }
}

__device__ __forceinline__ void router_phase(Frame& F, int l) {
    FRESH_IDS(F);
    const bf16* X = WSP(bf16, WS_XRES); const float* mods = WSP(float, WS_MODS) + (size_t)l * NB * 6 * D; const float* g2n = FIN(15) + (size_t)l * D;
    const bf16* rwh = WSP(bf16, WS_RWT) + (size_t)l * NB * NE * D; const float* rbias = WSP(float, WS_RBIAS) + (size_t)l * NB * NE;
    bf16* H = WSP(bf16, WS_H); int* LIST = WSP(int, WS_LIST); float* WL = WSP(float, WS_WLIST); unsigned* cnt = F.ctl + CW_CNT + l * NE;
    LAS float* lg = (LAS float*)(F.lds) + F.wave * (16 * 33);
    LAS float* rsd = (LAS float*)(F.lds + 17408) + F.wave * 16;
    LAS int* te = (LAS int*)(F.lds + 18432);
    LAS float* tw = (LAS float*)(F.lds + 20480);
    LAS unsigned* hist = (LAS unsigned*)(F.lds + 22528);
    LAS unsigned* base = (LAS unsigned*)(F.lds + 22656);
    const int lane = F.lane, tid = F.tid, q = lane >> 4, r = lane & 15;
    if (tid < 32) hist[tid] = 0u;
    __syncthreads();
    for (int tile = F.bid; tile < NTOK / 128; tile += F.G) {
        const int tok0 = tile * 128 + F.wave * 16, b = tok0 / SEQ;
        u32x4 xr[32];
#pragma unroll
        for (int J = 0; J < 32; ++J) xr[J] = ldg<u32x4>(X + (size_t)tok0 * D, ((unsigned)r * D + 8u * q + 32u * J) * 2u);
        {
            const char* wsrc = (const char*)(rwh + (size_t)b * NE * D);
#pragma unroll
            for (int i = 0; i < 16; ++i) { const int idx = F.wave * 16 + i, hl = idx >> 6, row = (idx >> 1) & 31, hf = idx & 1;
                __builtin_amdgcn_global_load_lds((const unsigned*)(wsrc + (size_t)hl * MiB + row * 2048 + hf * 1024 + lane * 16), (LAS unsigned*)(F.lds + hl * 66048 + row * 2064 + hf * 1024), 16, 0, 0); }
            asm volatile("s_waitcnt vmcnt(0)" ::: "memory");
            __syncthreads();
        }
        const LAS unsigned char* wl = F.lds + r * 2064 + 16 * q;
        f32x4 acc0 = {0.f, 0.f, 0.f, 0.f}, acc1 = {0.f, 0.f, 0.f, 0.f}; float ss = 0.f;
#pragma unroll
        for (int J = 0; J < 32; ++J) {
            const bf16x8 h0 = *(const LAS bf16x8*)(wl + 64 * J), h1 = *(const LAS bf16x8*)(wl + 16 * 2064 + 64 * J), l0 = *(const LAS bf16x8*)(wl + 66048 + 64 * J), l1 = *(const LAS bf16x8*)(wl + 66048 + 16 * 2064 + 64 * J);
            const u32x4 xw = xr[J]; const bf16x8 xf = __builtin_bit_cast(bf16x8, xw);
            const f32x4 x0 = {bflo(xw.x), bfhi(xw.x), bflo(xw.y), bfhi(xw.y)}, x1 = {bflo(xw.z), bfhi(xw.z), bflo(xw.w), bfhi(xw.w)};
            ss += ((x0.x * x0.x + x0.y * x0.y) + (x0.z * x0.z + x0.w * x0.w)) + ((x1.x * x1.x + x1.y * x1.y) + (x1.z * x1.z + x1.w * x1.w));
            acc0 = __builtin_amdgcn_mfma_f32_16x16x32_bf16(xf, h0, acc0, 0, 0, 0); acc1 = __builtin_amdgcn_mfma_f32_16x16x32_bf16(xf, h1, acc1, 0, 0, 0);
            acc0 = __builtin_amdgcn_mfma_f32_16x16x32_bf16(xf, l0, acc0, 0, 0, 0); acc1 = __builtin_amdgcn_mfma_f32_16x16x32_bf16(xf, l1, acc1, 0, 0, 0);
            if ((J & 3) == 3) __builtin_amdgcn_sched_barrier(0); }
        ss += __shfl_xor(ss, 16); ss += __shfl_xor(ss, 32);
        __syncthreads();
        if (tid < 32) hist[tid] = 0u;
        const float rstd = 1.0f / sqrtf(ss * (1.0f / D) + RMS_EPS);
#pragma unroll
        for (int g = 0; g < 4; ++g) { lg[(4 * q + g) * 33 + r] = acc0[g]; lg[(4 * q + g) * 33 + 16 + r] = acc1[g]; }
        if (lane < 16) rsd[lane] = rstd;
        __syncthreads();
        if (lane < 16) {
            float v[NE]; const float rsv = rsd[lane];
#pragma unroll
            for (int e = 0; e < NE; ++e) v[e] = lg[lane * 33 + e] * rsv + rbias[b * NE + e];
            float tv[TOPK]; int ti[TOPK];
#pragma unroll
            for (int k = 0; k < TOPK; ++k) { float best = v[0]; int bi = 0;
#pragma unroll
                for (int e = 1; e < NE; ++e) { if (v[e] > best) { best = v[e]; bi = e; } }
                tv[k] = best; ti[k] = bi;
#pragma unroll
                for (int e = 0; e < NE; ++e) v[e] = (e == bi) ? -3.0e38f : v[e]; }
            float p[TOPK], ps = 0.f;
#pragma unroll
            for (int k = 0; k < TOPK; ++k) { p[k] = __expf(tv[k] - tv[0]); ps += p[k]; }
            const float inv = 1.0f / ps;
#pragma unroll
            for (int k = 0; k < TOPK; ++k) { te[(F.wave * 16 + lane) * 4 + k] = ti[k]; tw[(F.wave * 16 + lane) * 4 + k] = p[k] * inv; }
        }
        {
            f32x4 gmul[4], gadd[4];
#pragma unroll
            for (int j = 0; j < 4; ++j) { const int col = 256 * j + 4 * lane; const f32x4 g = *(const f32x4*)(g2n + col), scv = *(const f32x4*)(mods + (size_t)b * 6 * D + 4 * D + col);
                gmul[j] = g * (scv + 1.0f); gadd[j] = *(const f32x4*)(mods + (size_t)b * 6 * D + 3 * D + col); }
            u32x2 xa0[4], xa1[4];
#pragma unroll
            for (int j = 0; j < 4; ++j) xa0[j] = *(const u32x2*)(X + (size_t)tok0 * D + 256 * j + 4 * lane);
#pragma unroll
            for (int i = 0; i < 16; i += 2) {
#pragma unroll
                for (int j = 0; j < 4; ++j) xa1[j] = *(const u32x2*)(X + (size_t)(tok0 + i + 1) * D + 256 * j + 4 * lane);
                { const float rsv = rsd[i];
#pragma unroll
                  for (int j = 0; j < 4; ++j) { const f32x4 o = unpack_lo4(xa0[j]) * rsv * gmul[j] + gadd[j]; u32x2 w; w.x = cvt_pk_bf16(o.x, o.y); w.y = cvt_pk_bf16(o.z, o.w); *(u32x2*)(H + (size_t)(tok0 + i) * D + 256 * j + 4 * lane) = w; } }
                if (i + 2 < 16) {
#pragma unroll
                    for (int j = 0; j < 4; ++j) xa0[j] = *(const u32x2*)(X + (size_t)(tok0 + i + 2) * D + 256 * j + 4 * lane); }
                { const float rsv = rsd[i + 1];
#pragma unroll
                  for (int j = 0; j < 4; ++j) { const f32x4 o = unpack_lo4(xa1[j]) * rsv * gmul[j] + gadd[j]; u32x2 w; w.x = cvt_pk_bf16(o.x, o.y); w.y = cvt_pk_bf16(o.z, o.w); *(u32x2*)(H + (size_t)(tok0 + i + 1) * D + 256 * j + 4 * lane) = w; } }
            }
        }
        __syncthreads();
        const int t = tid >> 2, k = tid & 3, e = te[t * 4 + k];
        const unsigned rl = __hip_atomic_fetch_add(&hist[e], 1u, __ATOMIC_RELAXED, __HIP_MEMORY_SCOPE_WORKGROUP);
        __syncthreads();
        if (tid < 32) base[tid] = __hip_atomic_fetch_add(cnt + tid, hist[tid], RLX_AGENT);
        __syncthreads();
        const unsigned pos = base[e] + rl;
        LIST[(size_t)e * NTOK + pos] = (tile * 128 + t) * 4 + k; WL[(size_t)e * NTOK + pos] = tw[t * 4 + k];
        __syncthreads();
        if (tid < 32) hist[tid] = 0u;
        __syncthreads();
    }
}

__device__ __forceinline__ void moe_tables(Frame& F, int l) {
    FRESH_IDS(F);
    LAS int* tb = (LAS int*)(F.lds + LDSCTL_OFF + 256);
    __syncthreads();
    if (F.tid == 0) { int ps = 0; for (int e = 0; e < NE; ++e) { const int c = (int)__hip_atomic_load(F.ctl + CW_CNT + l * NE + e, RLX_AGENT); const int T = (c + 255) >> 8; tb[e] = T; tb[32 + e] = ps; tb[64 + e] = c; ps += T * 256; } }
    __syncthreads();
}

__global__ void __launch_bounds__(NTHREADS, 2) fwd_kernel(Args args) {
    extern __shared__ __attribute__((aligned(16))) unsigned char lds_raw[];
    Frame F;
    F.lds = (LAS unsigned char*)lds_raw; F.ws = args.ws; F.ctl = (unsigned*)(args.ws + WS_CTL);
    F.tid = threadIdx.x; F.lane = F.tid & 63; F.wave = __builtin_amdgcn_readfirstlane(F.tid >> 6); F.wave0 = F.wave; F.G = gridDim.x; F.bid = blockIdx.x;
    F.a = &args;
    for (int u = F.tid; u < 256; u += NTHREADS) ((LAS unsigned*)(F.lds + LDSCTL_OFF))[u] = 0u;
    __syncthreads();
    XcdBarrier bar; bar.bar = F.ctl + CW_BAR; bar.x = 0; bar.st = nullptr; bar.wave0 = F.wave0;
    if (N_LAUNCHES == 1) bar = xcd_barrier_post(F.ctl + CW_BAR, (volatile LAS unsigned*)(F.lds + LDSCTL_OFF + 16), F.wave0);
    const int lo = args.ph_lo, hi = args.ph_hi;
#ifdef ONLY_PH
#define IN(k) ((((k) < 2 ? (k) : 2 + ((k) - 2) % 8) == ONLY_PH) && lo <= (k) && (k) < hi)
#else
#define IN(k) (lo <= (k) && (k) < hi)
#endif
#ifdef DIAG_A
#define STAMP(k) do { if (blockIdx.x == 0 && threadIdx.x == 0) ((LAS unsigned long long*)(F.lds + LDSCTL_OFF + 704))[k] = __builtin_amdgcn_s_memrealtime(); } while (0)
#else
#define STAMP(k) do { } while (0)
#endif
#define SEAM(k) do { if (IN(k) && IN((k) + 1)) xcd_barrier(bar); } while (0)

    if (IN(0)) { STAMP(0); p0_prologue(F); } SEAM(0);
    if (IN(1)) {
        STAMP(1);
        const float* mods = WSP(float, WS_MODS);
        norm_rows<0, false>(F, FIN(0), nullptr, nullptr, nullptr, FIN(2), mods + D, mods, WSP(bf16, WS_H), nullptr);
        router_prep(F);
    } SEAM(1);

    for (int l = 0; l < DEPTH; ++l) {
        const int pb = 2 + 8 * l;
        const float* mods = WSP(float, WS_MODS) + (size_t)l * NB * 6 * D;
        if (IN(pb + 0)) { STAMP(pb + 0);
            SchedZ S{F.G, F.bid, (const char*)WSP(bf16, WS_H), (const char*)(WSP(bf16, WS_WTIN) + (size_t)l * INC * D), F.ctl + CW_QZ + l * 128};
            EpiZ E{WSP(bf16, WS_Z), WSP(bf16, WS_VT), WSP(float, WS_VSS) + (size_t)l * NTOK};
            if (((F.bid >> 3) & 3) == 3) convert_items<1>(F, F.ctl + CW_CVCTR + 32 * l, l);
            gm::gemm_phase<EpiZ, SchedZ, false, true>(F.lds, S, E, F.wave0);
        } SEAM(pb + 0);
        if (IN(pb + 1)) { STAMP(pb + 1); mixer_prep(F, l); } SEAM(pb + 1);
        if (IN(pb + 2)) { STAMP(pb + 2);
            SchedMix S{F.G, F.bid, (const char*)WSP(bf16, WS_AIN), (const char*)WSP(bf16, WS_CIN), (const char*)WSP(bf16, WS_PIN),
                       (const char*)(WSP(bf16, WS_WTA) + (size_t)l * D * D), (const char*)(WSP(bf16, WS_WTC) + (size_t)l * D * D), (const char*)(WSP(bf16, WS_WTPOOL) + (size_t)l * D * D)};
            EpiMix E{WSP(bf16, WS_Z), WSP(bf16, WS_MIX), FIN(11) + (size_t)l * D};
            gm::gemm_phase<EpiMix, SchedMix, false>(F.lds, S, E, F.wave0);
        } SEAM(pb + 2);
        if (IN(pb + 3)) { STAMP(pb + 3);
            SchedOut S{F.G, F.bid, (const char*)WSP(bf16, WS_MIX), (const char*)(WSP(bf16, WS_WTO) + (size_t)l * D * D)};
            if (l == 0) { EpiOut<true> E{FIN(0), WSP(bf16, WS_XRES), mods + 2 * D}; gm::gemm_phase<EpiOut<true>, SchedOut, false>(F.lds, S, E, F.wave0); }
            else { EpiOut<false> E{WSP(bf16, WS_XRES), WSP(bf16, WS_XRES), mods + 2 * D}; gm::gemm_phase<EpiOut<false>, SchedOut, false>(F.lds, S, E, F.wave0); }
        } SEAM(pb + 3);
        if (IN(pb + 4)) { STAMP(pb + 4); router_phase(F, l); } SEAM(pb + 4);
        if (IN(pb + 5)) { STAMP(pb + 5);
            moe_tables(F, l);
            SchedMoe S{F.G / 8, F.bid / 8, F.bid % 8, 8, (const LAS int*)(F.lds + LDSCTL_OFF + 256), (const char*)WSP(bf16, WS_H), (const char*)(WSP(bf16, WS_WTGU) + (size_t)l * NE * 2 * FF * D), (unsigned)(2 * FF * D * 2), WSP(int, WS_LIST), true};
            EpiGU E{WSP(bf16, WS_ACT), FIN(19) + (size_t)l * NE * 2 * FF};
            gm::gemm_phase<EpiGU, SchedMoe, true>(F.lds, S, E, F.wave0);
        } SEAM(pb + 5);
        if (IN(pb + 6)) { STAMP(pb + 6);
            moe_tables(F, l);
            SchedMoe S{F.G / 8, F.bid / 8, F.bid % 8, 4, (const LAS int*)(F.lds + LDSCTL_OFF + 256), (const char*)WSP(bf16, WS_ACT), (const char*)(WSP(bf16, WS_WTDN) + (size_t)l * NE * D * FF), (unsigned)(D * FF * 2), WSP(int, WS_LIST), false};
            EpiDown E{WSP(bf16, WS_YB), FIN(21) + (size_t)l * NE * D, WSP(int, WS_LIST), WSP(float, WS_WLIST)};
            gm::gemm_phase<EpiDown, SchedMoe, false>(F.lds, S, E, F.wave0);
        } SEAM(pb + 6);
        if (IN(pb + 7)) { STAMP(pb + 7);
            if (l + 1 < DEPTH) { const float* m2 = WSP(float, WS_MODS) + (size_t)(l + 1) * NB * 6 * D;
                norm_rows<0, true>(F, WSP(bf16, WS_XRES), WSP(bf16, WS_YB), mods + 5 * D, WSP(bf16, WS_XRES), FIN(2) + (size_t)(l + 1) * D, m2 + D, m2, WSP(bf16, WS_H), nullptr); }
            else norm_rows<1, true>(F, WSP(bf16, WS_XRES), WSP(bf16, WS_YB), mods + 5 * D, nullptr, FIN(22), nullptr, nullptr, nullptr, F.a->out);
        } SEAM(pb + 7);
    }
#undef IN
#undef SEAM
}

extern "C" void kernel_launch(void* const* d_in, const int* in_sizes, int n_in, void* d_out, int out_size, void* d_ws, size_t ws_size, hipStream_t stream) {
    static int grid = 0;
    if (grid == 0) {
        if (n_in != 23 || out_size != NTOK * D || ws_size < WS_END) { fprintf(stderr, "kernel_launch: unexpected shapes (n_in %d out %d ws %zu)\n", n_in, out_size, ws_size); grid = -1; return; }
        int dev = 0, cus = 0, per_cu = 0;
        if (hipGetDevice(&dev) != hipSuccess || hipDeviceGetAttribute(&cus, hipDeviceAttributeMultiprocessorCount, dev) != hipSuccess) { grid = -1; return; }
        if (hipFuncSetAttribute((const void*)fwd_kernel, hipFuncAttributeMaxDynamicSharedMemorySize, LDS_BYTES) != hipSuccess) { fprintf(stderr, "kernel_launch: hipFuncSetAttribute failed\n"); grid = -1; return; }
        if (hipOccupancyMaxActiveBlocksPerMultiprocessor(&per_cu, (const void*)fwd_kernel, NTHREADS, LDS_BYTES) != hipSuccess || per_cu < 1) fprintf(stderr, "kernel_launch: occupancy query reports %d\n", per_cu);
        (void)hipGetLastError();
        grid = (cus / 8) * 8;
        if (grid > 256) grid = 256;
        if (grid < 8) { grid = -1; return; }
    }
    if (grid < 0) return;
    if (hipMemsetAsync((char*)d_ws + WS_CTL, 0, CTL_ZERO_BYTES, stream) != hipSuccess) return;
    Args a{};
    for (int i = 0; i < 23; ++i) a.in[i] = (const float*)d_in[i];
    a.out = (float*)d_out; a.ws = (unsigned char*)d_ws;
    for (int li = 0; li < N_LAUNCHES; ++li) {
        a.ph_lo = (N_LAUNCHES == 1) ? 0 : li; a.ph_hi = (N_LAUNCHES == 1) ? NPHASES : li + 1;
        hipLaunchKernelGGL(fwd_kernel, dim3(grid), dim3(NTHREADS), LDS_BYTES, stream, a);
        if (hipPeekAtLastError() != hipSuccess) { fprintf(stderr, "kernel_launch: launch %d failed\n", li); break; }
    }
}
```

```cpp
#include <hip/hip_runtime.h>
#include <cstdio>
#include <cstdint>

#ifndef MK_N_LAUNCHES
#define MK_N_LAUNCHES 1
#endif

#define GAS __attribute__((address_space(1)))
#define LAS __attribute__((address_space(3)))
typedef unsigned short bf16;
typedef short bf16x8 __attribute__((ext_vector_type(8)));
typedef float f32x4 __attribute__((ext_vector_type(4)));
typedef float f32x2 __attribute__((ext_vector_type(2)));
typedef unsigned u32x4 __attribute__((ext_vector_type(4)));
typedef unsigned u32x2 __attribute__((ext_vector_type(2)));

constexpr int D = 1024, NB = 8, SEQ = 4096, NTOK = NB * SEQ, DEPTH = 2, INC = 9216, NE = 32, TOPK = 4, FF = 1024, CHUNK = 128;
constexpr int Z_U = 0, Z_V = 1024, Z_P = 2048, Z_X = 3072, Z_B = 4096, Z_C = 5120, Z_GA = 6144, Z_GB = 7168, Z_GC = 8192;
constexpr float RMS_EPS = 1e-5f;
constexpr int NWAVES = 8, NTHREADS = NWAVES * 64;
constexpr int NPHASES = 2 + 8 * DEPTH;
constexpr int N_LAUNCHES = MK_N_LAUNCHES;
static_assert(N_LAUNCHES == 1 || N_LAUNCHES == NPHASES, "MK_N_LAUNCHES must be 1 or NPHASES");

constexpr size_t MiB = 1u << 20;
constexpr size_t WS_CTL = 0, CTL_ZERO_BYTES = 512 * 1024;
constexpr int CW_BAR = 4096;
constexpr int CW_CNT = 8192;
constexpr int CW_QZ = 8192 + 512;
constexpr int CW_CVCTR = 8192 + 320;
constexpr int CW_P0CTR = 8192 + 256;
constexpr size_t WS_VSS = 256 * 1024;
constexpr size_t WS_MODS = 512 * 1024;
constexpr size_t WS_RWT = 1 * MiB;
constexpr size_t WS_RBIAS = 3 * MiB;
constexpr size_t WS_LIST = 4 * MiB;
constexpr size_t WS_WLIST = 8 * MiB;
constexpr size_t WS_WTPOOL = 12 * MiB;
constexpr size_t WS_WTA = 16 * MiB, WS_WTC = 20 * MiB, WS_WTO = 24 * MiB;
constexpr size_t WS_WTIN = 28 * MiB;
constexpr size_t WS_WTGU = 64 * MiB;
constexpr size_t WS_WTDN = 320 * MiB;
constexpr size_t WS_H = 448 * MiB;
constexpr size_t WS_VT = 512 * MiB;
constexpr size_t WS_AIN = 576 * MiB, WS_CIN = 640 * MiB, WS_PIN = 704 * MiB;
constexpr size_t WS_MIX = 768 * MiB;
constexpr size_t WS_XRES = 832 * MiB;
constexpr size_t WS_WIMG = 960 * MiB;
constexpr size_t WS_Z = 1088 * MiB;
constexpr size_t WS_ACT = WS_Z;
constexpr size_t WS_YB = WS_Z + 288 * MiB;
constexpr size_t WS_END = 1664 * MiB;

constexpr int RING_BYTES = 131072;
constexpr int LDS_BYTES = 147456;
constexpr int LDSCTL_OFF = LDS_BYTES - 1024;

#define RLX_AGENT __ATOMIC_RELAXED, __HIP_MEMORY_SCOPE_AGENT
typedef __bf16 bf16x2_t __attribute__((ext_vector_type(2)));
__device__ __forceinline__ unsigned cvt_pk_bf16(float lo, float hi) { const f32x2 v = {lo, hi}; const bf16x2_t r = __builtin_convertvector(v, bf16x2_t); return __builtin_bit_cast(unsigned, r); }
__device__ __forceinline__ float bflo(unsigned u) { return __uint_as_float(u << 16); }
__device__ __forceinline__ float bfhi(unsigned u) { return __uint_as_float(u & 0xffff0000u); }
__device__ __forceinline__ float wave_sum(float v) {
#pragma unroll
    for (int o = 1; o < 64; o <<= 1) v += __shfl_xor(v, o);
    return v;
}
__device__ __forceinline__ float sigmoidf_fast(float x) { return __builtin_amdgcn_rcpf(1.0f + __builtin_amdgcn_exp2f(-1.44269504089f * x)); }
__device__ __forceinline__ float gelu_tanh(float x) {
    const float t = x * (1.0f + 0.044715f * x * x);
    return x * __builtin_amdgcn_rcpf(1.0f + __builtin_amdgcn_exp2f(-2.30220818f * t));
}
__device__ __forceinline__ f32x4 unpack_lo4(u32x2 w) { return (f32x4){bflo(w.x), bfhi(w.x), bflo(w.y), bfhi(w.y)}; }

__device__ __forceinline__ int tid_of(int wave0) { int l; asm volatile("v_mbcnt_lo_u32_b32 %0, -1, 0\n\tv_mbcnt_hi_u32_b32 %0, -1, %0" : "=v"(l)); return wave0 * 64 + l; }
#define XB_TMO      128
#define XB_XCNT(j)  (256  + 64 * (j))
#define XB_XSUB(j)  (1280 + 64 * (j))
#define XB_XGEN(j)  (2304 + 64 * (j))
#define XB_TOP      3328
#define XB_TOPGEN   3392
#define XCD_BAR_WORDS 3456
#define XB_SPIN_CAP (1u << 18)
__device__ __forceinline__ unsigned xb_ld(unsigned* p)              { return __hip_atomic_load(p, __ATOMIC_RELAXED, __HIP_MEMORY_SCOPE_AGENT); }
__device__ __forceinline__ unsigned xb_add(unsigned* p, unsigned v) { return __hip_atomic_fetch_add(p, v, __ATOMIC_RELAXED, __HIP_MEMORY_SCOPE_AGENT); }
__device__ __forceinline__ unsigned xb_xcc_id() { return (unsigned)__builtin_amdgcn_s_getreg((3 << 11) | 20) & 0xFu; }
#define XB_SPIN(cond, bar) do { unsigned _sp = 0; while (cond) { __builtin_amdgcn_s_sleep(1); \
    if ((++_sp & 255u) == 0u) { if (xb_ld(&(bar)[XB_TMO])) break; if (_sp > XB_SPIN_CAP) { atomicAdd(&(bar)[XB_TMO], 1u); break; } } } } while (0)
struct XcdBarrier { unsigned* bar; unsigned x; volatile LAS unsigned* st; int wave0; };
__device__ __forceinline__ XcdBarrier xcd_barrier_post(unsigned* bar, volatile LAS unsigned* st, int wave0) {
    XcdBarrier b; b.bar = bar; b.x = xb_xcc_id(); b.st = st; b.wave0 = wave0;
    if (tid_of(wave0) == 0) (void)xb_add(&bar[XB_XCNT(b.x)], 1u);
    return b;
}
__device__ __forceinline__ void xcd_barrier_complete(unsigned* bar, unsigned x, unsigned& nloc, unsigned& nx) {
    const unsigned G = gridDim.x * gridDim.y * gridDim.z;
    unsigned sum, cnt, mine, sp = 0u;
    for (;;) {
        sum = 0u; cnt = 0u; mine = 0u;
#pragma unroll
        for (unsigned j = 0; j < 16; ++j) { const unsigned c = xb_ld(&bar[XB_XCNT(j)]); sum += c; cnt += (c > 0u) ? 1u : 0u; mine = (j == x) ? c : mine; }
        if (sum == G) break;
        __builtin_amdgcn_s_sleep(1);
        if ((++sp & 255u) == 0u) { if (xb_ld(&bar[XB_TMO])) break; if (sp > XB_SPIN_CAP) { atomicAdd(&bar[XB_TMO], 1u); break; } }
    }
    nloc = mine > 0u ? mine : 1u; nx = cnt > 0u ? cnt : 1u;
}
__device__ __forceinline__ void xcd_barrier(const XcdBarrier& b) {
    asm volatile("s_waitcnt vmcnt(0)" ::: "memory");
    __syncthreads();
    if (tid_of(b.wave0) == 0) {
        unsigned* bar = b.bar;
        __builtin_amdgcn_s_waitcnt(0);
        unsigned nloc = b.st[0], nx = b.st[1];
        if (nloc == 0u) { xcd_barrier_complete(bar, b.x, nloc, nx); b.st[0] = nloc; b.st[1] = nx; }
        const unsigned old = xb_add(&bar[XB_XSUB(b.x)], 1u);
        const unsigned gen = old / nloc;
        if (old + 1u == (gen + 1u) * nloc) {
            __builtin_amdgcn_fence(__ATOMIC_RELEASE, "agent");
            asm volatile("s_waitcnt vmcnt(0)" ::: "memory");
            const unsigned og = xb_add(&bar[XB_TOP], 1u);
            const unsigned tg = og / nx;
            if (og + 1u == (tg + 1u) * nx) xb_add(&bar[XB_TOPGEN], 1u);
            else XB_SPIN(xb_ld(&bar[XB_TOPGEN]) == tg, bar);
            __builtin_amdgcn_fence(__ATOMIC_ACQUIRE, "agent");
            xb_add(&bar[XB_XGEN(b.x)], 1u);
            asm volatile("s_waitcnt vmcnt(0)" ::: "memory");
        } else {
            XB_SPIN(xb_ld(&bar[XB_XGEN(b.x)]) == gen, bar);
            __builtin_amdgcn_fence(__ATOMIC_ACQUIRE, "agent");
            asm volatile("s_waitcnt vmcnt(0)" ::: "memory");
        }
    }
    __syncthreads();
}

namespace gm {
constexpr int BM = 256, BK = 64, HALF = 128, HTB = HALF * BK * 2;
constexpr unsigned PITCH = 2048u, HSTEP = 128u * PITCH, TSTEP = 256u * PITCH, KSTEP = 128u;
__device__ __forceinline__ int lds_byte(int r, int c) { const int st = (r >> 4) * 2 + (c >> 5), rr = r & 15, cc = c & 31, ob = rr * 64 + cc * 2; return st * 1024 + (ob ^ (((ob >> 9) & 1) << 5)); }
__device__ __forceinline__ void stage_rc(int b, int& R, int& C) { const int st = b / 1024, sb = b % 1024, swz = sb ^ (((sb >> 9) & 1) << 5); R = (st >> 1) * 16 + swz / 64; C = (st & 1) * 32 + (swz % 64) / 2; }
__device__ __forceinline__ int perm32(int rho) { const int n = rho >> 4, i = rho & 15; return 8 * (i >> 2) + 4 * n + (i & 3); }

struct Unit { const char* A; const char* B; int nt, kind, pm, pn, aux; };

__device__ __forceinline__ void tile_map(int L, int nM, int nN, int& pm, int& pn) {
    const int nwg = nM * nN; int wgid = L;
    { const int q = nwg / 8, r = nwg % 8, xcd = wgid % 8, off = wgid / 8; wgid = (xcd < r ? xcd * (q + 1) : r * (q + 1) + (xcd - r) * q) + off; }
    constexpr int WGM = 3; const int nig = WGM * nN, gid = wgid / nig, fm = gid * WGM, gsz = (nM - fm) < WGM ? (nM - fm) : WGM;
    pm = fm + ((wgid % nig) % gsz); pn = (wgid % nig) / gsz;
    if (gid & 1) pn = nN - 1 - pn;
}

template <class Epi, class Sched, bool GATHER, bool DYN = false>
__device__ __forceinline__ void gemm_phase(LAS unsigned char* lds, const Sched& S, const Epi& E, int wave0) {
    int tid_ = tid_of(wave0); asm volatile("" : "+v"(tid_));
    const int tid = tid_, wid = __builtin_amdgcn_readfirstlane(tid >> 6), lane = tid & 63, wr = wid >> 2, wc = wid & 3, fr = lane & 15, fq = lane >> 4;
    unsigned voffB[2], cvA[2][2], nvA[2][2]; int rA[2]; unsigned cC[2];
#pragma unroll
    for (int i = 0; i < 2; ++i) { int R, C; stage_rc(tid * 16 + i * 8192, R, C); const int Rb = (R & ~31) + perm32(R & 31);
        voffB[i] = (unsigned)Rb * PITCH + (unsigned)C * 2u; rA[i] = R; cC[i] = (unsigned)C * 2u;
        cvA[0][i] = (unsigned)R * PITCH + cC[i]; cvA[1][i] = cvA[0][i] + HSTEP; nvA[0][i] = cvA[0][i]; nvA[1][i] = cvA[1][i]; }
    const unsigned ldsw = (unsigned)wid * 1024u;
    const int aoff = lds_byte(wr * 64 + fr, fq * 8), boff = lds_byte(wc * 32 + fr, fq * 8);
#define GM_SA(b, h) (((b) * 2 + (h)) * HTB)
#define GM_SB(b, h) ((4 + (b) * 2 + (h)) * HTB)
#define GM_STAGE(bufoff, gbase, voff) do { _Pragma("unroll") for (int _i = 0; _i < 2; ++_i) \
        __builtin_amdgcn_global_load_lds((const unsigned*)((const char*)(gbase) + (voff)[_i]), (LAS unsigned*)(lds + (bufoff) + ldsw + _i * 8192), 16, 0, 0); } while (0)
#define GM_LDA(dst, b, h) do { _Pragma("unroll") for (int m = 0; m < 4; ++m) _Pragma("unroll") for (int k = 0; k < 2; ++k) dst[m][k] = *(const LAS bf16x8*)(lds + GM_SA(b, h) + aoff + m * 2048 + k * 1024); } while (0)
#define GM_LDB(dst, b, h) do { _Pragma("unroll") for (int n = 0; n < 2; ++n) _Pragma("unroll") for (int k = 0; k < 2; ++k) dst[n][k] = *(const LAS bf16x8*)(lds + GM_SB(b, h) + boff + n * 2048 + k * 1024); } while (0)
#define GM_MMA(ai, bj, At, Bt) do { __builtin_amdgcn_s_setprio(1); _Pragma("unroll") for (int m = 0; m < 4; ++m) _Pragma("unroll") for (int n = 0; n < 2; ++n) _Pragma("unroll") for (int k = 0; k < 2; ++k) \
        acc[ai][bj][m][n] = __builtin_amdgcn_mfma_f32_16x16x32_bf16(Bt[n][k], At[m][k], acc[ai][bj][m][n], 0, 0, 0); __builtin_amdgcn_s_setprio(0); } while (0)
#define GM_WAIT_V(n) asm volatile("s_waitcnt vmcnt(" #n ")" ::: "memory")
#define GM_WAIT_VE() asm volatile("s_waitcnt vmcnt(%0)" :: "n"(8 + Epi::MIN_VMEM) : "memory")
#define GM_WAIT_L(n) asm volatile("s_waitcnt lgkmcnt(" #n ")" ::: "memory")
#define GM_BAR __builtin_amdgcn_s_barrier()
#define GM_SCHED __builtin_amdgcn_sched_barrier(0)
    Unit cur, nxt; int ui = 0;
    volatile LAS int* dq = (volatile LAS int*)(lds + LDSCTL_OFF + 128);
    unsigned dtok = 0u;
    if constexpr (DYN) {
        __syncthreads();
        if (tid == 0) { unsigned* q = S.draw_ptr(); dq[0] = (int)__hip_atomic_fetch_add(q, 1u, RLX_AGENT); dq[1] = (int)__hip_atomic_fetch_add(q, 1u, RLX_AGENT); }
        __syncthreads();
        if (!S.next(__builtin_amdgcn_readfirstlane(dq[0]), cur)) return;
    } else {
        if (!S.next(0, cur)) return;
    }
    f32x4 acc[2][2][4][2];
#pragma unroll
    for (int a = 0; a < 2; ++a)
#pragma unroll
        for (int b = 0; b < 2; ++b)
#pragma unroll
            for (int m = 0; m < 4; ++m)
#pragma unroll
                for (int n = 0; n < 2; ++n) acc[a][b][m][n] = (f32x4){0.f, 0.f, 0.f, 0.f};
    bf16x8 At[4][2], B0[2][2], B1[2][2];
    const char* cA = cur.A; const char* cB = cur.B;
    if constexpr (GATHER) {
#pragma unroll
        for (int h = 0; h < 2; ++h)
#pragma unroll
            for (int i = 0; i < 2; ++i) cvA[h][i] = S.row_off(cur, h * HALF + rA[i]) + cC[i];
    }
    GM_STAGE(GM_SB(0, 0), cB, voffB); GM_STAGE(GM_SB(0, 1), cB + HSTEP, voffB); GM_STAGE(GM_SA(0, 0), cA, cvA[0]); GM_STAGE(GM_SA(0, 1), cA, cvA[1]);
    if (wr == 1) GM_BAR;
    GM_WAIT_V(2); GM_BAR;
    GM_STAGE(GM_SB(1, 0), cB + KSTEP, voffB); GM_STAGE(GM_SA(1, 0), cA + KSTEP, cvA[0]); GM_STAGE(GM_SB(1, 1), cB + HSTEP + KSTEP, voffB);
    GM_WAIT_V(6); GM_BAR;
    for (;;) {
        if constexpr (Epi::PREF) { if (wid == 0) E.prefetch(cur, lds, lane, ui & 1); }
        bool has_next;
        if constexpr (DYN) {
            has_next = S.next(__builtin_amdgcn_readfirstlane(dq[(ui + 1) & 1]), nxt);
            if (tid == 0) { unsigned* q = S.draw_ptr(); const unsigned one = 1u; asm volatile("global_atomic_add %0, %1, %2, off sc0" : "=v"(dtok) : "v"(q), "v"(one) : "memory"); }
        } else has_next = S.next(ui + 1, nxt);
        const char* nA = has_next ? nxt.A : cA; const char* nB = has_next ? nxt.B : cB;
        if constexpr (GATHER) {
            if (has_next) {
#pragma unroll
                for (int h = 0; h < 2; ++h)
#pragma unroll
                    for (int i = 0; i < 2; ++i) nvA[h][i] = S.row_off(nxt, h * HALF + rA[i]) + cC[i];
            } else {
#pragma unroll
                for (int h = 0; h < 2; ++h)
#pragma unroll
                    for (int i = 0; i < 2; ++i) nvA[h][i] = cvA[h][i];
            }
        }
        const int nt = cur.nt;
        for (int t = 0; t < nt; t += 2) {
            const bool last = (t == nt - 2);
            if constexpr (DYN) { if (last && tid == 0) dq[ui & 1] = (int)dtok; }
            const char* a1 = cA + (size_t)(t + 1) * KSTEP;
            const char* a2 = last ? nA : cA + (size_t)(t + 2) * KSTEP; const char* b2 = last ? nB : cB + (size_t)(t + 2) * KSTEP;
            const char* a3 = a2 + KSTEP; const char* b3 = b2 + KSTEP;
            unsigned o0[2], o1[2];
            if constexpr (GATHER) { o0[0] = last ? nvA[0][0] : cvA[0][0]; o0[1] = last ? nvA[0][1] : cvA[0][1]; o1[0] = last ? nvA[1][0] : cvA[1][0]; o1[1] = last ? nvA[1][1] : cvA[1][1]; }
            else { o0[0] = cvA[0][0]; o0[1] = cvA[0][1]; o1[0] = cvA[1][0]; o1[1] = cvA[1][1]; }
            GM_LDB(B0, 0, 0); GM_LDB(B1, 0, 1); GM_SCHED; GM_LDA(At, 0, 0); GM_STAGE(GM_SA(1, 1), a1, cvA[1]);
            GM_WAIT_V(8); GM_WAIT_L(0); GM_BAR; GM_MMA(0, 0, At, B0); GM_MMA(0, 1, At, B1); GM_BAR; GM_SCHED;
            GM_LDA(At, 0, 1); GM_STAGE(GM_SB(0, 0), b2, voffB); GM_STAGE(GM_SB(0, 1), b2 + HSTEP, voffB); GM_STAGE(GM_SA(0, 0), a2, o0);
            GM_WAIT_V(8); GM_WAIT_L(0); GM_BAR; GM_MMA(1, 0, At, B0); GM_MMA(1, 1, At, B1); GM_BAR; GM_SCHED;
            GM_LDB(B0, 1, 0); GM_LDB(B1, 1, 1); GM_SCHED; GM_LDA(At, 1, 0); GM_STAGE(GM_SA(0, 1), a2, o1);
            GM_WAIT_V(8); GM_WAIT_L(0); GM_BAR; GM_MMA(0, 0, At, B0); GM_MMA(0, 1, At, B1); GM_BAR; GM_SCHED;
            GM_LDA(At, 1, 1); GM_STAGE(GM_SB(1, 0), b3, voffB); GM_STAGE(GM_SB(1, 1), b3 + HSTEP, voffB); GM_STAGE(GM_SA(1, 0), a3, o0);
            GM_WAIT_V(8); GM_WAIT_L(0); GM_BAR; GM_MMA(1, 0, At, B0); GM_MMA(1, 1, At, B1); GM_BAR; GM_SCHED;
        }
        if (wr == 0) GM_BAR;
        if constexpr (Epi::PREF) E.epi(acc, cur, wr, wc, fr, fq, lds, ui & 1); else E(acc, cur, wr, wc, fr, fq);
        if (!has_next) break;
#pragma unroll
        for (int a = 0; a < 2; ++a)
#pragma unroll
            for (int b = 0; b < 2; ++b)
#pragma unroll
                for (int m = 0; m < 4; ++m)
#pragma unroll
                    for (int n = 0; n < 2; ++n) acc[a][b][m][n] = (f32x4){0.f, 0.f, 0.f, 0.f};
        cur = nxt; cA = nA; cB = nB; ++ui;
        if constexpr (GATHER) {
#pragma unroll
            for (int h = 0; h < 2; ++h)
#pragma unroll
                for (int i = 0; i < 2; ++i) cvA[h][i] = nvA[h][i];
        }
        if (wr == 1) GM_BAR;
    }
    GM_WAIT_V(0);
    GM_BAR;
#undef GM_SA
#undef GM_SB
#undef GM_STAGE
#undef GM_LDA
#undef GM_LDB
#undef GM_MMA
#undef GM_WAIT_V
#undef GM_WAIT_VE
#undef GM_WAIT_L
#undef GM_BAR
#undef GM_SCHED
}
}

struct Args { const float* in[23]; float* out; unsigned char* ws; int ph_lo, ph_hi; };
struct Frame {
    LAS unsigned char* lds;
    unsigned* ctl;
    unsigned char* ws;
    int tid, lane, wave, G, bid, wave0;
    const Args* a;
};
#define FIN(i) (F.a->in[i])
#define FRESH_IDS(F) do { int t_ = tid_of((F).wave0); asm volatile("" : "+v"(t_)); (F).tid = t_; (F).lane = t_ & 63; (F).wave = __builtin_amdgcn_readfirstlane(t_ >> 6); } while (0)
#define WSP(T, off) ((T*)(F.ws + (off)))

template <class T> __device__ __forceinline__ T ldg(const void* base, unsigned off) { return *(const T*)((const char*)base + off); }
template <class T> __device__ __forceinline__ void stg(void* base, unsigned off, T v) { *(T*)((char*)base + off) = v; }
typedef f32x4 Acc[2][2][4][2];

struct EpiZ { static constexpr bool PREF = false;
    static constexpr int MIN_VMEM = 16;
    bf16* Z; bf16* VT; float* vss;
    __device__ __forceinline__ void operator()(const Acc& acc, const gm::Unit& u, int wr, int wc, int fr, int fq) const {
        asm volatile("" : "+v"(fr), "+v"(fq));
        if (u.kind == 1) {
            bf16* base = VT + (size_t)((u.pn - 4) * 256) * NTOK + u.pm * 256; const unsigned lo = ((unsigned)(wr * 64 + fr) * NTOK + wc * 32 + 8 * fq) * 2u;
            float ss[2][8];
#pragma unroll
            for (int bj = 0; bj < 2; ++bj)
#pragma unroll
                for (int j = 0; j < 8; ++j) ss[bj][j] = 0.f;
#pragma unroll
            for (int ai = 0; ai < 2; ++ai)
#pragma unroll
                for (int m = 0; m < 4; ++m) {
#pragma unroll
                    for (int bj = 0; bj < 2; ++bj) { float v[8];
#pragma unroll
                        for (int j = 0; j < 8; ++j) { v[j] = gelu_tanh(acc[ai][bj][m][j >> 2][j & 3]); ss[bj][j] += v[j] * v[j]; }
                        u32x4 w; w.x = cvt_pk_bf16(v[0], v[1]); w.y = cvt_pk_bf16(v[2], v[3]); w.z = cvt_pk_bf16(v[4], v[5]); w.w = cvt_pk_bf16(v[6], v[7]);
                        stg<u32x4>(base, lo + (unsigned)((ai * 128 + m * 16) * NTOK + bj * 128) * 2u, w); }
                    asm volatile("" ::: "memory"); __builtin_amdgcn_sched_barrier(0); }
            float* vb = vss + u.pm * 256; const unsigned vo = (unsigned)(wc * 32 + 8 * fq) * 4u;
#pragma unroll
            for (int bj = 0; bj < 2; ++bj)
#pragma unroll
                for (int j = 0; j < 8; ++j) { float sv = ss[bj][j]; sv += __shfl_xor(sv, 1); sv += __shfl_xor(sv, 2); sv += __shfl_xor(sv, 4); sv += __shfl_xor(sv, 8); ss[bj][j] = sv; }
            if (fr == 0) {
#pragma unroll
                for (int bj = 0; bj < 2; ++bj)
#pragma unroll
                    for (int j = 0; j < 8; ++j) atomicAdd((float*)((char*)vb + vo + (bj * 128 + j) * 4), ss[bj][j]); }
        } else if (u.kind == 4) {
            const int j = u.pn < 16 ? u.pn - 12 : u.pn - 16;
            bf16* base = Z + (size_t)(u.pm * 256) * INC + Z_X + 128 * j; const unsigned lo = ((unsigned)(wr * 64 + fr) * INC + wc * 32 + 8 * fq) * 2u;
#pragma unroll
            for (int ai = 0; ai < 2; ++ai)
#pragma unroll
                for (int m = 0; m < 4; ++m) { const f32x4 o0 = acc[ai][0][m][0] * acc[ai][1][m][0], o1 = acc[ai][0][m][1] * acc[ai][1][m][1];
                    u32x4 w; w.x = cvt_pk_bf16(o0[0], o0[1]); w.y = cvt_pk_bf16(o0[2], o0[3]); w.z = cvt_pk_bf16(o1[0], o1[1]); w.w = cvt_pk_bf16(o1[2], o1[3]);
                    stg<u32x4>(base, lo + (unsigned)((ai * 128 + m * 16) * INC) * 2u, w); }
        } else if (u.kind == 0) rowmajor<0>(acc, u, wr, wc, fr, fq);
        else if (u.kind == 3) rowmajor<3>(acc, u, wr, wc, fr, fq);
        else rowmajor<2>(acc, u, wr, wc, fr, fq);
    }
    template <int KIND> __device__ __forceinline__ void rowmajor(const Acc& acc, const gm::Unit& u, int wr, int wc, int fr, int fq) const {
        bf16* base = Z + (size_t)(u.pm * 256) * INC + u.pn * 256; const unsigned lo = ((unsigned)(wr * 64 + fr) * INC + wc * 32 + 8 * fq) * 2u;
#pragma unroll
        for (int ai = 0; ai < 2; ++ai)
#pragma unroll
            for (int m = 0; m < 4; ++m) {
#pragma unroll
                for (int bj = 0; bj < 2; ++bj) { float v[8];
#pragma unroll
                    for (int j = 0; j < 8; ++j) { const float a = acc[ai][bj][m][j >> 2][j & 3]; v[j] = KIND == 0 ? gelu_tanh(a) : (KIND == 3 ? sigmoidf_fast(a) : a); }
                    u32x4 w; w.x = cvt_pk_bf16(v[0], v[1]); w.y = cvt_pk_bf16(v[2], v[3]); w.z = cvt_pk_bf16(v[4], v[5]); w.w = cvt_pk_bf16(v[6], v[7]);
                    stg<u32x4>(base, lo + (unsigned)((ai * 128 + m * 16) * INC + bj * 128) * 2u, w); }
                asm volatile("" ::: "memory"); __builtin_amdgcn_sched_barrier(0); }
    }
};
struct SchedZ {
    int G, c; const char* H; const char* W; unsigned* q;
    __device__ __forceinline__ unsigned* draw_ptr() const { return q + 16 * (c & 7); }
    __device__ __forceinline__ bool next(int j, gm::Unit& u) const {
        const int L = 8 * j + (c & 7); if (j < 0 || L >= 128 * 36) return false;
        int pm, pn; gm::tile_map(L, 128, 36, pm, pn);
        u.pm = pm; u.pn = pn; u.nt = 16; u.aux = 0;
        if (pn >= 4 && pn < 8) { u.A = W + (size_t)pn * gm::TSTEP; u.B = H + (size_t)pm * gm::TSTEP; u.kind = 1; }
        else { u.A = H + (size_t)pm * gm::TSTEP; u.B = W + (size_t)pn * gm::TSTEP; u.kind = pn < 4 ? 0 : (pn >= 24 ? 3 : (((pn >= 12 && pn < 16) || (pn >= 20 && pn < 24)) ? 4 : 2)); }
        return true;
    }
    __device__ __forceinline__ unsigned row_off(const gm::Unit&, int) const { return 0u; }
};

struct EpiMix { static constexpr bool PREF = false;
    static constexpr int MIN_VMEM = 16;
    const bf16* Z; bf16* MIX; const float* pscale;
    __device__ __forceinline__ void operator()(const Acc& acc, const gm::Unit& u, int wr, int wc, int fr, int fq) const {
        asm volatile("" : "+v"(fr), "+v"(fq));
        if (u.kind == 0) body<0>(acc, u, wr, wc, fr, fq); else if (u.kind == 1) body<1>(acc, u, wr, wc, fr, fq); else body<2>(acc, u, wr, wc, fr, fq);
    }
    template <int KIND> __device__ __forceinline__ void body(const Acc& acc, const gm::Unit& u, int wr, int wc, int fr, int fq) const {
        const int lr = wr * 64 + fr, lc = wc * 32 + 8 * fq;
        const bf16* zb = Z + (size_t)(u.pm * 256) * INC + (KIND == 0 ? Z_GA : (KIND == 1 ? Z_GC : Z_GB)) + u.pn * 256; const unsigned zo = ((unsigned)lr * INC + lc) * 2u;
        bf16* xb = MIX + (size_t)(u.pm * 256) * D + u.pn * 256; const unsigned xo = ((unsigned)lr * D + lc) * 2u;
        f32x4 ps[2][2];
#pragma unroll
        for (int bj = 0; bj < 2; ++bj)
#pragma unroll
            for (int n = 0; n < 2; ++n) ps[bj][n] = KIND == 2 ? ldg<f32x4>(pscale + u.pn * 256, (unsigned)(lc + bj * 128 + 4 * n) * 4u) : (f32x4){1.f, 1.f, 1.f, 1.f};
#pragma unroll
        for (int ai = 0; ai < 2; ++ai)
#pragma unroll
          for (int mp = 0; mp < 2; ++mp) {
            u32x4 gw[2][2], mw[2][2];
#pragma unroll
            for (int mm = 0; mm < 2; ++mm)
#pragma unroll
                for (int bj = 0; bj < 2; ++bj) { const unsigned ro = (unsigned)(ai * 128 + (2 * mp + mm) * 16);
                    gw[mm][bj] = ldg<u32x4>(zb, zo + (ro * INC + bj * 128) * 2u);
                    if (KIND != 0) mw[mm][bj] = ldg<u32x4>(xb, xo + (ro * D + bj * 128) * 2u); else mw[mm][bj] = (u32x4){0u, 0u, 0u, 0u}; }
#pragma unroll
            for (int mm = 0; mm < 2; ++mm)
#pragma unroll
                for (int bj = 0; bj < 2; ++bj) { const int m = 2 * mp + mm; const unsigned ro = (unsigned)(ai * 128 + m * 16); const u32x4 g = gw[mm][bj], q = mw[mm][bj];
                    f32x4 g0 = {bflo(g.x), bfhi(g.x), bflo(g.y), bfhi(g.y)}, g1 = {bflo(g.z), bfhi(g.z), bflo(g.w), bfhi(g.w)};
                    if (KIND == 2) { g0 *= ps[bj][0]; g1 *= ps[bj][1]; }
                    const f32x4 o0 = g0 * acc[ai][bj][m][0] + (f32x4){bflo(q.x), bfhi(q.x), bflo(q.y), bfhi(q.y)}, o1 = g1 * acc[ai][bj][m][1] + (f32x4){bflo(q.z), bfhi(q.z), bflo(q.w), bfhi(q.w)};
                    u32x4 w; w.x = cvt_pk_bf16(o0[0], o0[1]); w.y = cvt_pk_bf16(o0[2], o0[3]); w.z = cvt_pk_bf16(o1[0], o1[1]); w.w = cvt_pk_bf16(o1[2], o1[3]);
                    stg<u32x4>(xb, xo + (ro * D + bj * 128) * 2u, w); }
            asm volatile("" ::: "memory");
          }
    }
};
struct SchedMix {
    int G, c; const char *AIN, *CIN, *PIN, *WA, *WC, *WP;
    __device__ __forceinline__ bool next(int i, gm::Unit& u) const {
        const int rnd = i / 3, ty = i - rnd * 3; const int L = rnd * G + c; if (L >= 128 * 4) return false;
        int pm, pn; gm::tile_map(L, 128, 4, pm, pn);
        u.pm = pm; u.pn = pn; u.kind = ty; u.aux = 0;
        if (ty == 0) { u.A = AIN + (size_t)pm * gm::TSTEP; u.B = WA + (size_t)pn * gm::TSTEP; u.nt = 16; }
        else if (ty == 1) { u.A = CIN + (size_t)pm * gm::TSTEP; u.B = WC + (size_t)pn * gm::TSTEP; u.nt = 16; }
        else { u.A = PIN + (size_t)pm * gm::TSTEP + pn * 512; u.B = WP + (size_t)pn * gm::TSTEP + pn * 512; u.nt = 4; }
        return true;
    }
    __device__ __forceinline__ unsigned row_off(const gm::Unit&, int) const { return 0u; }
};

template <bool XF32> struct EpiOut { static constexpr bool PREF = false;
    static constexpr bool CHAIN = false;
    const void* xin; bf16* xout; const float* g1;
    __device__ __forceinline__ void operator()(const Acc& acc, const gm::Unit& u, int wr, int wc, int fr, int fq) const {
        asm volatile("" : "+v"(fr), "+v"(fq));
        const int lr = wr * 64 + fr, lc = wc * 32 + 8 * fq; const int b = u.pm / 16;
        bf16* ob = xout + (size_t)(u.pm * 256) * D + u.pn * 256; const unsigned xo = ((unsigned)lr * D + lc) * 2u;
        f32x4 gv[2][2];
#pragma unroll
        for (int bj = 0; bj < 2; ++bj)
#pragma unroll
            for (int n = 0; n < 2; ++n) gv[bj][n] = ldg<f32x4>(g1 + (size_t)b * 6 * D + u.pn * 256, (unsigned)(lc + bj * 128 + 4 * n) * 4u);
        if constexpr (XF32) {
            const float* ib = (const float*)xin + (size_t)(u.pm * 256) * D + u.pn * 256;
#pragma unroll
            for (int ai = 0; ai < 2; ++ai)
#pragma unroll
                for (int mp = 0; mp < 2; ++mp) {
                    f32x4 xv[2][2][2];
#pragma unroll
                    for (int mm = 0; mm < 2; ++mm)
#pragma unroll
                        for (int bj = 0; bj < 2; ++bj) { const unsigned o = 2u * xo + ((unsigned)(ai * 128 + (2 * mp + mm) * 16) * D + bj * 128) * 4u; xv[mm][bj][0] = ldg<f32x4>(ib, o); xv[mm][bj][1] = ldg<f32x4>(ib, o + 16u); }
#pragma unroll
                    for (int mm = 0; mm < 2; ++mm)
#pragma unroll
                        for (int bj = 0; bj < 2; ++bj) { const int m = 2 * mp + mm; const f32x4 o0 = xv[mm][bj][0] + gv[bj][0] * acc[ai][bj][m][0], o1 = xv[mm][bj][1] + gv[bj][1] * acc[ai][bj][m][1];
                            u32x4 w; w.x = cvt_pk_bf16(o0[0], o0[1]); w.y = cvt_pk_bf16(o0[2], o0[3]); w.z = cvt_pk_bf16(o1[0], o1[1]); w.w = cvt_pk_bf16(o1[2], o1[3]);
                            stg<u32x4>(ob, xo + ((unsigned)(ai * 128 + m * 16) * D + bj * 128) * 2u, w); }
                    asm volatile("" ::: "memory");
                }
        } else {
            const bf16* ib = (const bf16*)xin + (size_t)(u.pm * 256) * D + u.pn * 256;
#pragma unroll
            for (int ai = 0; ai < 2; ++ai) {
                u32x4 xv[4][2];
#pragma unroll
                for (int m = 0; m < 4; ++m)
#pragma unroll
                    for (int bj = 0; bj < 2; ++bj) xv[m][bj] = ldg<u32x4>(ib, xo + ((unsigned)(ai * 128 + m * 16) * D + bj * 128) * 2u);
#pragma unroll
                for (int m = 0; m < 4; ++m)
#pragma unroll
                    for (int bj = 0; bj < 2; ++bj) { const u32x4 q = xv[m][bj];
                        const f32x4 o0 = (f32x4){bflo(q.x), bfhi(q.x), bflo(q.y), bfhi(q.y)} + gv[bj][0] * acc[ai][bj][m][0], o1 = (f32x4){bflo(q.z), bfhi(q.z), bflo(q.w), bfhi(q.w)} + gv[bj][1] * acc[ai][bj][m][1];
                        u32x4 w; w.x = cvt_pk_bf16(o0[0], o0[1]); w.y = cvt_pk_bf16(o0[2], o0[3]); w.z = cvt_pk_bf16(o1[0], o1[1]); w.w = cvt_pk_bf16(o1[2], o1[3]);
                        stg<u32x4>(ob, xo + ((unsigned)(ai * 128 + m * 16) * D + bj * 128) * 2u, w); }
                asm volatile("" ::: "memory");
            }
        }
    }
};
struct SchedOut {
    int G, c; const char *MIXP, *WO;
    __device__ __forceinline__ bool next(int i, gm::Unit& u) const {
        const int L = i * G + c; if (L >= 128 * 4) return false;
        int pm, pn; gm::tile_map(L, 128, 4, pm, pn);
        u.pm = pm; u.pn = pn; u.kind = 0; u.aux = 0; u.nt = 16; u.A = MIXP + (size_t)pm * gm::TSTEP; u.B = WO + (size_t)pn * gm::TSTEP;
        return true;
    }
    __device__ __forceinline__ unsigned row_off(const gm::Unit&, int) const { return 0u; }
};

struct SchedMoe {
    int NG, r, x, npn; const LAS int* tb;
    const char* Abase; const char* Wbase; unsigned wstride;
    const int* LIST; bool gather;
    __device__ __forceinline__ bool next(int i, gm::Unit& u) const {
#define TB(i) __builtin_amdgcn_readfirstlane(tb[i])
        int j = i * NG + r;
        if (!gather) { const int tot = (TB(x) + TB(x + 8) + TB(x + 16) + TB(x + 24)) * npn; if (j >= tot) return false; j = tot - 1 - j; }
        int mt = j / npn; const int pn = j - mt * npn;
        int e = x; int T = TB(e);
        if (mt >= T) { mt -= T; e += 8; T = TB(e);
            if (mt >= T) { mt -= T; e += 8; T = TB(e);
                if (mt >= T) { mt -= T; e += 8; T = TB(e); if (mt >= T) return false; } } }
        u.aux = e; u.pn = pn; u.nt = 16; u.kind = TB(64 + e) - 256 * mt;
        const int arow = TB(32 + e) + 256 * mt;
        if (gather) { u.A = Abase; u.pm = arow; u.B = Wbase + (size_t)e * wstride + (size_t)pn * gm::TSTEP; }
        else { u.A = Abase + (size_t)arow * gm::PITCH; u.pm = 256 * mt; u.B = Wbase + (size_t)e * wstride + (size_t)pn * gm::TSTEP; }
        return true;
    }
    __device__ __forceinline__ unsigned row_off(const gm::Unit& u, int rr) const {
        const int mt256 = u.pm - TB(32 + u.aux);
        int slot = LIST[(size_t)u.aux * NTOK + mt256 + rr]; slot = (rr < u.kind) ? slot : 0;
        return (unsigned)(slot >> 2) * gm::PITCH;
    }
};
struct EpiGU { static constexpr bool PREF = true;
    static constexpr int MIN_VMEM = 8;
    bf16* ACT; const float* bgu;
    __device__ __forceinline__ void prefetch(const gm::Unit& u, LAS unsigned char* lds, int lane, int par) const {
        const char* bb = (const char*)(bgu + (size_t)u.aux * 2 * FF + u.pn * 128) + (lane < 32 ? lane * 16 : FF * 4 + (lane - 32) * 16);
        __builtin_amdgcn_global_load_lds((const unsigned*)bb, (LAS unsigned*)(lds + 131072 + par * 4096), 16, 0, 0);
    }
    __device__ __forceinline__ void epi(const Acc& acc, const gm::Unit& u, int wr, int wc, int fr, int fq, LAS unsigned char* lds, int par) const {
        asm volatile("" : "+v"(fr), "+v"(fq));
        const int lc = wc * 32 + 8 * fq;
        bf16* ab = ACT + (size_t)u.pm * FF + u.pn * 128; const unsigned ao = ((unsigned)(wr * 64 + fr) * FF + lc) * 2u;
        const LAS float* bl = (const LAS float*)(lds + 131072 + par * 4096);
        f32x4 bg[2], bu[2];
#pragma unroll
        for (int n = 0; n < 2; ++n) { bg[n] = *(const LAS f32x4*)(bl + lc + 4 * n); bu[n] = *(const LAS f32x4*)(bl + 128 + lc + 4 * n); }
#pragma unroll
        for (int ai = 0; ai < 2; ++ai)
#pragma unroll
            for (int m = 0; m < 4; ++m) { float o[8];
#pragma unroll
                for (int j = 0; j < 8; ++j) { float g = acc[ai][0][m][j >> 2][j & 3] + bg[j >> 2][j & 3], up = acc[ai][1][m][j >> 2][j & 3] + bu[j >> 2][j & 3];
                    g = fminf(g, 7.0f); up = fminf(fmaxf(up, -7.0f), 7.0f);
                    const float glu = g * __builtin_amdgcn_rcpf(1.0f + __builtin_amdgcn_exp2f(-1.702f * 1.44269504089f * g));
                    o[j] = (up + 1.0f) * glu; }
                u32x4 w; w.x = cvt_pk_bf16(o[0], o[1]); w.y = cvt_pk_bf16(o[2], o[3]); w.z = cvt_pk_bf16(o[4], o[5]); w.w = cvt_pk_bf16(o[6], o[7]);
                stg<u32x4>(ab, ao + (unsigned)((ai * 128 + m * 16) * FF) * 2u, w);
                asm volatile("" ::: "memory"); }
    }
};
struct EpiDown {
    static constexpr bool PREF = true;
    static constexpr int MIN_VMEM = 16;
    bf16* YB; const float* bdn; const int* LIST; const float* WL;
    __device__ __forceinline__ void prefetch(const gm::Unit& u, LAS unsigned char* lds, int lane, int par) const {
        const char* lb = (const char*)(LIST + (size_t)u.aux * NTOK + u.pm); const char* wb = (const char*)(WL + (size_t)u.aux * NTOK + u.pm);
        const char* bb = (const char*)(bdn + (size_t)u.aux * D + u.pn * 256);
        LAS unsigned char* dst = lds + 131072 + par * 4096;
        __builtin_amdgcn_global_load_lds((const unsigned*)(lb + lane * 16), (LAS unsigned*)dst, 16, 0, 0);
        __builtin_amdgcn_global_load_lds((const unsigned*)(wb + lane * 16), (LAS unsigned*)(dst + 1024), 16, 0, 0);
        __builtin_amdgcn_global_load_lds((const unsigned*)(bb + lane * 16), (LAS unsigned*)(dst + 2048), 16, 0, 0);
    }
    __device__ __forceinline__ void epi(const Acc& acc, const gm::Unit& u, int wr, int wc, int fr, int fq, LAS unsigned char* lds, int par) const {
        asm volatile("" : "+v"(fr), "+v"(fq));
        const int e = u.aux, lc = wc * 32 + 8 * fq, nvalid = u.kind, lr = wr * 64 + fr;
        const LAS int* sl = (const LAS int*)(lds + 131072 + par * 4096); const LAS float* wl = (const LAS float*)(lds + 131072 + par * 4096 + 1024); const LAS float* bl = (const LAS float*)(lds + 131072 + par * 4096 + 2048);
        bf16* yb = YB + u.pn * 256; (void)e;
        f32x4 bd[2][2];
#pragma unroll
        for (int bj = 0; bj < 2; ++bj)
#pragma unroll
            for (int n = 0; n < 2; ++n) bd[bj][n] = *(const LAS f32x4*)(bl + lc + bj * 128 + 4 * n);
        int slots[2][4]; float wts[2][4];
#pragma unroll
        for (int ai = 0; ai < 2; ++ai)
#pragma unroll
            for (int m = 0; m < 4; ++m) { const int r = lr + ai * 128 + m * 16; slots[ai][m] = sl[r]; wts[ai][m] = wl[r]; }
#pragma unroll
        for (int ai = 0; ai < 2; ++ai)
#pragma unroll
            for (int m = 0; m < 4; ++m) { const int r = lr + ai * 128 + m * 16;
                const unsigned slot = (r < nvalid) ? (unsigned)slots[ai][m] : (unsigned)(NTOK * TOPK); const float w = (r < nvalid) ? wts[ai][m] : 0.f;
#pragma unroll
                for (int bj = 0; bj < 2; ++bj) { const f32x4 y0 = (acc[ai][bj][m][0] + bd[bj][0]) * w, y1 = (acc[ai][bj][m][1] + bd[bj][1]) * w;
                    u32x4 o; o.x = cvt_pk_bf16(y0[0], y0[1]); o.y = cvt_pk_bf16(y0[2], y0[3]); o.z = cvt_pk_bf16(y1[0], y1[1]); o.w = cvt_pk_bf16(y1[2], y1[3]);
                    stg<u32x4>(yb, (slot * D + lc + bj * 128) * 2u, o); }
                asm volatile("" ::: "memory"); }
    }
};

__device__ __forceinline__ void tt_load(f32x4 (&tv)[16], const float* W, int N, int k0, int n0, int lane) {
#pragma unroll
    for (int i = 0; i < 16; ++i) tv[i] = ldg<f32x4>(W + (size_t)k0 * N + n0, ((unsigned)(i * 4 + (lane >> 4)) * (unsigned)N + 4u * (lane & 15)) * 4u);
}
__device__ __forceinline__ void tt_store(const f32x4 (&tv)[16], int k0, int n0, bf16* WT, int drow0, int dcol0, LAS float* scr, int lane) {
#pragma unroll
    for (int i = 0; i < 16; ++i) { const int kk = i * 4 + (lane >> 4); LAS float* p = scr + kk * 65 + 4 * (lane & 15); p[0] = tv[i].x; p[1] = tv[i].y; p[2] = tv[i].z; p[3] = tv[i].w; }
    asm volatile("s_waitcnt lgkmcnt(0)" ::: "memory");
    const int c = lane & 7;
#pragma unroll
    for (int j = 0; j < 8; ++j) { const int n = (lane >> 3) + 8 * j; const LAS float* s = scr + (8 * c) * 65 + n;
        u32x4 o; o.x = cvt_pk_bf16(s[0 * 65], s[1 * 65]); o.y = cvt_pk_bf16(s[2 * 65], s[3 * 65]); o.z = cvt_pk_bf16(s[4 * 65], s[5 * 65]); o.w = cvt_pk_bf16(s[6 * 65], s[7 * 65]);
        stg<u32x4>(WT + (size_t)(drow0 + n0) * 1024 + dcol0 + k0, ((unsigned)n * 1024u + 8u * c) * 2u, o);
        if (j & 1) __builtin_amdgcn_sched_barrier(0); }
    asm volatile("s_waitcnt lgkmcnt(0)" ::: "memory");
}
struct P0Item { const float* W; bf16* WT; int N, k0, n0, drow0, dcol0; };
__device__ __forceinline__ P0Item p0_decode(Frame& F, int it) {
    constexpr int I_GU = 16 * 32, I_DN = 16 * 16, I_IN = 16 * 144, I_SQ = 16 * 16, I_PL = 4 * 4;
    constexpr int N_GU = DEPTH * NE * I_GU, N_DN = DEPTH * NE * I_DN, N_IN = DEPTH * I_IN, N_SQ = DEPTH * I_SQ;
    P0Item t; t.dcol0 = 0; t.drow0 = 0;
    int r = it;
    if (r < N_GU) { const int mat = r / I_GU, q = r % I_GU, kb = q / 32, nb = q % 32, n0 = 64 * nb, half = n0 / FF, f0 = n0 % FF;
        t.W = FIN(18) + (size_t)mat * D * 2 * FF; t.N = 2 * FF; t.k0 = 64 * kb; t.n0 = n0; t.WT = WSP(bf16, WS_WTGU) + (size_t)mat * 2 * FF * D; t.drow0 = (f0 / 128) * 256 + 128 * half + (f0 % 128) - n0; return t; }
    r -= N_GU;
    if (r < N_DN) { const int mat = r / I_DN, q = r % I_DN, kb = q / 16, nb = q % 16;
        t.W = FIN(20) + (size_t)mat * FF * D; t.N = D; t.k0 = 64 * kb; t.n0 = 64 * nb; t.WT = WSP(bf16, WS_WTDN) + (size_t)mat * D * FF; return t; }
    r -= N_DN;
    if (r < N_IN) { const int mat = r / I_IN, q = r % I_IN, kb = q / 144, nb = q % 144;
        const int n0 = 64 * nb; int dr = n0;
        if (n0 >= Z_X && n0 < Z_X + D) { const int f = n0 - Z_X, j = f >> 7; dr = (j < 4 ? 12 + j : 16 + j) * 256 + (f & 127); }
        else if (n0 >= Z_C && n0 < Z_C + D) { const int f = n0 - Z_C, j = f >> 7; dr = (j < 4 ? 12 + j : 16 + j) * 256 + 128 + (f & 127); }
        t.W = FIN(5) + (size_t)mat * D * INC; t.N = INC; t.k0 = 64 * kb; t.n0 = n0; t.WT = WSP(bf16, WS_WTIN) + (size_t)mat * INC * D; t.drow0 = dr - n0; return t; }
    r -= N_IN;
    if (r < 3 * N_SQ) { const int which = r / N_SQ, q2 = r % N_SQ, mat = q2 / I_SQ, q = q2 % I_SQ, kb = q / 16, nb = q % 16;
        t.W = (which == 0 ? FIN(9) : (which == 1 ? FIN(13) : FIN(14))) + (size_t)mat * D * D;
        t.WT = WSP(bf16, which == 0 ? WS_WTA : (which == 1 ? WS_WTC : WS_WTO)) + (size_t)mat * D * D;
        t.N = D; t.k0 = 64 * kb; t.n0 = 64 * nb; return t; }
    r -= 3 * N_SQ;
    { const int mat = r / I_PL, q = r % I_PL, kb = q / 4, nb = q % 4, l = mat / 4, g = mat % 4;
        t.W = FIN(10) + (size_t)mat * 256 * 256; t.N = 256; t.k0 = 64 * kb; t.n0 = 64 * nb; t.WT = WSP(bf16, WS_WTPOOL) + (size_t)l * D * D; t.drow0 = g * 256; t.dcol0 = g * 256; }
    return t;
}
template <int MODE>
__device__ __forceinline__ void convert_items(Frame& F, unsigned* ctr, int l) {
    constexpr int I_GU = 16 * 32, I_DN = 16 * 16, I_IN = 16 * 144, I_SQ = 16 * 16, I_PL = 4 * 4;
    constexpr int N_GU = DEPTH * NE * I_GU, N_DN = DEPTH * NE * I_DN, N_IN = DEPTH * I_IN, N_SQ = DEPTH * I_SQ, N_PL = DEPTH * 4 * I_PL;
    constexpr int NMIX = I_IN + 3 * I_SQ + 4 * I_PL, NEXP = (N_GU + N_DN) / DEPTH;
    static_assert(NMIX % 8 == 0 && NEXP % 8 == 0 && (N_GU / DEPTH) % 8 == 0 && I_IN % 8 == 0 && I_SQ % 8 == 0, "chunks of eight (a chunk is whole or absent, and of one kind)");
    const int NV = MODE == 0 ? NMIX : NEXP + (l + 1 < DEPTH ? NMIX : 0);
    FRESH_IDS(F);
    LAS float* scr = (LAS float*)(F.lds + F.wave * 16640);
    LAS int* nbs = (LAS int*)(F.lds + LDSCTL_OFF + 64);
#define CV_MIX(L, v) ((v) < I_IN ? N_GU + N_DN + (L) * I_IN + (v) : ((v) - I_IN < 3 * I_SQ ? N_GU + N_DN + N_IN + (((v) - I_IN) / I_SQ) * N_SQ + (L) * I_SQ + ((v) - I_IN) % I_SQ : N_GU + N_DN + N_IN + 3 * N_SQ + (L) * 4 * I_PL + ((v) - I_IN - 3 * I_SQ)))
#define CV_ITEM(v) (MODE == 0 ? CV_MIX(0, (v)) : ((v) < N_GU / DEPTH ? l * (N_GU / DEPTH) + (v) : ((v) < NEXP ? N_GU + l * (N_DN / DEPTH) + (v) - N_GU / DEPTH : CV_MIX(l + 1, (v) - NEXP))))
    __syncthreads();
    if (F.tid == 0) { nbs[0] = (int)__hip_atomic_fetch_add(ctr, 8u, RLX_AGENT); nbs[1] = (int)__hip_atomic_fetch_add(ctr, 8u, RLX_AGENT); }
    __syncthreads();
    int cur = __builtin_amdgcn_readfirstlane(nbs[0]), nxt = __builtin_amdgcn_readfirstlane(nbs[1]);
    f32x4 ta[16], tb[16];
    if (cur < NV) { const P0Item t = p0_decode(F, CV_ITEM(cur + F.wave)); tt_load(ta, t.W, t.N, t.k0, t.n0, F.lane); }
#define P0_STEP(TC, TN, slot) { int nn = 0; if (F.tid == 0) nn = (int)__hip_atomic_fetch_add(ctr, 8u, RLX_AGENT); \
        if (nxt < NV) { const P0Item t = p0_decode(F, CV_ITEM(nxt + F.wave)); tt_load(TN, t.W, t.N, t.k0, t.n0, F.lane); } \
        { const P0Item t = p0_decode(F, CV_ITEM(cur + F.wave)); tt_store(TC, t.k0, t.n0, t.WT, t.drow0, t.dcol0, scr, F.lane); } \
        if (F.tid == 0) nbs[slot] = nn; \
        __syncthreads(); \
        cur = nxt; nxt = __builtin_amdgcn_readfirstlane(nbs[slot]); }
    while (cur < NV) {
        P0_STEP(ta, tb, 0)
        if (cur >= NV) break;
        P0_STEP(tb, ta, 1)
    }
#undef P0_STEP
#undef CV_ITEM
#undef CV_MIX
    __syncthreads();
}
__device__ __forceinline__ void p0_prologue(Frame& F) {
    FRESH_IDS(F);
    float* mods = WSP(float, WS_MODS);
    {
        LAS float* sil = (LAS float*)(F.lds + 65536);
        LAS f32x4* part = (LAS f32x4*)F.lds;
        {
            f32x4 cv4[4];
#pragma unroll
            for (int i = 0; i < 4; ++i) cv4[i] = ldg<f32x4>(FIN(1), (unsigned)(F.tid * 4 + i * 4 * NTHREADS) * 4u);
#pragma unroll
            for (int i = 0; i < 4; ++i) { f32x4 o;
#pragma unroll
                for (int j = 0; j < 4; ++j) o[j] = cv4[i][j] * __builtin_amdgcn_rcpf(1.0f + __builtin_amdgcn_exp2f(-1.44269504089f * cv4[i][j]));
                *(LAS f32x4*)(sil + F.tid * 4 + i * 4 * NTHREADS) = o; }
        }
        __syncthreads();
        for (int cb = F.bid; cb < 256; cb += F.G) {
            const int l = cb >> 7, colq = F.lane % 12, rsub = F.lane / 12, cbase = (cb & 127) * 48, k0 = F.wave * 128;
            const float* aw = FIN(3) + (size_t)l * D * 6 * D + cbase;
            f32x4 a[NB];
#pragma unroll
            for (int b = 0; b < NB; ++b) a[b] = (f32x4){0.f, 0.f, 0.f, 0.f};
#pragma unroll
            for (int jb = 0; jb < 2; ++jb) { f32x4 w[13]; int kk[13];
#pragma unroll
                for (int j = 0; j < 13; ++j) { const int k = k0 + 5 * (13 * jb + j) + rsub; kk[j] = k < k0 + 128 ? k : k0 + 127; w[j] = ldg<f32x4>(aw, ((unsigned)kk[j] * (6u * D) + 4u * colq) * 4u);
                    if (!(rsub < 5 && k < k0 + 128)) w[j] = (f32x4){0.f, 0.f, 0.f, 0.f}; }
#pragma unroll
                for (int j = 0; j < 13; ++j) {
#pragma unroll
                    for (int b = 0; b < NB; ++b) a[b] += w[j] * sil[b * D + kk[j]];
                    __builtin_amdgcn_sched_barrier(0); } }
#pragma unroll
            for (int b = 0; b < NB; ++b) part[(F.wave * 64 + F.lane) * NB + b] = a[b];
            __syncthreads();
            if (F.tid < 96) { const int b = F.tid / 12, cq = F.tid % 12;
                f32x4 sum = ldg<f32x4>(FIN(4) + (size_t)l * 6 * D + cbase, (unsigned)(4 * cq) * 4u);
#pragma unroll
                for (int w = 0; w < 8; ++w) {
#pragma unroll
                    for (int rs = 0; rs < 5; ++rs) sum += part[(w * 64 + cq + 12 * rs) * NB + b];
                    __builtin_amdgcn_sched_barrier(0); }
                stg<f32x4>(mods + (size_t)l * NB * 6 * D + cbase, ((unsigned)b * (6u * D) + 4u * cq) * 4u, sum); }
            __syncthreads();
        }
    }
    {
        const int gt = F.bid * NTHREADS + F.tid, NGT = F.G * NTHREADS;
        for (int p = gt; p < DEPTH * 8 * CHUNK * 16; p += NGT) { const int kc = p & 15, t = (p >> 4) & 127, hh = p >> 11;
            const float* wrow = FIN(7) + (size_t)hh * CHUNK * CHUNK + t * CHUNK + 8 * kc;
            const f32x4 a = *(const f32x4*)wrow, c = *(const f32x4*)(wrow + 4); float v[8] = {a.x, a.y, a.z, a.w, c.x, c.y, c.z, c.w};
#pragma unroll
            for (int j = 0; j < 8; ++j) v[j] = (8 * kc + j <= t) ? v[j] : 0.f;
            u32x4 w; w.x = cvt_pk_bf16(v[0], v[1]); w.y = cvt_pk_bf16(v[2], v[3]); w.z = cvt_pk_bf16(v[4], v[5]); w.w = cvt_pk_bf16(v[6], v[7]);
            *(u32x4*)(F.ws + WS_WIMG + (size_t)hh * 32768 + t * 256 + ((kc ^ (t & 15)) << 4)) = w; }
    }
    convert_items<0>(F, F.ctl + CW_P0CTR, 0);
}

#define NCOL(j) (512 * ((j) >> 1) + 8 * lane + 4 * ((j) & 1))
struct RowBuf { f32x4 x[4]; u32x4 xb[2]; u32x4 y[2][4]; };
template <bool HASY>
__device__ __forceinline__ void row_load(RowBuf& R, const void* xin, const bf16* yb, int row, int lane) {
    if (HASY) {
#pragma unroll
        for (int jj = 0; jj < 2; ++jj) R.xb[jj] = *(const u32x4*)((const bf16*)xin + (size_t)row * D + 512 * jj + 8 * lane);
#pragma unroll
        for (int jj = 0; jj < 2; ++jj)
#pragma unroll
            for (int k = 0; k < TOPK; ++k) R.y[jj][k] = *(const u32x4*)(yb + ((size_t)row * TOPK + k) * D + 512 * jj + 8 * lane);
    } else {
#pragma unroll
        for (int j = 0; j < 4; ++j) R.x[j] = *(const f32x4*)((const float*)xin + (size_t)row * D + NCOL(j));
    }
}
__device__ __forceinline__ f32x4 unpack_half4(u32x4 w, int half) { return half ? (f32x4){bflo(w.z), bfhi(w.z), bflo(w.w), bfhi(w.w)} : (f32x4){bflo(w.x), bfhi(w.x), bflo(w.y), bfhi(w.y)}; }
template <int MODE, bool HASY>
__device__ __forceinline__ void norm_rows(Frame& F, const void* xin, const bf16* yb, const float* g2, bf16* xst, const float* gn, const float* sc, const float* sh, bf16* hout, float* fout) {
    FRESH_IDS(F);
    const int gw = F.bid * NWAVES + F.wave, NGW = F.G * NWAVES, lane = F.lane;
    f32x4 gnv[4], g2v[4], scv[4], shv[4]; int bcur = -1;
#pragma unroll
    for (int j = 0; j < 4; ++j) gnv[j] = *(const f32x4*)(gn + NCOL(j));
    RowBuf R0, R1;
    int row = gw;
    if (row < NTOK) row_load<HASY>(R0, xin, yb, row, lane);
#define NORM_PROCESS(R, row_) do { const int b = (row_) / SEQ; const size_t ro = (size_t)(row_) * D; \
        if (b != bcur) { bcur = b; _Pragma("unroll") for (int j = 0; j < 4; ++j) { const int col = NCOL(j); \
            if (HASY) g2v[j] = *(const f32x4*)(g2 + (size_t)b * 6 * D + col); \
            if (MODE == 0) { scv[j] = *(const f32x4*)(sc + (size_t)b * 6 * D + col); shv[j] = *(const f32x4*)(sh + (size_t)b * 6 * D + col); } } } \
        f32x4 v[4]; float s = 0.f; \
        _Pragma("unroll") for (int j = 0; j < 4; ++j) { \
            if (HASY) { f32x4 ys = unpack_half4((R).y[j >> 1][0], j & 1); _Pragma("unroll") for (int k = 1; k < TOPK; ++k) ys += unpack_half4((R).y[j >> 1][k], j & 1); v[j] = unpack_half4((R).xb[j >> 1], j & 1) + g2v[j] * ys; } \
            else v[j] = (R).x[j]; \
            s += (v[j].x * v[j].x + v[j].y * v[j].y) + (v[j].z * v[j].z + v[j].w * v[j].w); } \
        if (xst) { _Pragma("unroll") for (int jj = 0; jj < 2; ++jj) { u32x4 w; w.x = cvt_pk_bf16(v[2 * jj].x, v[2 * jj].y); w.y = cvt_pk_bf16(v[2 * jj].z, v[2 * jj].w); w.z = cvt_pk_bf16(v[2 * jj + 1].x, v[2 * jj + 1].y); w.w = cvt_pk_bf16(v[2 * jj + 1].z, v[2 * jj + 1].w); \
            *(u32x4*)(xst + ro + 512 * jj + 8 * lane) = w; } } \
        const float rstd = 1.0f / sqrtf(wave_sum(s) * (1.0f / D) + RMS_EPS); \
        if (MODE == 0) { _Pragma("unroll") for (int jj = 0; jj < 2; ++jj) { \
            const f32x4 o0 = v[2 * jj] * rstd * gnv[2 * jj] * (scv[2 * jj] + 1.0f) + shv[2 * jj], o1 = v[2 * jj + 1] * rstd * gnv[2 * jj + 1] * (scv[2 * jj + 1] + 1.0f) + shv[2 * jj + 1]; \
            u32x4 w; w.x = cvt_pk_bf16(o0.x, o0.y); w.y = cvt_pk_bf16(o0.z, o0.w); w.z = cvt_pk_bf16(o1.x, o1.y); w.w = cvt_pk_bf16(o1.z, o1.w); *(u32x4*)(hout + ro + 512 * jj + 8 * lane) = w; } } \
        else { _Pragma("unroll") for (int j = 0; j < 4; ++j) *(f32x4*)(fout + ro + NCOL(j)) = v[j] * rstd * gnv[j]; } } while (0)
    while (row < NTOK) {
        const int r1 = row + NGW;
        if (r1 < NTOK) row_load<HASY>(R1, xin, yb, r1, lane);
        NORM_PROCESS(R0, row);
        if (r1 >= NTOK) break;
        const int r2 = r1 + NGW;
        if (r2 < NTOK) row_load<HASY>(R0, xin, yb, r2, lane);
        NORM_PROCESS(R1, r1);
        row = r2;
    }
#undef NORM_PROCESS
#undef NCOL
}

__device__ __forceinline__ void router_prep(Frame& F) {
    FRESH_IDS(F);
    const float* mods = WSP(float, WS_MODS); bf16* rwh = WSP(bf16, WS_RWT); bf16* rwl = WSP(bf16, WS_RWT + 1 * MiB); float* rb = WSP(float, WS_RBIAS);
    const int gt = F.bid * NTHREADS + F.tid, NGT = F.G * NTHREADS;
    for (int i0 = gt; i0 < DEPTH * NB * NE * D; i0 += 4 * NGT) {
        float gv[4], mv[4], rv[4];
#pragma unroll
        for (int j = 0; j < 4; ++j) { const int i = i0 + j * NGT; const bool ok = i < DEPTH * NB * NE * D; const int ii = ok ? i : gt;
            const int k = ii % D, e = (ii / D) % NE, b = (ii / (D * NE)) % NB, l = ii / (D * NE * NB);
            gv[j] = FIN(15)[l * D + k]; mv[j] = mods[((size_t)l * NB + b) * 6 * D + 4 * D + k]; rv[j] = FIN(16)[((size_t)l * D + k) * NE + e]; }
#pragma unroll
        for (int j = 0; j < 4; ++j) { const int i = i0 + j * NGT; if (i < DEPTH * NB * NE * D) {
            const float w = gv[j] * (1.0f + mv[j]) * rv[j];
            const unsigned hi = cvt_pk_bf16(w, 0.f) & 0xffffu, lo = cvt_pk_bf16(w - __uint_as_float(hi << 16), 0.f) & 0xffffu;
            rwh[i] = (bf16)hi; rwl[i] = (bf16)lo; } }
    }
    if (F.wave < 2) {
        for (int o = F.bid * 2 + F.wave; o < DEPTH * NB * NE; o += F.G * 2) { const int e = o % NE, b = (o / NE) % NB, l = o / (NE * NB);
            float mv[16], rv[16];
#pragma unroll
            for (int j = 0; j < 16; ++j) { const int k = F.lane + 64 * j; mv[j] = mods[((size_t)l * NB + b) * 6 * D + 3 * D + k]; rv[j] = FIN(16)[((size_t)l * D + k) * NE + e]; }
            float s = 0.f;
#pragma unroll
            for (int j = 0; j < 16; ++j) s += mv[j] * rv[j];
            s = wave_sum(s); if (F.lane == 0) rb[o] = s + FIN(17)[l * NE + e]; }
    }
}

__device__ __forceinline__ void mixer_prep(Frame& F, int l) {
    FRESH_IDS(F);
    const bf16* Z = WSP(bf16, WS_Z); const bf16* VT = WSP(bf16, WS_VT); const float* vss = WSP(float, WS_VSS) + (size_t)l * NTOK;
    bf16* AIN = WSP(bf16, WS_AIN); bf16* CIN = WSP(bf16, WS_CIN); bf16* PIN = WSP(bf16, WS_PIN);
    const float* convw = FIN(12) + (size_t)l * 3 * D; const float* gng = FIN(6) + (size_t)l * D; const char* wimg = (const char*)(F.ws + WS_WIMG) + (size_t)l * 8 * 32768; const float* bs = FIN(8) + (size_t)l * 8 * CHUNK;
    LAS unsigned char* Abuf = F.lds; LAS unsigned char* Bimg = F.lds + 65536; LAS float* rs = (LAS float*)(F.lds + 98304);
    for (int chunk = F.bid; chunk < NTOK / CHUNK; chunk += F.G) {
        const int tok0 = chunk * CHUNK, pos0 = tok0 % SEQ;
        FRESH_IDS(F);
        int tid = F.tid, lane = F.lane, wave = F.wave;
        {
            const int cg = (wave & 1) * 64 + lane, rsq = wave >> 1, t0 = 32 * rsq; const unsigned c0b = 16u * (unsigned)cg;
            float w0[8], w1[8], w2[8];
#pragma unroll
            for (int j = 0; j < 8; ++j) { w0[j] = ldg<float>(convw, 2 * c0b + 4 * j); w1[j] = ldg<float>(convw + D, 2 * c0b + 4 * j); w2[j] = ldg<float>(convw + 2 * D, 2 * c0b + 4 * j); }
            float p2[8], p1[8];
#pragma unroll
            for (int j = 0; j < 8; ++j) { p2[j] = 0.f; p1[j] = 0.f; }
            if (pos0 + t0 >= 2) {
#pragma unroll
                for (int q = 0; q < 2; ++q) { const bf16* zr = Z + (size_t)(tok0 + t0 - 2 + q) * INC; const u32x4 xv = ldg<u32x4>(zr + Z_X, c0b);
                    const unsigned xa[4] = {xv.x, xv.y, xv.z, xv.w};
#pragma unroll
                    for (int j = 0; j < 4; ++j) { const float a = bflo(xa[j]), bq = bfhi(xa[j]);
                        if (q == 0) { p2[2 * j] = a; p2[2 * j + 1] = bq; } else { p1[2 * j] = a; p1[2 * j + 1] = bq; } } }
            }
            const int pwin = 2 << (cg >> 5);
            float sw[8];
#pragma unroll
            for (int j = 0; j < 8; ++j) sw[j] = 0.f;
            for (int q = 1; q < 16; ++q) { if (q < pwin && pos0 + t0 - q >= 0) { const u32x4 pv = ldg<u32x4>(Z + (size_t)(tok0 + t0 - q) * INC + Z_P, c0b); const unsigned pa[4] = {pv.x, pv.y, pv.z, pv.w};
#pragma unroll
                    for (int j = 0; j < 4; ++j) { sw[2 * j] += bflo(pa[j]); sw[2 * j + 1] += bfhi(pa[j]); } } }
#pragma unroll 1
            for (int tb = t0; tb < t0 + 32; tb += 4) {
                u32x4 xv4[4], bv4[4], pv4[4], qv4[4];
#pragma unroll
                for (int r = 0; r < 4; ++r) { const bf16* zr = Z + (size_t)(tok0 + tb + r) * INC; const int pos = pos0 + tb + r;
                    xv4[r] = ldg<u32x4>(zr + Z_X, c0b); bv4[r] = ldg<u32x4>(zr + Z_B, c0b); pv4[r] = ldg<u32x4>(zr + Z_P, c0b);
                    const int back = (pos - (pwin - 1) >= 0) ? (pwin - 1) : 0;
                    qv4[r] = ldg<u32x4>(zr + Z_P - (ptrdiff_t)back * INC, c0b); }
#pragma unroll
                for (int r = 0; r < 4; ++r) { const int t = tb + r, pos = pos0 + t;
                    const unsigned xa[4] = {xv4[r].x, xv4[r].y, xv4[r].z, xv4[r].w}, ba[4] = {bv4[r].x, bv4[r].y, bv4[r].z, bv4[r].w},
                                   pa[4] = {pv4[r].x, pv4[r].y, pv4[r].z, pv4[r].w}, qa[4] = {qv4[r].x, qv4[r].y, qv4[r].z, qv4[r].w};
                    float zc[8], o[8], pf[8];
#pragma unroll
                    for (int j = 0; j < 4; ++j) { zc[2 * j] = bflo(xa[j]); zc[2 * j + 1] = bfhi(xa[j]); pf[2 * j] = bflo(pa[j]); pf[2 * j + 1] = bfhi(pa[j]); }
#pragma unroll
                    for (int j = 0; j < 8; ++j) { const float cvv = w0[j] * p2[j] + w1[j] * p1[j] + w2[j] * zc[j]; const float bb = (j & 1) ? bfhi(ba[j >> 1]) : bflo(ba[j >> 1]); o[j] = bb * cvv; p2[j] = p1[j]; p1[j] = zc[j]; }
                    u32x4 w; w.x = cvt_pk_bf16(o[0], o[1]); w.y = cvt_pk_bf16(o[2], o[3]); w.z = cvt_pk_bf16(o[4], o[5]); w.w = cvt_pk_bf16(o[6], o[7]);
                    stg<u32x4>(CIN + (size_t)(tok0 + t) * D, c0b, w);
                    const float inv = 1.0f / (float)((pos + 1) < pwin ? (pos + 1) : pwin);
#pragma unroll
                    for (int j = 0; j < 8; ++j) { sw[j] += pf[j]; o[j] = sw[j] * inv - pf[j]; }
                    w.x = cvt_pk_bf16(o[0], o[1]); w.y = cvt_pk_bf16(o[2], o[3]); w.z = cvt_pk_bf16(o[4], o[5]); w.w = cvt_pk_bf16(o[6], o[7]);
                    stg<u32x4>(PIN + (size_t)(tok0 + t) * D, c0b, w);
                    const float qm = (pos - (pwin - 1) >= 0) ? 1.0f : 0.0f;
#pragma unroll
                    for (int j = 0; j < 4; ++j) { sw[2 * j] -= qm * bflo(qa[j]); sw[2 * j + 1] -= qm * bfhi(qa[j]); } }
            }
        }
        FRESH_IDS(F); tid = F.tid; lane = F.lane; wave = F.wave;
        if (tid < CHUNK) rs[tid] = 1.0f / sqrtf(vss[tok0 + tid] * (1.0f / D) + RMS_EPS);
        u32x4 gvv[4];
        const int tq = tid >> 4, kc = tid & 15;
        const unsigned voff = ((unsigned)tq * NTOK + 8u * kc) * 2u;
#define GM_PREFETCH(h_) do { const char* wih = wimg + (size_t)(h_) * 32768 + (unsigned)tid * 16u; const bf16* vth = VT + (size_t)(h_) * CHUNK * NTOK + tok0; \
            _Pragma("unroll") for (int i = 0; i < 4; ++i) __builtin_amdgcn_global_load_lds((const unsigned*)(wih + i * 8192), (LAS unsigned*)(Abuf + ((h_) & 1) * 32768 + i * 8192 + wave * 1024), 16, 0, 0); \
            asm volatile("" ::: "memory");     \
            _Pragma("unroll") for (int i = 0; i < 4; ++i) gvv[i] = ldg<u32x4>(vth + (size_t)32 * i * NTOK, voff); } while (0)
        const int wr = wave >> 1, wc = wave & 1, fr = lane & 15, fq = lane >> 4;
        u32x4 uwA[2][2], uwB[2][2]; f32x4 ggA[4], ggB[4]; float btA[2], btB[2];
#define GM_EPI_LOAD(h_, UW, GG, BT) do { const unsigned coff_ = (unsigned)((h_) * CHUNK + 64 * wc + 16 * fq); \
            _Pragma("unroll") for (int n = 0; n < 4; ++n) GG[n] = ldg<f32x4>(gng, (coff_ + 4 * n) * 4u); \
            _Pragma("unroll") for (int m = 0; m < 2; ++m) { const int t = 32 * wr + 16 * m + fr; BT[m] = ldg<float>(bs, (unsigned)((h_) * CHUNK + t) * 4u); \
                _Pragma("unroll") for (int n = 0; n < 2; ++n) UW[m][n] = ldg<u32x4>(Z + (size_t)tok0 * INC + Z_U, ((unsigned)t * INC + coff_ + 8 * n) * 2u); } } while (0)
#define GM_HEAD(h, UW, GG, BT, UWN, GGN, BTN) do { \
            const LAS unsigned char* Aimg = Abuf + ((h) & 1) * 32768; \
            _Pragma("unroll") for (int i = 0; i < 4; ++i) { const int t = tq + 32 * i; const u32x4 g = gvv[i]; \
                u32x4 w; w.x = cvt_pk_bf16(bflo(g.x) * rsv[0], bfhi(g.x) * rsv[1]); w.y = cvt_pk_bf16(bflo(g.y) * rsv[2], bfhi(g.y) * rsv[3]); \
                w.z = cvt_pk_bf16(bflo(g.z) * rsv[4], bfhi(g.z) * rsv[5]); w.w = cvt_pk_bf16(bflo(g.w) * rsv[6], bfhi(g.w) * rsv[7]); \
                const int tp = (t & ~60) | ((t & 12) << 2) | ((t & 48) >> 2); *(LAS u32x4*)(Bimg + tp * 256 + ((kc ^ (tp & 15)) << 4)) = w; }     \
            __syncthreads(); \
            if ((h) + 1 < 8) { GM_PREFETCH((h) + 1); GM_EPI_LOAD((h) + 1, UWN, GGN, BTN); } \
            const unsigned coff = (unsigned)((h) * CHUNK + 64 * wc + 16 * fq);     \
            f32x4 acc[2][4]; \
            _Pragma("unroll") for (int m = 0; m < 2; ++m) _Pragma("unroll") for (int n = 0; n < 4; ++n) acc[m][n] = (f32x4){0.f, 0.f, 0.f, 0.f}; \
            for (int kk = 0; kk <= wr; ++kk) { \
                bf16x8 a[2], bq[4]; \
                _Pragma("unroll") for (int m = 0; m < 2; ++m) { const int row = 32 * wr + 16 * m + fr; a[m] = *(const LAS bf16x8*)(Aimg + row * 256 + (((4 * kk + fq) ^ (row & 15)) << 4)); } \
                _Pragma("unroll") for (int n = 0; n < 4; ++n) { const int row = 64 * wc + 16 * n + fr; bq[n] = *(const LAS bf16x8*)(Bimg + row * 256 + (((4 * kk + fq) ^ (row & 15)) << 4)); } \
                _Pragma("unroll") for (int m = 0; m < 2; ++m) _Pragma("unroll") for (int n = 0; n < 4; ++n) acc[m][n] = __builtin_amdgcn_mfma_f32_16x16x32_bf16(bq[n], a[m], acc[m][n], 0, 0, 0); \
            } \
            _Pragma("unroll") for (int m = 0; m < 2; ++m) { const int t = 32 * wr + 16 * m + fr; \
                _Pragma("unroll") for (int n = 0; n < 2; ++n) { const u32x4 uq = UW[m][n]; \
                    const f32x4 u0 = {bflo(uq.x), bfhi(uq.x), bflo(uq.y), bfhi(uq.y)}, u1 = {bflo(uq.z), bfhi(uq.z), bflo(uq.w), bfhi(uq.w)}; \
                    const f32x4 o0 = u0 * (acc[m][2 * n] * GG[2 * n] + BT[m]), o1 = u1 * (acc[m][2 * n + 1] * GG[2 * n + 1] + BT[m]); \
                    u32x4 w; w.x = cvt_pk_bf16(o0.x, o0.y); w.y = cvt_pk_bf16(o0.z, o0.w); w.z = cvt_pk_bf16(o1.x, o1.y); w.w = cvt_pk_bf16(o1.z, o1.w); \
                    stg<u32x4>(AIN + (size_t)tok0 * D, ((unsigned)t * D + coff + 8 * n) * 2u, w); } } \
            __syncthreads(); } while (0)
        GM_PREFETCH(0); GM_EPI_LOAD(0, uwA, ggA, btA);
        __syncthreads();
        float rsv[8];
#pragma unroll
        for (int j = 0; j < 8; ++j) rsv[j] = rs[8 * kc + j];
#pragma unroll 1
        for (int h = 0; h < 8; h += 2) {
            GM_HEAD(h, uwA, ggA, btA, uwB, ggB, btB);
            GM_HEAD(h + 1, uwB, ggB, btB, uwA, ggA, btA);
        }
#undef GM_HEAD
#undef GM_EPI_LOAD
#undef GM_PREFETCH
    }
}

__device__ __forceinline__ void router_phase(Frame& F, int l) {
    FRESH_IDS(F);
    const bf16* X = WSP(bf16, WS_XRES); const float* mods = WSP(float, WS_MODS) + (size_t)l * NB * 6 * D; const float* g2n = FIN(15) + (size_t)l * D;
    const bf16* rwh = WSP(bf16, WS_RWT) + (size_t)l * NB * NE * D; const float* rbias = WSP(float, WS_RBIAS) + (size_t)l * NB * NE;
    bf16* H = WSP(bf16, WS_H); int* LIST = WSP(int, WS_LIST); float* WL = WSP(float, WS_WLIST); unsigned* cnt = F.ctl + CW_CNT + l * NE;
    LAS float* lg = (LAS float*)(F.lds) + F.wave * (16 * 33);
    LAS float* rsd = (LAS float*)(F.lds + 17408) + F.wave * 16;
    LAS int* te = (LAS int*)(F.lds + 18432);
    LAS float* tw = (LAS float*)(F.lds + 20480);
    LAS unsigned* hist = (LAS unsigned*)(F.lds + 22528);
    LAS unsigned* base = (LAS unsigned*)(F.lds + 22656);
    const int lane = F.lane, tid = F.tid, q = lane >> 4, r = lane & 15;
    if (tid < 32) hist[tid] = 0u;
    __syncthreads();
    for (int tile = F.bid; tile < NTOK / 128; tile += F.G) {
        const int tok0 = tile * 128 + F.wave * 16, b = tok0 / SEQ;
        u32x4 xr[32];
#pragma unroll
        for (int J = 0; J < 32; ++J) xr[J] = ldg<u32x4>(X + (size_t)tok0 * D, ((unsigned)r * D + 8u * q + 32u * J) * 2u);
        {
            const char* wsrc = (const char*)(rwh + (size_t)b * NE * D);
#pragma unroll
            for (int i = 0; i < 16; ++i) { const int idx = F.wave * 16 + i, hl = idx >> 6, row = (idx >> 1) & 31, hf = idx & 1;
                __builtin_amdgcn_global_load_lds((const unsigned*)(wsrc + (size_t)hl * MiB + row * 2048 + hf * 1024 + lane * 16), (LAS unsigned*)(F.lds + hl * 66048 + row * 2064 + hf * 1024), 16, 0, 0); }
            asm volatile("s_waitcnt vmcnt(0)" ::: "memory");
            __syncthreads();
        }
        const LAS unsigned char* wl = F.lds + r * 2064 + 16 * q;
        f32x4 acc0 = {0.f, 0.f, 0.f, 0.f}, acc1 = {0.f, 0.f, 0.f, 0.f}; float ss = 0.f;
#pragma unroll
        for (int J = 0; J < 32; ++J) {
            const bf16x8 h0 = *(const LAS bf16x8*)(wl + 64 * J), h1 = *(const LAS bf16x8*)(wl + 16 * 2064 + 64 * J), l0 = *(const LAS bf16x8*)(wl + 66048 + 64 * J), l1 = *(const LAS bf16x8*)(wl + 66048 + 16 * 2064 + 64 * J);
            const u32x4 xw = xr[J]; const bf16x8 xf = __builtin_bit_cast(bf16x8, xw);
            const f32x4 x0 = {bflo(xw.x), bfhi(xw.x), bflo(xw.y), bfhi(xw.y)}, x1 = {bflo(xw.z), bfhi(xw.z), bflo(xw.w), bfhi(xw.w)};
            ss += ((x0.x * x0.x + x0.y * x0.y) + (x0.z * x0.z + x0.w * x0.w)) + ((x1.x * x1.x + x1.y * x1.y) + (x1.z * x1.z + x1.w * x1.w));
            acc0 = __builtin_amdgcn_mfma_f32_16x16x32_bf16(xf, h0, acc0, 0, 0, 0); acc1 = __builtin_amdgcn_mfma_f32_16x16x32_bf16(xf, h1, acc1, 0, 0, 0);
            acc0 = __builtin_amdgcn_mfma_f32_16x16x32_bf16(xf, l0, acc0, 0, 0, 0); acc1 = __builtin_amdgcn_mfma_f32_16x16x32_bf16(xf, l1, acc1, 0, 0, 0);
            if ((J & 3) == 3) __builtin_amdgcn_sched_barrier(0); }
        ss += __shfl_xor(ss, 16); ss += __shfl_xor(ss, 32);
        __syncthreads();
        if (tid < 32) hist[tid] = 0u;
        const float rstd = 1.0f / sqrtf(ss * (1.0f / D) + RMS_EPS);
#pragma unroll
        for (int g = 0; g < 4; ++g) { lg[(4 * q + g) * 33 + r] = acc0[g]; lg[(4 * q + g) * 33 + 16 + r] = acc1[g]; }
        if (lane < 16) rsd[lane] = rstd;
        __syncthreads();
        if (lane < 16) {
            float v[NE]; const float rsv = rsd[lane];
#pragma unroll
            for (int e = 0; e < NE; ++e) v[e] = lg[lane * 33 + e] * rsv + rbias[b * NE + e];
            float tv[TOPK]; int ti[TOPK];
#pragma unroll
            for (int k = 0; k < TOPK; ++k) { float best = v[0]; int bi = 0;
#pragma unroll
                for (int e = 1; e < NE; ++e) { if (v[e] > best) { best = v[e]; bi = e; } }
                tv[k] = best; ti[k] = bi;
#pragma unroll
                for (int e = 0; e < NE; ++e) v[e] = (e == bi) ? -3.0e38f : v[e]; }
            float p[TOPK], ps = 0.f;
#pragma unroll
            for (int k = 0; k < TOPK; ++k) { p[k] = __expf(tv[k] - tv[0]); ps += p[k]; }
            const float inv = 1.0f / ps;
#pragma unroll
            for (int k = 0; k < TOPK; ++k) { te[(F.wave * 16 + lane) * 4 + k] = ti[k]; tw[(F.wave * 16 + lane) * 4 + k] = p[k] * inv; }
        }
        {
            f32x4 gmul[4], gadd[4];
#pragma unroll
            for (int j = 0; j < 4; ++j) { const int col = 256 * j + 4 * lane; const f32x4 g = *(const f32x4*)(g2n + col), scv = *(const f32x4*)(mods + (size_t)b * 6 * D + 4 * D + col);
                gmul[j] = g * (scv + 1.0f); gadd[j] = *(const f32x4*)(mods + (size_t)b * 6 * D + 3 * D + col); }
            u32x2 xa0[4], xa1[4];
#pragma unroll
            for (int j = 0; j < 4; ++j) xa0[j] = *(const u32x2*)(X + (size_t)tok0 * D + 256 * j + 4 * lane);
#pragma unroll
            for (int i = 0; i < 16; i += 2) {
#pragma unroll
                for (int j = 0; j < 4; ++j) xa1[j] = *(const u32x2*)(X + (size_t)(tok0 + i + 1) * D + 256 * j + 4 * lane);
                { const float rsv = rsd[i];
#pragma unroll
                  for (int j = 0; j < 4; ++j) { const f32x4 o = unpack_lo4(xa0[j]) * rsv * gmul[j] + gadd[j]; u32x2 w; w.x = cvt_pk_bf16(o.x, o.y); w.y = cvt_pk_bf16(o.z, o.w); *(u32x2*)(H + (size_t)(tok0 + i) * D + 256 * j + 4 * lane) = w; } }
                if (i + 2 < 16) {
#pragma unroll
                    for (int j = 0; j < 4; ++j) xa0[j] = *(const u32x2*)(X + (size_t)(tok0 + i + 2) * D + 256 * j + 4 * lane); }
                { const float rsv = rsd[i + 1];
#pragma unroll
                  for (int j = 0; j < 4; ++j) { const f32x4 o = unpack_lo4(xa1[j]) * rsv * gmul[j] + gadd[j]; u32x2 w; w.x = cvt_pk_bf16(o.x, o.y); w.y = cvt_pk_bf16(o.z, o.w); *(u32x2*)(H + (size_t)(tok0 + i + 1) * D + 256 * j + 4 * lane) = w; } }
            }
        }
        __syncthreads();
        const int t = tid >> 2, k = tid & 3, e = te[t * 4 + k];
        const unsigned rl = __hip_atomic_fetch_add(&hist[e], 1u, __ATOMIC_RELAXED, __HIP_MEMORY_SCOPE_WORKGROUP);
        __syncthreads();
        if (tid < 32) base[tid] = __hip_atomic_fetch_add(cnt + tid, hist[tid], RLX_AGENT);
        __syncthreads();
        const unsigned pos = base[e] + rl;
        LIST[(size_t)e * NTOK + pos] = (tile * 128 + t) * 4 + k; WL[(size_t)e * NTOK + pos] = tw[t * 4 + k];
        __syncthreads();
        if (tid < 32) hist[tid] = 0u;
        __syncthreads();
    }
}

__device__ __forceinline__ void moe_tables(Frame& F, int l) {
    FRESH_IDS(F);
    LAS int* tb = (LAS int*)(F.lds + LDSCTL_OFF + 256);
    __syncthreads();
    if (F.tid < 64) {
        const int e = F.tid & 31; const int c = (int)__hip_atomic_load(F.ctl + CW_CNT + l * NE + e, RLX_AGENT); const int T = (c + 255) >> 8;
        int v = T * 256;
#pragma unroll
        for (int d = 1; d < 32; d <<= 1) { const int t = __builtin_amdgcn_ds_bpermute((F.tid - d) << 2, v); if (e >= d) v += t; }
        if (F.tid < 32) { tb[e] = T; tb[32 + e] = v - T * 256; tb[64 + e] = c; } }
    __syncthreads();
}

__global__ void __launch_bounds__(NTHREADS, 2) fwd_kernel(Args args) {
    extern __shared__ __attribute__((aligned(16))) unsigned char lds_raw[];
    Frame F;
    F.lds = (LAS unsigned char*)lds_raw; F.ws = args.ws; F.ctl = (unsigned*)(args.ws + WS_CTL);
    F.tid = threadIdx.x; F.lane = F.tid & 63; F.wave = __builtin_amdgcn_readfirstlane(F.tid >> 6); F.wave0 = F.wave; F.G = gridDim.x; F.bid = blockIdx.x;
    F.a = &args;
    for (int u = F.tid; u < 256; u += NTHREADS) ((LAS unsigned*)(F.lds + LDSCTL_OFF))[u] = 0u;
    __syncthreads();
    XcdBarrier bar; bar.bar = F.ctl + CW_BAR; bar.x = 0; bar.st = nullptr; bar.wave0 = F.wave0;
    if (N_LAUNCHES == 1) bar = xcd_barrier_post(F.ctl + CW_BAR, (volatile LAS unsigned*)(F.lds + LDSCTL_OFF + 16), F.wave0);
    const int lo = args.ph_lo, hi = args.ph_hi;
#ifdef ONLY_PH
#define IN(k) ((((k) < 2 ? (k) : 2 + ((k) - 2) % 8) == ONLY_PH) && lo <= (k) && (k) < hi)
#else
#define IN(k) (lo <= (k) && (k) < hi)
#endif
#ifdef DIAG_A
#define STAMP(k) do { if (blockIdx.x == 0 && threadIdx.x == 0) ((LAS unsigned long long*)(F.lds + LDSCTL_OFF + 704))[k] = __builtin_amdgcn_s_memrealtime(); } while (0)
#else
#define STAMP(k) do { } while (0)
#endif
#define SEAM(k) do { if (IN(k) && IN((k) + 1)) xcd_barrier(bar); } while (0)

    if (IN(0)) { STAMP(0); p0_prologue(F); } SEAM(0);
    if (IN(1)) {
        STAMP(1);
        const float* mods = WSP(float, WS_MODS);
        norm_rows<0, false>(F, FIN(0), nullptr, nullptr, nullptr, FIN(2), mods + D, mods, WSP(bf16, WS_H), nullptr);
        router_prep(F);
    } SEAM(1);

    for (int l = 0; l < DEPTH; ++l) {
        const int pb = 2 + 8 * l;
        const float* mods = WSP(float, WS_MODS) + (size_t)l * NB * 6 * D;
        if (IN(pb + 0)) { STAMP(pb + 0);
            SchedZ S{F.G, F.bid, (const char*)WSP(bf16, WS_H), (const char*)(WSP(bf16, WS_WTIN) + (size_t)l * INC * D), F.ctl + CW_QZ + l * 128};
            EpiZ E{WSP(bf16, WS_Z), WSP(bf16, WS_VT), WSP(float, WS_VSS) + (size_t)l * NTOK};
            if (((F.bid >> 3) % 6) == 5) convert_items<1>(F, F.ctl + CW_CVCTR + 32 * l, l);
            gm::gemm_phase<EpiZ, SchedZ, false, true>(F.lds, S, E, F.wave0);
        } SEAM(pb + 0);
        if (IN(pb + 1)) { STAMP(pb + 1); mixer_prep(F, l); } SEAM(pb + 1);
        if (IN(pb + 2)) { STAMP(pb + 2);
            SchedMix S{F.G, F.bid, (const char*)WSP(bf16, WS_AIN), (const char*)WSP(bf16, WS_CIN), (const char*)WSP(bf16, WS_PIN),
                       (const char*)(WSP(bf16, WS_WTA) + (size_t)l * D * D), (const char*)(WSP(bf16, WS_WTC) + (size_t)l * D * D), (const char*)(WSP(bf16, WS_WTPOOL) + (size_t)l * D * D)};
            EpiMix E{WSP(bf16, WS_Z), WSP(bf16, WS_MIX), FIN(11) + (size_t)l * D};
            gm::gemm_phase<EpiMix, SchedMix, false>(F.lds, S, E, F.wave0);
        } SEAM(pb + 2);
        if (IN(pb + 3)) { STAMP(pb + 3);
            SchedOut S{F.G, F.bid, (const char*)WSP(bf16, WS_MIX), (const char*)(WSP(bf16, WS_WTO) + (size_t)l * D * D)};
            if (l == 0) { EpiOut<true> E{FIN(0), WSP(bf16, WS_XRES), mods + 2 * D}; gm::gemm_phase<EpiOut<true>, SchedOut, false>(F.lds, S, E, F.wave0); }
            else { EpiOut<false> E{WSP(bf16, WS_XRES), WSP(bf16, WS_XRES), mods + 2 * D}; gm::gemm_phase<EpiOut<false>, SchedOut, false>(F.lds, S, E, F.wave0); }
        } SEAM(pb + 3);
        if (IN(pb + 4)) { STAMP(pb + 4); router_phase(F, l); } SEAM(pb + 4);
        if (IN(pb + 5)) { STAMP(pb + 5);
            moe_tables(F, l);
            SchedMoe S{F.G / 8, F.bid / 8, F.bid % 8, 8, (const LAS int*)(F.lds + LDSCTL_OFF + 256), (const char*)WSP(bf16, WS_H), (const char*)(WSP(bf16, WS_WTGU) + (size_t)l * NE * 2 * FF * D), (unsigned)(2 * FF * D * 2), WSP(int, WS_LIST), true};
            EpiGU E{WSP(bf16, WS_ACT), FIN(19) + (size_t)l * NE * 2 * FF};
            gm::gemm_phase<EpiGU, SchedMoe, true>(F.lds, S, E, F.wave0);
        } SEAM(pb + 5);
        if (IN(pb + 6)) { STAMP(pb + 6);
            if (N_LAUNCHES != 1) moe_tables(F, l);
            SchedMoe S{F.G / 8, F.bid / 8, F.bid % 8, 4, (const LAS int*)(F.lds + LDSCTL_OFF + 256), (const char*)WSP(bf16, WS_ACT), (const char*)(WSP(bf16, WS_WTDN) + (size_t)l * NE * D * FF), (unsigned)(D * FF * 2), WSP(int, WS_LIST), false};
            EpiDown E{WSP(bf16, WS_YB), FIN(21) + (size_t)l * NE * D, WSP(int, WS_LIST), WSP(float, WS_WLIST)};
            gm::gemm_phase<EpiDown, SchedMoe, false>(F.lds, S, E, F.wave0);
        } SEAM(pb + 6);
        if (IN(pb + 7)) { STAMP(pb + 7);
            if (l + 1 < DEPTH) { const float* m2 = WSP(float, WS_MODS) + (size_t)(l + 1) * NB * 6 * D;
                norm_rows<0, true>(F, WSP(bf16, WS_XRES), WSP(bf16, WS_YB), mods + 5 * D, WSP(bf16, WS_XRES), FIN(2) + (size_t)(l + 1) * D, m2 + D, m2, WSP(bf16, WS_H), nullptr); }
            else norm_rows<1, true>(F, WSP(bf16, WS_XRES), WSP(bf16, WS_YB), mods + 5 * D, nullptr, FIN(22), nullptr, nullptr, nullptr, F.a->out);
        } SEAM(pb + 7);
    }
#undef IN
#undef SEAM
}

extern "C" void kernel_launch(void* const* d_in, const int* in_sizes, int n_in, void* d_out, int out_size, void* d_ws, size_t ws_size, hipStream_t stream) {
    static int grid = 0;
    if (grid == 0) {
        if (n_in != 23 || out_size != NTOK * D || ws_size < WS_END) { fprintf(stderr, "kernel_launch: unexpected shapes (n_in %d out %d ws %zu)\n", n_in, out_size, ws_size); grid = -1; return; }
        int dev = 0, cus = 0, per_cu = 0;
        if (hipGetDevice(&dev) != hipSuccess || hipDeviceGetAttribute(&cus, hipDeviceAttributeMultiprocessorCount, dev) != hipSuccess) { grid = -1; return; }
        if (hipFuncSetAttribute((const void*)fwd_kernel, hipFuncAttributeMaxDynamicSharedMemorySize, LDS_BYTES) != hipSuccess) { fprintf(stderr, "kernel_launch: hipFuncSetAttribute failed\n"); grid = -1; return; }
        if (hipOccupancyMaxActiveBlocksPerMultiprocessor(&per_cu, (const void*)fwd_kernel, NTHREADS, LDS_BYTES) != hipSuccess || per_cu < 1) fprintf(stderr, "kernel_launch: occupancy query reports %d\n", per_cu);
        (void)hipGetLastError();
        grid = (cus / 8) * 8;
        if (grid > 256) grid = 256;
        if (grid < 8) { grid = -1; return; }
    }
    if (grid < 0) return;
    if (hipMemsetAsync((char*)d_ws + WS_CTL, 0, CTL_ZERO_BYTES, stream) != hipSuccess) return;
    Args a{};
    for (int i = 0; i < 23; ++i) a.in[i] = (const float*)d_in[i];
    a.out = (float*)d_out; a.ws = (unsigned char*)d_ws;
    for (int li = 0; li < N_LAUNCHES; ++li) {
        a.ph_lo = (N_LAUNCHES == 1) ? 0 : li; a.ph_hi = (N_LAUNCHES == 1) ? NPHASES : li + 1;
        hipLaunchKernelGGL(fwd_kernel, dim3(grid), dim3(NTHREADS), LDS_BYTES, stream, a);
        if (hipPeekAtLastError() != hipSuccess) { fprintf(stderr, "kernel_launch: launch %d failed\n", li); break; }
    }
}
```
